# Optimizing an MI355X kernel written in HIP

```python
import math
import jax, jax.numpy as jnp
from jax import lax
import numpy as np

D_MODEL = 2048
BATCH = 8
SEQ = 4096
DEPTH = 1

D_MIX = D_MODEL
HEAD_DIM = 128
DN_WIDTH = D_MIX // 2
DN_HEADS = DN_WIDTH // HEAD_DIM
FOX_WIDTH = D_MIX - DN_WIDTH
FOX_HEADS = FOX_WIDTH // HEAD_DIM
CONV_WIDTH = 4
DN_CHUNK = 64
Q_BLOCK = 128
MIX_SPLITS = (3 * DN_WIDTH, 4 * DN_WIDTH, 4 * DN_WIDTH + DN_HEADS, 4 * DN_WIDTH + 2 * DN_HEADS,
              4 * DN_WIDTH + 2 * DN_HEADS + 3 * FOX_WIDTH)
D_IN = 4 * DN_WIDTH + 2 * DN_HEADS + 3 * FOX_WIDTH + FOX_HEADS
N_GROUPS = 4
EXPERTS_PER_GROUP = 8
N_EXPERTS = N_GROUPS * EXPERTS_PER_GROUP
TOP_K = 2
D_EXPERT = D_MODEL // 4
MOE_BLOCK = 256
LN_EPS = 1e-5
NORM_EPS = 1e-6

kernel_name = 'hybrid_deltanet_fox_hmoe_deepnorm_adaln'


def layer_norm(x, g, b):
    xf = x.astype(jnp.float32)
    mu = jnp.mean(xf, axis=-1, keepdims=True)
    var = jnp.mean(jnp.square(xf - mu), axis=-1, keepdims=True)
    return ((xf - mu) * lax.rsqrt(var + LN_EPS) * g.astype(jnp.float32) + b.astype(jnp.float32)).astype(x.dtype)


def l2_normalize(x):
    return x * lax.rsqrt(jnp.sum(jnp.square(x), axis=-1, keepdims=True) + NORM_EPS)


def causal_short_conv(x, w):
    S = x.shape[1]
    xp = jnp.pad(x, ((0, 0), (CONV_WIDTH - 1, 0), (0, 0)))
    return sum(xp[:, i:i + S] * w[i] for i in range(CONV_WIDTH))


def gated_delta_rule(q, k, v, g, beta):
    B, H, S, Dk = q.shape
    Dv = v.shape[-1]
    C = DN_CHUNK
    nc = S // C
    chunk = lambda t: t.reshape(B, H, nc, C, *t.shape[3:])
    q = chunk(q * Dk ** -0.5)
    k = chunk(k)
    v = chunk(v)
    beta = chunk(beta)
    G = jnp.cumsum(chunk(g), axis=-1)
    incl = jnp.tril(jnp.ones((C, C), bool))
    strict = jnp.tril(jnp.ones((C, C), bool), -1)
    diff = G[..., :, None] - G[..., None, :]
    decay = jnp.where(incl, jnp.exp(jnp.where(incl, diff, 0.0)), 0.0)
    kb = k * beta[..., None]
    A = jnp.where(strict, jnp.einsum('bhncd,bhnsd->bhncs', kb, k) * decay, 0.0)
    eye = jnp.eye(C, dtype=jnp.float32)
    T = lax.linalg.triangular_solve(eye + A, jnp.broadcast_to(eye, A.shape),
                                    left_side=True, lower=True, unit_diagonal=True)
    u = T @ (v * beta[..., None])
    w = T @ (kb * jnp.exp(G)[..., None])
    qk = jnp.where(incl, jnp.einsum('bhncd,bhnsd->bhncs', q, k) * decay, 0.0)

    def step(state, inp):
        qc, kc, uc, wc, qkc, Gc = inp
        v_new = uc - wc @ state
        o = (qc * jnp.exp(Gc)[..., None]) @ state + qkc @ v_new
        G_last = Gc[..., -1:]
        state = state * jnp.exp(G_last)[..., None] + jnp.einsum(
            'bhcd,bhce->bhde', kc * jnp.exp(G_last - Gc)[..., None], v_new)
        return state, o

    state0 = jnp.zeros((B, H, Dk, Dv), jnp.float32)
    xs = tuple(jnp.moveaxis(t, 2, 0) for t in (q, k, u, w, qk, G))
    _, o = lax.scan(step, state0, xs)
    return jnp.moveaxis(o, 0, 2).reshape(B, H, S, Dv)


def forgetting_attention(q, k, v, log_f):
    B, H, S, Dh = q.shape
    nb = S // Q_BLOCK
    F = jnp.cumsum(log_f, axis=-1)
    qb = jnp.moveaxis(q.reshape(B, H, nb, Q_BLOCK, Dh), 2, 0)
    Fb = jnp.moveaxis(F.reshape(B, H, nb, Q_BLOCK), 2, 0)
    k_pos = jnp.arange(S)

    def block(inp):
        qi, Fi, i = inp
        logits = jnp.einsum('bhqd,bhkd->bhqk', qi, k).astype(jnp.float32) * Dh ** -0.5
        logits = logits + Fi[..., :, None] - F[..., None, :]
        q_pos = i * Q_BLOCK + jnp.arange(Q_BLOCK)
        logits = jnp.where(k_pos[None, :] <= q_pos[:, None], logits, -jnp.inf)
        p = jax.nn.softmax(logits, axis=-1)
        return jnp.einsum('bhqk,bhkd->bhqd', p.astype(v.dtype), v)

    o = lax.map(block, (qb, Fb, jnp.arange(nb)))
    return jnp.moveaxis(o, 0, 2).reshape(B, H, S, Dh)


def hybrid_mixer(h, w_in, conv_w, a_log, dt_bias, norm_w, f_bias, w_out):
    B, S, _ = h.shape
    proj = h @ w_in
    dn_qkv, dn_z, dn_b, dn_a, fox_qkv, fox_f = jnp.split(proj, MIX_SPLITS, axis=-1)
    heads = lambda t, nh: t.reshape(B, S, nh, -1).transpose(0, 2, 1, 3)
    f32 = jnp.float32
    dn_qkv = jax.nn.silu(causal_short_conv(dn_qkv, conv_w))
    dq, dk, dv = jnp.split(dn_qkv.astype(f32), 3, axis=-1)
    dq = l2_normalize(heads(dq, DN_HEADS))
    dk = l2_normalize(heads(dk, DN_HEADS))
    dv = heads(dv, DN_HEADS)
    beta = jax.nn.sigmoid(dn_b.astype(f32)).transpose(0, 2, 1)
    g = (-jnp.exp(a_log.astype(f32)) * jax.nn.softplus(dn_a.astype(f32) + dt_bias.astype(f32))).transpose(0, 2, 1)
    o_dn = gated_delta_rule(dq, dk, dv, g, beta).transpose(0, 2, 1, 3)
    z = dn_z.astype(f32).reshape(B, S, DN_HEADS, HEAD_DIM)
    o_dn = o_dn * lax.rsqrt(jnp.mean(jnp.square(o_dn), axis=-1, keepdims=True) + NORM_EPS) \
        * norm_w.astype(f32) * jax.nn.silu(z)
    o_dn = o_dn.reshape(B, S, DN_WIDTH).astype(h.dtype)
    fq, fk, fv = jnp.split(fox_qkv, 3, axis=-1)
    log_f = jax.nn.log_sigmoid(fox_f.astype(f32) + f_bias.astype(f32)).transpose(0, 2, 1)
    o_fox = forgetting_attention(heads(fq, FOX_HEADS), heads(fk, FOX_HEADS), heads(fv, FOX_HEADS), log_f)
    o_fox = o_fox.transpose(0, 2, 1, 3).reshape(B, S, FOX_WIDTH)
    return jnp.concatenate([o_dn, o_fox], axis=-1) @ w_out


def hier_moe(h, w_rg, b_rg, w_re, b_re, w_gate, w_up, w_down):
    B, S, D = h.shape
    hf = h.reshape(-1, D)
    N = hf.shape[0]
    f32 = jnp.float32
    g_logits = (hf @ w_rg + b_rg).astype(f32)
    g_prob = jax.nn.softmax(g_logits, axis=-1)
    g_idx = jnp.argmax(g_logits, axis=-1)
    g_w = jnp.take_along_axis(g_prob, g_idx[:, None], axis=-1)
    e_logits = jnp.einsum('nd,gde->nge', hf, w_re) + b_re
    e_logits = jnp.take_along_axis(e_logits, g_idx[:, None, None], axis=1)[:, 0].astype(f32)
    e_prob = jax.nn.softmax(e_logits, axis=-1)
    top_p, top_e = lax.top_k(e_prob, TOP_K)
    weights = g_w * top_p / jnp.sum(top_p, axis=-1, keepdims=True)
    expert = g_idx[:, None].astype(jnp.int32) * EXPERTS_PER_GROUP + top_e.astype(jnp.int32)
    M = N * TOP_K
    P = (-(-M // MOE_BLOCK) + N_EXPERTS) * MOE_BLOCK
    n_blocks = P // MOE_BLOCK
    e_flat = expert.reshape(-1)
    tok_flat = jnp.repeat(jnp.arange(N, dtype=jnp.int32), TOP_K)
    w_flat = weights.reshape(-1)
    order = jnp.argsort(e_flat)
    e_s, tok_s, w_s = e_flat[order], tok_flat[order], w_flat[order]
    sizes = jnp.zeros((N_EXPERTS,), jnp.int32).at[e_flat].add(1)
    padded = (sizes + MOE_BLOCK - 1) // MOE_BLOCK * MOE_BLOCK
    p_end = jnp.cumsum(padded)
    p_start = p_end - padded
    u_start = jnp.cumsum(sizes) - sizes
    dest = p_start[e_s] + jnp.arange(M, dtype=jnp.int32) - u_start[e_s]
    tok_buf = jnp.zeros((P,), jnp.int32).at[dest].set(tok_s)
    w_buf = jnp.zeros((P,), hf.dtype).at[dest].set(w_s.astype(hf.dtype))
    blk_expert = jnp.minimum(jnp.searchsorted(p_end, jnp.arange(n_blocks, dtype=jnp.int32) * MOE_BLOCK,
                                              side='right'), N_EXPERTS - 1)

    def expert_block(inp):
        tok, wt, e = inp
        xb = hf[tok]
        hid = jax.nn.silu(xb @ w_gate[e]) * (xb @ w_up[e])
        return (hid @ w_down[e]) * wt[:, None]

    y_buf = lax.map(expert_block, (tok_buf.reshape(n_blocks, MOE_BLOCK),
                                   w_buf.reshape(n_blocks, MOE_BLOCK), blk_expert))
    y = jax.ops.segment_sum(y_buf.reshape(P, D), tok_buf, num_segments=N)
    return y.reshape(B, S, D)


def setup_inputs(seed: int = 0) -> dict:
    key = jax.random.key(seed)
    ks = jax.random.split(key, 32)
    L = DEPTH
    f32 = jnp.float32
    nrm = lambda k, shape, scale: jax.random.normal(k, shape, f32) * scale
    beta_dn = (8 * DEPTH) ** -0.25
    s_in = D_MODEL ** -0.5
    x = nrm(ks[0], (BATCH, SEQ, D_MODEL), 1.0)
    c = nrm(ks[1], (BATCH, D_MODEL), 1.0)
    w_ada = nrm(ks[2], (L, D_MODEL, 6 * D_MODEL), 0.1 * s_in)
    b_ada = nrm(ks[3], (L, 6 * D_MODEL), 0.01)
    w_in = jnp.concatenate([
        nrm(ks[4], (L, D_MODEL, 2 * DN_WIDTH), s_in),
        nrm(ks[5], (L, D_MODEL, DN_WIDTH), s_in * beta_dn),
        nrm(ks[6], (L, D_MODEL, DN_WIDTH + 2 * DN_HEADS), s_in),
        nrm(ks[7], (L, D_MODEL, 2 * FOX_WIDTH), s_in),
        nrm(ks[8], (L, D_MODEL, FOX_WIDTH), s_in * beta_dn),
        nrm(ks[9], (L, D_MODEL, FOX_HEADS), s_in)], axis=-1)
    dn_conv_w = nrm(ks[10], (L, CONV_WIDTH, 3 * DN_WIDTH), CONV_WIDTH ** -0.5)
    dn_a_log = jnp.log(jax.random.uniform(ks[11], (L, DN_HEADS), f32, 1.0, 16.0))
    dt = jnp.exp(jax.random.uniform(ks[12], (L, DN_HEADS), f32, math.log(1e-3), math.log(1e-1)))
    dn_dt_bias = dt + jnp.log(-jnp.expm1(-dt))
    dn_norm_w = 1.0 + nrm(ks[13], (L, HEAD_DIM), 0.02)
    fox_f_bias = jax.random.uniform(ks[14], (L, FOX_HEADS), f32, 1.0, 5.0)
    w_out = nrm(ks[15], (L, D_MIX, D_MODEL), D_MIX ** -0.5 * beta_dn)
    ln1_g = 1.0 + nrm(ks[16], (L, D_MODEL), 0.02)
    ln1_b = nrm(ks[17], (L, D_MODEL), 0.02)
    w_router_group = nrm(ks[18], (L, D_MODEL, N_GROUPS), s_in)
    b_router_group = nrm(ks[19], (L, N_GROUPS), 0.01)
    w_router_expert = nrm(ks[20], (L, N_GROUPS, D_MODEL, EXPERTS_PER_GROUP), s_in)
    b_router_expert = nrm(ks[21], (L, N_GROUPS, EXPERTS_PER_GROUP), 0.01)
    w_gate = nrm(ks[22], (L, N_EXPERTS, D_MODEL, D_EXPERT), s_in)
    w_up = nrm(ks[23], (L, N_EXPERTS, D_MODEL, D_EXPERT), s_in)
    w_down = nrm(ks[24], (L, N_EXPERTS, D_EXPERT, D_MODEL), D_EXPERT ** -0.5 * beta_dn)
    ln2_g = 1.0 + nrm(ks[25], (L, D_MODEL), 0.02)
    ln2_b = nrm(ks[26], (L, D_MODEL), 0.02)
    return {'x': x, 'c': c, 'w_ada': w_ada, 'b_ada': b_ada, 'w_in': w_in, 'dn_conv_w': dn_conv_w,
            'dn_a_log': dn_a_log, 'dn_dt_bias': dn_dt_bias, 'dn_norm_w': dn_norm_w,
            'fox_f_bias': fox_f_bias, 'w_out': w_out, 'ln1_g': ln1_g, 'ln1_b': ln1_b,
            'w_router_group': w_router_group, 'b_router_group': b_router_group,
            'w_router_expert': w_router_expert, 'b_router_expert': b_router_expert,
            'w_gate': w_gate, 'w_up': w_up, 'w_down': w_down, 'ln2_g': ln2_g, 'ln2_b': ln2_b}


def reference(x, c, w_ada, b_ada, w_in, dn_conv_w, dn_a_log, dn_dt_bias, dn_norm_w, fox_f_bias,
              w_out, ln1_g, ln1_b, w_router_group, b_router_group, w_router_expert, b_router_expert,
              w_gate, w_up, w_down, ln2_g, ln2_b):
    alpha = (2 * DEPTH) ** 0.25
    for l in range(DEPTH):
        mod = jax.nn.silu(c) @ w_ada[l] + b_ada[l]
        sh1, sc1, g1, sh2, sc2, g2 = jnp.split(mod[:, None, :], 6, axis=-1)
        h = x * (1.0 + sc1) + sh1
        y = hybrid_mixer(h, w_in[l], dn_conv_w[l], dn_a_log[l], dn_dt_bias[l], dn_norm_w[l],
                         fox_f_bias[l], w_out[l])
        x = layer_norm(alpha * x + (1.0 + g1) * y, ln1_g[l], ln1_b[l])
        h = x * (1.0 + sc2) + sh2
        y = hier_moe(h, w_router_group[l], b_router_group[l], w_router_expert[l], b_router_expert[l],
                     w_gate[l], w_up[l], w_down[l])
        x = layer_norm(alpha * x + (1.0 + g2) * y, ln2_g[l], ln2_b[l])
    return x
```

```cpp
#include <hip/hip_runtime.h>
#include <cstdio>
#include <cstdint>

#ifndef MK_ONE_LAUNCH
#define MK_ONE_LAUNCH 1
#endif

#define LAS __attribute__((address_space(3)))
typedef unsigned short bf16_t;
typedef short bf16x8 __attribute__((ext_vector_type(8)));
typedef short s16x4 __attribute__((ext_vector_type(4)));
typedef float f32x4 __attribute__((ext_vector_type(4)));
typedef float f32x2 __attribute__((ext_vector_type(2)));
typedef float f32x16 __attribute__((ext_vector_type(16)));
typedef unsigned u32x4 __attribute__((ext_vector_type(4)));
typedef unsigned u32x2 __attribute__((ext_vector_type(2)));

constexpr int NB = 8, SEQ = 4096, DM = 2048, NTOK = NB * SEQ;
constexpr int NH = 8, HD = 128;
constexpr int LDP = 7168;
constexpr int PQ = 0, PK = 1024, PV = 2048, PZ = 3072, FQ = 4096, FK = 5120, FV = 6144;
constexpr int WIN_LD = 7192;
constexpr int NEXP = 32, DEXP = 512, PMAX = 2 * NTOK + NEXP * 256;
constexpr float LN_EPS = 1e-5f, NORM_EPS = 1e-6f;
constexpr float ALPHA = 1.189207115002721f;
constexpr float QSCALE = 0.08838834764831845f;
constexpr int NPHASE = 13;

constexpr size_t WS_CTL   = 0;
constexpr size_t CTL_BYTES = 65536;
constexpr int CW_CNT = 4096, CW_QUEUE = 5120, CW_NTILES = 6144, CW_TILE_E = 7168, CW_QKMAX = 8192;
constexpr size_t WS_MOD   = 65536;
constexpr size_t WS_SMALLW= WS_MOD + 393216;
constexpr size_t WS_RTW   = WS_SMALLW + 131072;
constexpr size_t WS_WOUT  = WS_RTW + 393216;
constexpr size_t WS_WIN   = WS_WOUT + 8388608;
constexpr size_t WS_SM    = WS_WIN + 29360128;
constexpr size_t WS_FCUM  = WS_SM + 4194304;
constexpr size_t WS_HBUF  = WS_FCUM + 1048576;
constexpr size_t WS_PROJ  = WS_HBUF + 134217728;
constexpr size_t WS_DN    = WS_PROJ + 469762048;
constexpr int DN_W = 0, DN_KT = 17408, DN_Q = 35840, DN_QK = 53248, DN_UT = 62464, DN_MISC = 78848, DN_CHUNK = 79104;
constexpr size_t WS_RT    = WS_DN + (size_t)4096 * DN_CHUNK;
constexpr size_t RT_E = 0, RT_W = 262144, RT_POS = 524288, RT_SLOT = 786432, RT_TOK = 1048576, RT_WB = 1048576 + 294912;
constexpr size_t WS_ELIST = WS_RT + 1048576 + 2 * 294912;
constexpr size_t WS_END   = WS_ELIST + (size_t)NEXP * NTOK * 4;
constexpr size_t WS_H2    = WS_PROJ;
constexpr size_t WS_X1    = WS_H2 + 134217728;
constexpr size_t WS_H2F8  = WS_X1 + 134217728;
constexpr size_t WS_HID   = WS_X1 + 268435456;
constexpr size_t WS_YB    = WS_HID + (size_t)PMAX * 512 * 2;
constexpr size_t WS_Y1    = WS_YB;
static_assert(WS_YB + (size_t)PMAX * 2048 * 2 <= WS_RT, "overlay");
static_assert(WS_END <= (size_t)1 << 30, "workspace");
constexpr size_t OUT_W1 = 0;
constexpr size_t OUT_W2 = 134217728;
constexpr float Y8_SCALE = 16.f, Y8_INV = 1.f / 16.f;
constexpr float W2_SCALE = 32.f, HID_SCALE = 8.f, Y2_INV = 1.f / (32.f * 8.f), W1_SCALE = 32.f, W1_INV = 1.f / 32.f;

constexpr int LDS_BYTES = 160 * 1024 - 512;
constexpr int LDS_MISC = LDS_BYTES - 256;

struct Params {
    const float* x; const float* c; const float* w_ada; const float* b_ada; const float* w_in; const float* conv_w; const float* a_log; const float* dt_bias;
    const float* norm_w; const float* f_bias; const float* w_out; const float* ln1_g; const float* ln1_b; const float* w_rg; const float* b_rg; const float* w_re;
    const float* b_re; const float* w_gate; const float* w_up; const float* w_down; const float* ln2_g; const float* ln2_b;
    float* out; unsigned char* ws; int ph_lo, ph_hi;
};

typedef __bf16 bf16v2 __attribute__((ext_vector_type(2)));
__device__ __forceinline__ unsigned cvtpk(float lo, float hi) { bf16v2 v; v[0] = (__bf16)lo; v[1] = (__bf16)hi; return __builtin_bit_cast(unsigned, v); }
__device__ __forceinline__ float bflo(unsigned w) { return __uint_as_float(w << 16); }
__device__ __forceinline__ float bfhi(unsigned w) { return __uint_as_float(w & 0xffff0000u); }
__device__ __forceinline__ float bf1(bf16_t h) { return __uint_as_float(((unsigned)h) << 16); }
__device__ __forceinline__ bf16_t f2bf(float f) { return (bf16_t)(cvtpk(f, 0.f) & 0xffffu); }
__device__ __forceinline__ float silu_f(float x) { return x * __builtin_amdgcn_rcpf(1.f + __expf(-x)); }
__device__ __forceinline__ f32x4 mfma16(bf16x8 a, bf16x8 b, f32x4 c) { return __builtin_amdgcn_mfma_f32_16x16x32_bf16(a, b, c, 0, 0, 0); }
__device__ __forceinline__ u32x2 pack4(f32x4 v) { u32x2 r; r.x = cvtpk(v[0], v[1]); r.y = cvtpk(v[2], v[3]); return r; }
__device__ __forceinline__ bf16x8 pack8(f32x4 a, f32x4 b) { u32x4 w = {cvtpk(a[0], a[1]), cvtpk(a[2], a[3]), cvtpk(b[0], b[1]), cvtpk(b[2], b[3])}; return *reinterpret_cast<bf16x8*>(&w); }
__device__ __forceinline__ void unpack8(u32x4 w, float* f) { f[0] = bflo(w.x); f[1] = bfhi(w.x); f[2] = bflo(w.y); f[3] = bfhi(w.y); f[4] = bflo(w.z); f[5] = bfhi(w.z); f[6] = bflo(w.w); f[7] = bfhi(w.w); }
typedef int i32x8 __attribute__((ext_vector_type(8)));
typedef int i32x4 __attribute__((ext_vector_type(4)));
typedef float f32x2_t __attribute__((ext_vector_type(2)));
__device__ __forceinline__ void unpack8_fp8(u32x2 w, float* f) { const f32x2_t a = __builtin_amdgcn_cvt_pk_f32_fp8((int)w.x, false), b = __builtin_amdgcn_cvt_pk_f32_fp8((int)w.x, true), c = __builtin_amdgcn_cvt_pk_f32_fp8((int)w.y, false), d = __builtin_amdgcn_cvt_pk_f32_fp8((int)w.y, true);
    f[0] = a[0]; f[1] = a[1]; f[2] = b[0]; f[3] = b[1]; f[4] = c[0]; f[5] = c[1]; f[6] = d[0]; f[7] = d[1]; }
__device__ __forceinline__ unsigned pack_fp8x4(float a, float b, float c, float d) { int w = __builtin_amdgcn_cvt_pk_fp8_f32(a, b, 0, false); w = __builtin_amdgcn_cvt_pk_fp8_f32(c, d, w, true); return (unsigned)w; }
__device__ __forceinline__ float wave_sum(float v) {
#pragma unroll
    for (int o = 32; o >= 1; o >>= 1) v += __shfl_xor(v, o);
    return v;
}
#define TRRD(dst, addr, off) asm volatile("ds_read_b64_tr_b16 %0, %1 offset:%2" : "=&v"(dst) : "v"(addr), "i"(off) : "memory")
#define LGKM0() do { asm volatile("s_waitcnt lgkmcnt(0)" ::: "memory"); __builtin_amdgcn_sched_barrier(0); } while (0)
#define VM0() asm volatile("s_waitcnt vmcnt(0)" ::: "memory")
__device__ __forceinline__ bf16x8 join8(s16x4 l, s16x4 h) { return (bf16x8){l[0], l[1], l[2], l[3], h[0], h[1], h[2], h[3]}; }

__device__ __forceinline__ int lane_id() { int l; asm volatile("v_mbcnt_lo_u32_b32 %0, -1, 0\n\tv_mbcnt_hi_u32_b32 %0, -1, %0" : "=v"(l)); __builtin_assume(l >= 0 && l < 64); return l; }
#define TID(wv) ((wv) * 64 + lane_id())
#define XB_TMO      128
#define XB_XCNT(j)  (256  + 64 * (j))
#define XB_XSUB(j)  (1280 + 64 * (j))
#define XB_XGEN(j)  (2304 + 64 * (j))
#define XB_TOP      3328
#define XB_TOPGEN   3392
#define XCD_BAR_WORDS 3456
#define XB_SPIN_CAP (1u << 18)
__device__ __forceinline__ unsigned xb_ld(unsigned* p)              { return __hip_atomic_load(p, __ATOMIC_RELAXED, __HIP_MEMORY_SCOPE_AGENT); }
__device__ __forceinline__ unsigned xb_add(unsigned* p, unsigned v) { return __hip_atomic_fetch_add(p, v, __ATOMIC_RELAXED, __HIP_MEMORY_SCOPE_AGENT); }
__device__ __forceinline__ unsigned xb_xcc_id() { return (unsigned)__builtin_amdgcn_s_getreg((3 << 11) | 20) & 0xFu; }
#define XB_SPIN(cond, bar) do { unsigned _sp = 0; while (cond) { __builtin_amdgcn_s_sleep(1); \
    if ((++_sp & 255u) == 0u) { if (xb_ld(&(bar)[XB_TMO])) break; if (_sp > XB_SPIN_CAP) { atomicAdd(&(bar)[XB_TMO], 1u); break; } } } } while (0)
struct XcdBarrier { unsigned* bar; unsigned x; volatile LAS unsigned* st; int wv; };
__device__ __forceinline__ XcdBarrier xcd_barrier_post(unsigned* bar, volatile LAS unsigned* st, int wv) {
    XcdBarrier b; b.bar = bar; b.x = xb_xcc_id(); b.st = st; b.wv = wv;
    if (TID(wv) == 0) (void)xb_add(&bar[XB_XCNT(b.x)], 1u);
    return b;
}
__device__ __forceinline__ void xcd_barrier_complete(unsigned* bar, unsigned x, unsigned& nloc, unsigned& nx) {
    const unsigned G = gridDim.x * gridDim.y * gridDim.z;
    unsigned sum, cnt, mine, sp = 0u;
    for (;;) {
        sum = 0u; cnt = 0u; mine = 0u;
#pragma unroll
        for (unsigned j = 0; j < 16; ++j) { const unsigned c = xb_ld(&bar[XB_XCNT(j)]); sum += c; cnt += (c > 0u) ? 1u : 0u; mine = (j == x) ? c : mine; }
        if (sum == G) break;
        __builtin_amdgcn_s_sleep(1);
        if ((++sp & 255u) == 0u) { if (xb_ld(&bar[XB_TMO])) break; if (sp > XB_SPIN_CAP) { atomicAdd(&bar[XB_TMO], 1u); break; } }
    }
    nloc = mine > 0u ? mine : 1u; nx = cnt > 0u ? cnt : 1u;
}
__device__ __forceinline__ void xcd_barrier(const XcdBarrier& b) {
    asm volatile("s_waitcnt vmcnt(0)" ::: "memory");
    __syncthreads();
    if (TID(b.wv) == 0) {
        unsigned* bar = b.bar;
        __builtin_amdgcn_s_waitcnt(0);
        unsigned nloc = b.st[0], nx = b.st[1];
        if (nloc == 0u) { xcd_barrier_complete(bar, b.x, nloc, nx); b.st[0] = nloc; b.st[1] = nx; }
        const unsigned old = xb_add(&bar[XB_XSUB(b.x)], 1u);
        const unsigned gen = old / nloc;
        if (old + 1u == (gen + 1u) * nloc) {
            __builtin_amdgcn_fence(__ATOMIC_RELEASE, "agent");
            asm volatile("s_waitcnt vmcnt(0)" ::: "memory");
            const unsigned og = xb_add(&bar[XB_TOP], 1u);
            const unsigned tg = og / nx;
            if (og + 1u == (tg + 1u) * nx) xb_add(&bar[XB_TOPGEN], 1u);
            else XB_SPIN(xb_ld(&bar[XB_TOPGEN]) == tg, bar);
            __builtin_amdgcn_fence(__ATOMIC_ACQUIRE, "agent");
            xb_add(&bar[XB_XGEN(b.x)], 1u);
            asm volatile("s_waitcnt vmcnt(0)" ::: "memory");
        } else {
            XB_SPIN(xb_ld(&bar[XB_XGEN(b.x)]) == gen, bar);
            __builtin_amdgcn_fence(__ATOMIC_ACQUIRE, "agent");
            asm volatile("s_waitcnt vmcnt(0)" ::: "memory");
        }
    }
    __syncthreads();
}

namespace pg8 {
constexpr int BM = 256, BK = 64, HALF = 128, HTB = HALF * BK * 2, STAGE_BYTES = 8 * HTB, NXCD = 8, WGM = 8;
__host__ __device__ __forceinline__ int lds_byte(int r, int c) { const int st = (r >> 4) * 2 + (c >> 5), rr = r & 15, cc = c & 31, ob = rr * 64 + cc * 2; return st * 1024 + (ob ^ (((ob >> 9) & 1) << 5)); }
__host__ __device__ __forceinline__ void stage_rc(int b, int& R, int& C) { const int st = b / 1024, sb = b % 1024, swz = sb ^ (((sb >> 9) & 1) << 5); R = (st >> 1) * 16 + swz / 64; C = (st & 1) * 32 + (swz % 64) / 2; }
__host__ __device__ __forceinline__ int perm32(int rho) { const int n = rho >> 4, i = rho & 15; return 8 * (i >> 2) + 4 * n + (i & 3); }
struct Unit { int pm, pn; };
struct Gemm { const bf16_t* A; const bf16_t* Bt; int M, N, K; };
struct StaticOrder {
    int nM, nN, nwg, G, c;
    __device__ void init(int M, int N, int G_, int c_) { nM = M / BM; nN = N / BM; nwg = nM * nN; G = G_; c = c_; }
    __device__ bool next(int i, Unit& u) const {
        const long L = (long)i * G + c; if (L >= nwg) return false;
        int wgid = (int)L; { const int q = nwg / NXCD, r = nwg % NXCD, xcd = wgid % NXCD, off = wgid / NXCD; wgid = (xcd < r ? xcd * (q + 1) : r * (q + 1) + (xcd - r) * q) + off; }
        const int nig = WGM * nN, gid = wgid / nig, fm = gid * WGM, gsz = (nM - fm) < WGM ? (nM - fm) : WGM;
        u.pm = fm + ((wgid % nig) % gsz); u.pn = (wgid % nig) / gsz; return true;
    }
};
struct MoeOrder {
    const LAS int* tile_e; int ntiles, ntl, G, c;
    __device__ bool next(int i, Unit& u) const {
        const long L = (long)i * G + c; if (L >= (long)ntiles * ntl) return false;
        const int t = (int)(L / ntl), j = (int)(L % ntl); u.pm = t; u.pn = tile_e[t] * ntl + j; return true;
    }
};
template <bool NT> struct EpiBf16T {
    static constexpr bool PERM = true; static constexpr int NST = 16;
    bf16_t* O; int ldc;
    __device__ __forceinline__ void operator()(const f32x4 (&acc)[2][2][4][2], const Unit& u, int wr, int wc, int fr, int fq) const {
        const int row0 = u.pm * BM + wr * 64 + fr, col0 = u.pn * BM + wc * 32 + 8 * fq;
#pragma unroll
        for (int ai = 0; ai < 2; ++ai)
#pragma unroll
            for (int m = 0; m < 4; ++m) { bf16_t* rowp = O + (size_t)(row0 + ai * HALF + m * 16) * ldc + col0;
#pragma unroll
                for (int bj = 0; bj < 2; ++bj) { const f32x4 v0 = acc[ai][bj][m][0], v1 = acc[ai][bj][m][1];
                    u32x4 w; w.x = cvtpk(v0[0], v0[1]); w.y = cvtpk(v0[2], v0[3]); w.z = cvtpk(v1[0], v1[1]); w.w = cvtpk(v1[2], v1[3]);
                    if constexpr (NT) __builtin_nontemporal_store(w, (u32x4*)(rowp + bj * HALF)); else *(u32x4*)(rowp + bj * HALF) = w; } }
    }
};
typedef EpiBf16T<false> EpiBf16;
struct EpiSwiglu {
    static constexpr bool PERM = true; static constexpr int NST = 8;
    unsigned char* O;
    __device__ __forceinline__ void operator()(const f32x4 (&acc)[2][2][4][2], const Unit& u, int wr, int wc, int fr, int fq) const {
        const int row0 = u.pm * BM + wr * 64 + fr, col0 = (u.pn & 3) * 128 + wc * 32 + 8 * fq;
#pragma unroll
        for (int ai = 0; ai < 2; ++ai)
#pragma unroll
            for (int m = 0; m < 4; ++m) { unsigned char* rowp = O + (size_t)(row0 + ai * HALF + m * 16) * DEXP + col0;
                float h[8];
#pragma unroll
                for (int n = 0; n < 2; ++n)
#pragma unroll
                    for (int j = 0; j < 4; ++j) { const float g = acc[ai][0][m][n][j] * W1_INV, up = acc[ai][1][m][n][j] * (W1_INV * HID_SCALE); h[n * 4 + j] = g * __builtin_amdgcn_rcpf(1.f + __expf(-g)) * up; }
                *(u32x2*)rowp = (u32x2){pack_fp8x4(h[0], h[1], h[2], h[3]), pack_fp8x4(h[4], h[5], h[6], h[7])}; }
    }
};
struct EpiY8 {
    static constexpr bool PERM = true, BJ8 = true; static constexpr int NST = 8;
    unsigned char* O;
    __device__ __forceinline__ void operator()(const f32x4 (&acc)[2][2][4][2], const Unit& u, int wr, int wc, int fr, int fq) const {
        const int row0 = u.pm * BM + wr * 64 + fr, col0 = (u.pn & 7) * BM + wc * 64 + 16 * fq;
#pragma unroll
        for (int ai = 0; ai < 2; ++ai)
#pragma unroll
            for (int m = 0; m < 4; ++m) { unsigned char* rowp = O + (size_t)(row0 + ai * HALF + m * 16) * DM + col0;
                u32x4 w;
#pragma unroll
                for (int bj = 0; bj < 2; ++bj)
#pragma unroll
                    for (int n = 0; n < 2; ++n) { f32x4 v = acc[ai][bj][m][n] * (Y2_INV * Y8_SCALE);
#pragma unroll
                        for (int e = 0; e < 4; ++e) v[e] = __builtin_amdgcn_fmed3f(v[e], -448.f, 448.f);
                        w[bj * 2 + n] = pack_fp8x4(v[0], v[1], v[2], v[3]); }
                *(u32x4*)rowp = w; }
    }
};

template <class E, class = void> struct EpiBj8 { static constexpr bool value = false; };
template <class E> struct EpiBj8<E, decltype((void)E::BJ8)> { static constexpr bool value = E::BJ8; };
template <class Epi, class Sched, bool GATHER, bool FP8 = false>
__device__ __forceinline__ void gemm_phase(LAS unsigned char* lds, const Gemm g, const Sched& S, const Epi& E, const LAS int* gidx, int wv) {
    const int wid = wv, lane = lane_id(), tid = wid * 64 + lane, wr = wid >> 2, wc = wid & 3, fr = lane & 15, fq = lane >> 4;
    const int K = g.K, nt = K / BK;
    unsigned voffA[2], voffB[2]; int RA[2], CA[2];
#pragma unroll
    for (int i = 0; i < 2; ++i) { int R, C; stage_rc(tid * 16 + i * 8192, R, C); const int Rb = EpiBj8<Epi>::value ? (64 * (R >> 5) + 16 * ((R & 15) >> 2) + 4 * ((R >> 4) & 1) + (R & 3)) : Epi::PERM ? ((R & ~31) + perm32(R & 31)) : R;
        voffA[i] = (unsigned)(R * K + C) * 2u; voffB[i] = (unsigned)(Rb * K + C) * 2u; RA[i] = R; CA[i] = C; }
    const size_t kstep = (size_t)(BK * 2);
    const size_t hstep = (size_t)HALF * K * 2;
    const size_t tstep = 2 * hstep;
    const size_t bstep = EpiBj8<Epi>::value ? (size_t)8 * K * 2 : hstep;
    const unsigned ldsw = (unsigned)wid * 1024u;
    const int aoff = lds_byte(wr * 64 + fr, fq * 8), boff = lds_byte(wc * 32 + fr, fq * 8);
    const int c8 = 32 * (fq >> 1) + 16 * (fq & 1);
    const int aoff8[2] = {lds_byte(wr * 64 + fr, c8), lds_byte(wr * 64 + fr, c8 + 8)}, boff8[2] = {lds_byte(wc * 32 + fr, c8), lds_byte(wc * 32 + fr, c8 + 8)};
#define PG8_SA(b, h) (((b) * 2 + (h)) * HTB)
#define PG8_SB(b, h) ((4 + (b) * 2 + (h)) * HTB)
#define PG8_STAGE(bufoff, gbase, voff) do { _Pragma("unroll") for (int _i = 0; _i < 2; ++_i) \
        __builtin_amdgcn_global_load_lds((const unsigned*)((const char*)(gbase) + (voff)[_i]), (LAS unsigned*)(lds + (bufoff) + ldsw + _i * 8192), 16, 0, 0); } while (0)
#define PG8_STAGE_A(bufoff, kbase, ubase, h, gv) do { if constexpr (GATHER) { PG8_STAGE(bufoff, kbase, gv[h]); } else { PG8_STAGE(bufoff, (ubase) + (h) * hstep, voffA); } } while (0)
#define PG8_LDA(dst, b, h) do { if constexpr (FP8) { _Pragma("unroll") for (int m = 0; m < 4; ++m) { const i32x4 lo_ = *(const LAS i32x4*)(lds + PG8_SA(b, h) + aoff8[0] + m * 2048), hi_ = *(const LAS i32x4*)(lds + PG8_SA(b, h) + aoff8[1] + m * 2048); dst##8[m] = __builtin_shufflevector(lo_, hi_, 0, 1, 2, 3, 4, 5, 6, 7); } } \
        else { _Pragma("unroll") for (int m = 0; m < 4; ++m) _Pragma("unroll") for (int k = 0; k < 2; ++k) dst[m][k] = *(const LAS bf16x8*)(lds + PG8_SA(b, h) + aoff + m * 2048 + k * 1024); } } while (0)
#define PG8_LDB(dst, b, h) do { if constexpr (FP8) { _Pragma("unroll") for (int n = 0; n < 2; ++n) { const i32x4 lo_ = *(const LAS i32x4*)(lds + PG8_SB(b, h) + boff8[0] + n * 2048), hi_ = *(const LAS i32x4*)(lds + PG8_SB(b, h) + boff8[1] + n * 2048); dst##8[n] = __builtin_shufflevector(lo_, hi_, 0, 1, 2, 3, 4, 5, 6, 7); } } \
        else { _Pragma("unroll") for (int n = 0; n < 2; ++n) _Pragma("unroll") for (int k = 0; k < 2; ++k) dst[n][k] = *(const LAS bf16x8*)(lds + PG8_SB(b, h) + boff + n * 2048 + k * 1024); } } while (0)
#define PG8_MMA(ai, bj, At, Bt) do { __builtin_amdgcn_s_setprio(1); \
        if constexpr (FP8) { _Pragma("unroll") for (int m = 0; m < 4; ++m) _Pragma("unroll") for (int n = 0; n < 2; ++n) \
            asm volatile("s_nop 1\n\tv_mfma_f32_16x16x128_f8f6f4 %0, %1, %2, %0" : "+v"(acc[ai][bj][m][n]) : "v"(Bt##8[n]), "v"(At##8[m])); }     \
        else { _Pragma("unroll") for (int m = 0; m < 4; ++m) _Pragma("unroll") for (int n = 0; n < 2; ++n) _Pragma("unroll") for (int k = 0; k < 2; ++k) \
            acc[ai][bj][m][n] = __builtin_amdgcn_mfma_f32_16x16x32_bf16(Bt[n][k], At[m][k], acc[ai][bj][m][n], 0, 0, 0); } \
        __builtin_amdgcn_s_setprio(0); } while (0)
#define PG8_WAIT_V(n) asm volatile("s_waitcnt vmcnt(" #n ")" ::: "memory")
#define PG8_WAIT_L(n) asm volatile("s_waitcnt lgkmcnt(" #n ")" ::: "memory")
#define PG8_BAR __builtin_amdgcn_s_barrier()
#define PG8_SCHED __builtin_amdgcn_sched_barrier(0)
    Unit cur, nxt; int ui = 0;
    if (!S.next(0, cur)) return;
    f32x4 acc[2][2][4][2];
#pragma unroll
    for (int a = 0; a < 2; ++a)
#pragma unroll
        for (int b = 0; b < 2; ++b)
#pragma unroll
            for (int m = 0; m < 4; ++m)
#pragma unroll
                for (int n = 0; n < 2; ++n) acc[a][b][m][n] = (f32x4){0.f, 0.f, 0.f, 0.f};
    bf16x8 At[4][2], B0[2][2], B1[2][2]; i32x8 At8[4], B08[2], B18[2];
    unsigned gc[2][2], gn[2][2];
#define PG8_GLOAD(dst, pm_) do { _Pragma("unroll") for (int h_ = 0; h_ < 2; ++h_) _Pragma("unroll") for (int i_ = 0; i_ < 2; ++i_) \
        dst[h_][i_] = ((unsigned)gidx[(pm_) * BM + h_ * HALF + RA[i_]] * (unsigned)K + (unsigned)CA[i_]) * 2u; } while (0)
    if constexpr (GATHER) { PG8_GLOAD(gc, 0); } else { gc[0][0] = gc[0][1] = gc[1][0] = gc[1][1] = 0u; }
    gn[0][0] = gc[0][0]; gn[0][1] = gc[0][1]; gn[1][0] = gc[1][0]; gn[1][1] = gc[1][1];
    const char* cA = (const char*)g.A + (GATHER ? (size_t)0 : (size_t)cur.pm * tstep); const char* cB = (const char*)g.Bt + (size_t)cur.pn * tstep;
    PG8_STAGE(PG8_SB(0, 0), cB, voffB); PG8_STAGE_A(PG8_SA(0, 0), cA, cA, 0, gc); PG8_STAGE(PG8_SB(0, 1), cB + bstep, voffB); PG8_STAGE_A(PG8_SA(0, 1), cA, cA, 1, gc);
    if (wr == 1) PG8_BAR;
    PG8_WAIT_V(4); PG8_BAR;
    PG8_STAGE(PG8_SB(1, 0), cB + kstep, voffB); PG8_STAGE_A(PG8_SA(1, 0), cA + kstep, cA + kstep, 0, gc); PG8_STAGE(PG8_SB(1, 1), cB + bstep + kstep, voffB);
    PG8_WAIT_V(6); PG8_BAR;
    PG8_STAGE_A(PG8_SA(1, 1), cA + kstep, cA + kstep, 1, gc);
    for (;;) {
        const bool has_next = S.next(ui + 1, nxt);
        const char* nA = has_next ? (const char*)g.A + (GATHER ? (size_t)0 : (size_t)nxt.pm * tstep) : cA; const char* nB = has_next ? (const char*)g.Bt + (size_t)nxt.pn * tstep : cB;
        if constexpr (GATHER) { if (has_next) { PG8_GLOAD(gn, ui + 1); } }
        for (int t = 0; t < nt; t += 2) {
            const bool last = (t == nt - 2);
            const char* a1 = cA + (size_t)(t + 1) * kstep;
            const char* a2 = last ? nA : cA + (size_t)(t + 2) * kstep; const char* b2 = last ? nB : cB + (size_t)(t + 2) * kstep;
            const char* a3 = a2 + kstep; const char* b3 = b2 + kstep;
            unsigned g2[2][2];
            if constexpr (GATHER) {
#pragma unroll
                for (int h_ = 0; h_ < 2; ++h_)
#pragma unroll
                    for (int i_ = 0; i_ < 2; ++i_) g2[h_][i_] = last ? gn[h_][i_] : gc[h_][i_];
            }
            PG8_LDB(B0, 0, 0); PG8_SCHED; PG8_LDA(At, 0, 0);
            PG8_WAIT_L(8); PG8_BAR; PG8_WAIT_L(0); PG8_MMA(0, 0, At, B0); PG8_BAR; PG8_SCHED;
            PG8_LDB(B1, 0, 1); PG8_STAGE(PG8_SB(0, 0), b2, voffB);
            PG8_BAR; PG8_WAIT_L(0); PG8_MMA(0, 1, At, B1); PG8_BAR;
            PG8_LDA(At, 0, 1); PG8_STAGE_A(PG8_SA(0, 0), a2, a2, 0, g2);
            PG8_BAR; PG8_WAIT_L(0); PG8_MMA(1, 0, At, B0); PG8_BAR; PG8_SCHED;
            PG8_STAGE(PG8_SB(0, 1), b2 + bstep, voffB);
            if (t == 0 && ui > 0) asm volatile("s_waitcnt vmcnt(%0)" :: "i"(6 + Epi::NST) : "memory"); else PG8_WAIT_V(6);
            PG8_BAR; PG8_MMA(1, 1, At, B1); PG8_BAR;
            PG8_LDB(B0, 1, 0); PG8_SCHED; PG8_LDA(At, 1, 0); PG8_STAGE_A(PG8_SA(0, 1), a2, a2, 1, g2);
            PG8_WAIT_L(8); PG8_BAR; PG8_WAIT_L(0); PG8_MMA(0, 0, At, B0); PG8_BAR; PG8_SCHED;
            PG8_LDB(B1, 1, 1); PG8_STAGE(PG8_SB(1, 0), b3, voffB);
            PG8_BAR; PG8_WAIT_L(0); PG8_MMA(0, 1, At, B1); PG8_BAR;
            PG8_LDA(At, 1, 1); PG8_STAGE_A(PG8_SA(1, 0), a3, a3, 0, g2);
            PG8_BAR; PG8_WAIT_L(0); PG8_MMA(1, 0, At, B0); PG8_BAR; PG8_SCHED;
            PG8_STAGE(PG8_SB(1, 1), b3 + bstep, voffB);
            PG8_WAIT_V(6); PG8_BAR; PG8_MMA(1, 1, At, B1); PG8_BAR;
            PG8_STAGE_A(PG8_SA(1, 1), a3, a3, 1, g2);
        }
        if constexpr (FP8) { asm volatile("s_nop 15\n\ts_nop 15" ::: "memory"); }
        E(acc, cur, wr, wc, fr, fq);
        if (!has_next) break;
#pragma unroll
        for (int a = 0; a < 2; ++a)
#pragma unroll
            for (int b = 0; b < 2; ++b)
#pragma unroll
                for (int m = 0; m < 4; ++m)
#pragma unroll
                    for (int n = 0; n < 2; ++n) acc[a][b][m][n] = (f32x4){0.f, 0.f, 0.f, 0.f};
        cur = nxt; cA = nA; cB = nB; ++ui;
        gc[0][0] = gn[0][0]; gc[0][1] = gn[0][1]; gc[1][0] = gn[1][0]; gc[1][1] = gn[1][1];
    }
    PG8_WAIT_V(0);
    if (wr == 0) PG8_BAR;
    PG8_BAR;
#undef PG8_SA
#undef PG8_SB
#undef PG8_STAGE
#undef PG8_STAGE_A
#undef PG8_LDA
#undef PG8_LDB
#undef PG8_MMA
#undef PG8_WAIT_V
#undef PG8_WAIT_L
#undef PG8_BAR
#undef PG8_SCHED
#undef PG8_GLOAD
}
}

struct Frame { LAS unsigned char* lds; int tid, lane, wave, G, bid; };

__device__ __forceinline__ void p0_mod_unit(const Params& p, const Frame& F, int u) {
    LAS float* st = (LAS float*)F.lds;
    LAS float* red = (LAS float*)(F.lds + 67584);
    for (int idx = F.tid; idx < NB * DM; idx += 512) { const int b = idx >> 11, k = idx & 2047; st[(k + (k >> 6)) * 8 + b] = silu_f(p.c[idx]); }
    __syncthreads();
    if (F.tid < 384) {
        const int cgp = F.tid % 12, kg = F.tid / 12;
        f32x4 acc[8];
#pragma unroll
        for (int b = 0; b < 8; ++b) acc[b] = (f32x4){0.f, 0.f, 0.f, 0.f};
        const char* wbase = (const char*)(p.w_ada + 48 * u); const unsigned woff = (unsigned)((kg * 64) * (6 * DM) + 4 * cgp) * 4u;
#define MOD_LOAD8(dst, j) do { _Pragma("unroll") for (int q = 0; q < 8; ++q) dst[q] = __builtin_nontemporal_load((const f32x4*)(wbase + (woff + (unsigned)((j) * 8 + q) * (unsigned)(6 * DM * 4)))); } while (0)
#define MOD_USE8(src, j) do { _Pragma("unroll") for (int q = 0; q < 8; ++q) { const int kk = (j) * 8 + q; const f32x4 w = src[q]; \
            const f32x4 s0 = *(const LAS f32x4*)(st + (kg * 65 + kk) * 8), s1 = *(const LAS f32x4*)(st + (kg * 65 + kk) * 8 + 4); \
            acc[0] += w * s0[0]; acc[1] += w * s0[1]; acc[2] += w * s0[2]; acc[3] += w * s0[3]; acc[4] += w * s1[0]; acc[5] += w * s1[1]; acc[6] += w * s1[2]; acc[7] += w * s1[3]; } } while (0)
        f32x4 wa[8], wb[8];
        MOD_LOAD8(wa, 0); __builtin_amdgcn_sched_barrier(0);
#pragma unroll 1
        for (int j = 0; j < 8; j += 2) {
            MOD_LOAD8(wb, j + 1); __builtin_amdgcn_sched_barrier(0);
            MOD_USE8(wa, j); __builtin_amdgcn_sched_barrier(0);
            { const int jn = j + 2 < 8 ? j + 2 : 7; MOD_LOAD8(wa, jn); } __builtin_amdgcn_sched_barrier(0);
            MOD_USE8(wb, j + 1); __builtin_amdgcn_sched_barrier(0);
        }
#undef MOD_LOAD8
#undef MOD_USE8
#pragma unroll
        for (int b = 0; b < 8; ++b) *(LAS f32x4*)(red + (kg * 8 + b) * 48 + 4 * cgp) = acc[b];
    }
    __syncthreads();
    if (F.tid < 384) {
        const int b = F.tid / 48, col = F.tid % 48; float s = p.b_ada[48 * u + col];
#pragma unroll
        for (int kg = 0; kg < 32; ++kg) s += red[(kg * 8 + b) * 48 + col];
        ((float*)(p.ws + WS_MOD))[b * (6 * DM) + 48 * u + col] = s;
    }
    __syncthreads();
}
struct CvtJob { const float* src; bf16_t* dst; int ld_src, ld_dst, qrows; float f8scale; };
constexpr int CVT_NT = 4;
#ifndef CVT_WGS
#define CVT_WGS 192
#endif
template <class JobFn>
__device__ __forceinline__ void cvt_stream(const Frame& F, int first, int stride, int total, JobFn job) {
    int v = first; if (v >= total) return;
    const int kr = F.tid >> 5, nc = (F.tid & 31) * 4, n = F.tid >> 2, kc = (F.tid & 3) * 16;
    CvtJob cur = job(v); f32x4 r[CVT_NT][4];
#define CVT_LOAD(jb) do { _Pragma("unroll") for (int q = 0; q < CVT_NT; ++q) _Pragma("unroll") for (int i = 0; i < 4; ++i) r[q][i] = __builtin_nontemporal_load((const f32x4*)((jb).src + (size_t)(kr + 16 * i) * (jb).ld_src + 128 * q + nc)); } while (0)
    CVT_LOAD(cur);
    int buf = 0;
    for (;;) {
        LAS unsigned char* t = F.lds + buf * (CVT_NT * 16384);
#pragma unroll
        for (int q = 0; q < CVT_NT; ++q)
#pragma unroll
            for (int i = 0; i < 4; ++i) *(LAS u32x2*)(t + q * 16384 + (kr + 16 * i) * 256 + nc * 2) = pack4(r[q][i]);
        const int vn = v + stride; const bool more = vn < total; CvtJob nx = cur;
        if (more) { nx = job(vn); CVT_LOAD(nx); }
        asm volatile("s_waitcnt lgkmcnt(0)" ::: "memory"); __builtin_amdgcn_s_barrier(); asm volatile("" ::: "memory");
#pragma unroll
        for (int q = 0; q < CVT_NT; ++q) { unsigned w[8];
#pragma unroll
          for (int e = 0; e < 8; ++e) { const unsigned lo = *(const LAS bf16_t*)(t + q * 16384 + (kc + 2 * e) * 256 + n * 2), hi = *(const LAS bf16_t*)(t + q * 16384 + (kc + 2 * e + 1) * 256 + n * 2); w[e] = lo | (hi << 16); }
          if (cur.f8scale != 0.f) { const float sc = cur.f8scale; unsigned f[4];
#pragma unroll
              for (int e = 0; e < 4; ++e) f[e] = pack_fp8x4(bflo(w[2 * e]) * sc, bfhi(w[2 * e]) * sc, bflo(w[2 * e + 1]) * sc, bfhi(w[2 * e + 1]) * sc);
              *(u32x4*)((unsigned char*)cur.dst + (size_t)(q * cur.qrows + n) * cur.ld_dst + kc) = (u32x4){f[0], f[1], f[2], f[3]}; }
          else { u32x4* d = (u32x4*)(cur.dst + (size_t)(q * cur.qrows + n) * cur.ld_dst + kc); d[0] = (u32x4){w[0], w[1], w[2], w[3]}; d[1] = (u32x4){w[4], w[5], w[6], w[7]}; } }
        if (!more) break;
        v = vn; buf ^= 1; cur = nx;
    }
#undef CVT_LOAD
    __syncthreads();
}
constexpr int P0_MOD = 256, P0_WIN = 1792, P0_WOUT = 512, P0_GU = 8192, P0_DOWN = 4096, P0_SMALL = 16, P0_RT = 24;
__device__ __forceinline__ void p0_prologue(const Params& p, const Frame& F) {
    bf16_t* wout_t = (bf16_t*)(p.ws + WS_WOUT); bf16_t* win_t = (bf16_t*)(p.ws + WS_WIN);
    for (int v = F.bid; v < P0_MOD; v += F.G) p0_mod_unit(p, F, v);
    cvt_stream(F, F.bid, F.G, (P0_WIN + P0_WOUT) / CVT_NT, [&](int g) -> CvtJob {
        int idx = g * CVT_NT;
        if (idx < P0_WIN) { const int kt = idx / 56, nt = idx % 56, n0 = 128 * nt, oc = n0 + (n0 >= 4096 ? 16 : 0);
            return CvtJob{p.w_in + (size_t)kt * 64 * WIN_LD + oc, win_t + (size_t)n0 * DM + kt * 64, WIN_LD, DM, 128, 0.f}; }
        idx -= P0_WIN; const int kt = idx / 16, nt = idx % 16;
        return CvtJob{p.w_out + (size_t)kt * 64 * DM + 128 * nt, wout_t + (size_t)(128 * nt) * DM + kt * 64, DM, DM, 128, 0.f}; });
    for (int v = F.bid; v < P0_SMALL + P0_RT; v += F.G) {
        int idx = v;
        if (idx < P0_SMALL) { bf16_t* sw = (bf16_t*)(p.ws + WS_SMALLW);
            for (int j = 0; j < 8; ++j) { const int i = idx * 4096 + j * 512 + F.tid, s = i >> 11, k = i & 2047;
                const float val = s < 24 ? p.w_in[(size_t)k * WIN_LD + (s < 16 ? 4096 + s : 7184 + s - 16)] : 0.f; sw[i] = f2bf(val); }
            continue; } idx -= P0_SMALL;
        { bf16_t* rw = (bf16_t*)(p.ws + WS_RTW);
            for (int j = 0; j < 8; ++j) { const int i = idx * 4096 + j * 512 + F.tid, n = i >> 11, k = i & 2047;
                const float val = n < 4 ? p.w_rg[k * 4 + n] : (n < 36 ? p.w_re[(size_t)((n - 4) >> 3) * DM * 8 + k * 8 + ((n - 4) & 7)] : 0.f);
                const bf16_t hi = f2bf(val); rw[i] = hi; rw[48 * DM + i] = f2bf(val - bf1(hi)); } }
    }
}
__device__ __forceinline__ void moe_weight_tiles(const Params& p, const Frame& F, int first, int stride) {
    bf16_t* w1 = (bf16_t*)((unsigned char*)p.out + OUT_W1); bf16_t* w2 = (bf16_t*)((unsigned char*)p.out + OUT_W2);
    cvt_stream(F, first, stride, (P0_GU + P0_DOWN) / CVT_NT, [&](int g) -> CvtJob {
        int idx = g * CVT_NT;
        if (idx < P0_GU) { const int e = idx >> 8, r = idx & 255, which = r >> 7, r2 = r & 127, kt = r2 >> 2;
            return CvtJob{(which ? p.w_up : p.w_gate) + (size_t)e * DM * DEXP + (size_t)kt * 64 * DEXP, (bf16_t*)((unsigned char*)w1 + (size_t)(e * 1024 + which * 128) * DM + kt * 64), DEXP, DM, 256, W1_SCALE}; }
        idx -= P0_GU; const int e = idx >> 7, r = idx & 127, kt = r >> 4, nt = r & 15;
        return CvtJob{p.w_down + (size_t)e * DEXP * DM + (size_t)kt * 64 * DM + 128 * nt, (bf16_t*)((unsigned char*)w2 + (size_t)(e * 2048 + 128 * nt) * DEXP + kt * 64), DM, DEXP, 128, W2_SCALE}; });
}

constexpr int H1_SW = 16384, H1_SWLD = 4112;
__device__ __forceinline__ void p1_hpass(const Params& p, const Frame& F) {
    const float* mod = (const float*)(p.ws + WS_MOD); bf16_t* hb = (bf16_t*)(p.ws + WS_HBUF); const bf16_t* sw = (const bf16_t*)(p.ws + WS_SMALLW); float* sm = (float*)(p.ws + WS_SM);
    const int fr = F.lane & 15, fq = F.lane >> 4;
    for (int i = F.tid; i < 32 * 256; i += 512) { const int r = i >> 8, ch = i & 255; *(LAS u32x4*)(F.lds + H1_SW + r * H1_SWLD + ch * 16) = *(const u32x4*)(sw + (size_t)r * DM + ch * 8); }
    int bcur = -1;
    for (int wt0 = F.bid * 8; wt0 < NTOK / 16; wt0 += F.G * 8) {
        const int wt = wt0 + F.wave, row0 = wt * 16, b = (wt0 * 16) / SEQ;
        if (b != bcur) { __syncthreads(); bcur = b;
            for (int i = F.tid; i < DM; i += 512) { ((LAS float*)F.lds)[i] = 1.f + mod[(size_t)b * (6 * DM) + DM + i]; ((LAS float*)F.lds)[DM + i] = mod[(size_t)b * (6 * DM) + i]; }
            __syncthreads(); }
        const float* xr = p.x + (size_t)(row0 + fr) * DM + 8 * fq; bf16_t* hr = hb + (size_t)(row0 + fr) * DM + 8 * fq;
        f32x4 a0 = {0.f, 0.f, 0.f, 0.f}, a1 = {0.f, 0.f, 0.f, 0.f};
        f32x4 xa[8][2], xn[8][2];
#define H1_LOAD(dst, blk_) do { _Pragma("unroll") for (int j = 0; j < 8; ++j) { dst[j][0] = __builtin_nontemporal_load((const f32x4*)(xr + 32 * (8 * (blk_) + j))); dst[j][1] = __builtin_nontemporal_load((const f32x4*)(xr + 32 * (8 * (blk_) + j) + 4)); } } while (0)
#define H1_COMP(src, blk_) do { _Pragma("unroll") for (int j = 0; j < 8; ++j) { const int s = 8 * (blk_) + j; \
                const f32x4 c0 = *(const LAS f32x4*)(F.lds + (32 * s + 8 * fq) * 4), c1 = *(const LAS f32x4*)(F.lds + (32 * s + 8 * fq) * 4 + 16); \
                const f32x4 h0 = *(const LAS f32x4*)(F.lds + 8192 + (32 * s + 8 * fq) * 4), h1 = *(const LAS f32x4*)(F.lds + 8192 + (32 * s + 8 * fq) * 4 + 16); \
                const bf16x8 af = pack8(src[j][0] * c0 + h0, src[j][1] * c1 + h1); \
                *(bf16x8*)(hr + 32 * s) = af; \
                const bf16x8 b0 = *(const LAS bf16x8*)(F.lds + H1_SW + fr * H1_SWLD + (32 * s + 8 * fq) * 2), b1 = *(const LAS bf16x8*)(F.lds + H1_SW + (16 + fr) * H1_SWLD + (32 * s + 8 * fq) * 2); \
                a0 = mfma16(af, b0, a0); a1 = mfma16(af, b1, a1); } } while (0)
        H1_LOAD(xa, 0);
#pragma unroll 1
        for (int bp = 0; bp < 4; ++bp) {
            H1_LOAD(xn, 2 * bp + 1); H1_COMP(xa, 2 * bp);
            if (bp < 3) H1_LOAD(xa, 2 * bp + 2);
            H1_COMP(xn, 2 * bp + 1);
        }
#undef H1_LOAD
#undef H1_COMP
#pragma unroll
        for (int j = 0; j < 4; ++j) { float* o = sm + (size_t)(row0 + 4 * fq + j) * 32; o[fr] = a0[j]; o[16 + fr] = a1[j]; }
    }
    __syncthreads();
}

constexpr int D1_KN = 0, D1_QN = 17408, D1_VN = 34816, D1_AOFF = 52224, D1_TM = 61440, D1_TB = 70656, D1_TG = 79872, D1_ADIAG = 89088, D1_GATES = 93440;
constexpr int D1_CW = 94464;
struct D1Pre { u32x4 x[3][5]; float gb, ga; };
__device__ __forceinline__ void d1_prefetch(const Params& p, const Frame& F, int u, D1Pre& P) {
    const int bh = u >> 6, c = u & 63, b = bh >> 3, h = bh & 7, row0 = b * SEQ + c * 64;
    const bf16_t* proj = (const bf16_t*)(p.ws + WS_PROJ); const float* sm = (const float*)(p.ws + WS_SM);
    const int cg = F.tid & 15, t0 = 2 * (F.tid >> 4);
#pragma unroll
    for (int part = 0; part < 3; ++part)
#pragma unroll
        for (int j = 0; j < 5; ++j) { const int tt = c * 64 + t0 - 3 + j; const int tc = tt >= 0 ? t0 - 3 + j : 0;
            P.x[part][j] = *(const u32x4*)(proj + (size_t)(row0 + tc) * LDP + part * 1024 + h * HD + 8 * cg); }
    const float* r = sm + (size_t)(row0 + F.lane) * 32; P.gb = r[h]; P.ga = r[8 + h];
}
__device__ __forceinline__ void d1_chunk(const Params& p, const Frame& F, int u, D1Pre& P, int unext) {
    LAS unsigned char* lds = F.lds;
    const int tid = F.tid, lane = F.lane, wave = F.wave, fr = lane & 15, fq = lane >> 4;
    const int bh = u >> 6, c = u & 63, h = bh & 7;
    unsigned char* outc = p.ws + WS_DN + (size_t)u * DN_CHUNK;
    LAS float* Gs = (LAS float*)(lds + D1_GATES); LAS float* Bs = Gs + 64; LAS float* EGs = Gs + 128;
    for (int i = tid; i < 2304; i += 512) *(LAS u32x4*)(lds + D1_AOFF + i * 16) = (u32x4){0u, 0u, 0u, 0u};
    if (wave == 0) {
        const float bl = P.gb, al = P.ga;
        const float beta = __builtin_amdgcn_rcpf(1.f + __expf(-bl));
        const float xs = al + p.dt_bias[h];
        const float sp = xs > 20.f ? xs : log1pf(__expf(xs));
        float G = -__expf(p.a_log[h]) * sp;
#pragma unroll
        for (int o = 1; o < 64; o <<= 1) { const float v = __shfl_up(G, o); if (lane >= o) G += v; }
        Gs[lane] = G; Bs[lane] = beta; EGs[lane] = __expf(G);
    }
    {
        const int cg = tid & 15, rp = tid >> 4, t0 = 2 * rp;
#pragma unroll
        for (int part = 0; part < 3; ++part) {
            float cw[4][8];
#pragma unroll
            for (int tp = 0; tp < 4; ++tp) { const f32x4 w0 = *(const LAS f32x4*)(lds + D1_CW + ((part * 4 + tp) * 128 + 8 * cg) * 4), w1 = *(const LAS f32x4*)(lds + D1_CW + ((part * 4 + tp) * 128 + 8 * cg + 4) * 4);
                cw[tp][0] = w0[0]; cw[tp][1] = w0[1]; cw[tp][2] = w0[2]; cw[tp][3] = w0[3]; cw[tp][4] = w1[0]; cw[tp][5] = w1[1]; cw[tp][6] = w1[2]; cw[tp][7] = w1[3]; }
            float o0[8], o1[8];
#pragma unroll
            for (int e = 0; e < 8; ++e) { o0[e] = 0.f; o1[e] = 0.f; }
#pragma unroll
            for (int j = 0; j < 5; ++j) { float xf[8]; unpack8(P.x[part][j], xf);
                const bool valid = c * 64 + t0 - 3 + j >= 0;
#pragma unroll
                for (int e = 0; e < 8; ++e) { const float xv = valid ? xf[e] : 0.f; if (j < 4) o0[e] += cw[j][e] * xv; if (j >= 1) o1[e] += cw[j - 1][e] * xv; } }
            float s0 = 0.f, s1 = 0.f;
#pragma unroll
            for (int e = 0; e < 8; ++e) { o0[e] = silu_f(o0[e]); o1[e] = silu_f(o1[e]); s0 += o0[e] * o0[e]; s1 += o1[e] * o1[e]; }
            if (part < 2) {
#pragma unroll
                for (int o = 1; o < 16; o <<= 1) { s0 += __shfl_xor(s0, o); s1 += __shfl_xor(s1, o); }
                const float r0 = rsqrtf(s0 + NORM_EPS), r1 = rsqrtf(s1 + NORM_EPS);
#pragma unroll
                for (int e = 0; e < 8; ++e) { o0[e] *= r0; o1[e] *= r1; }
            }
            const int img = part == 0 ? D1_QN : (part == 1 ? D1_KN : D1_VN);
            *(LAS bf16x8*)(lds + img + t0 * 272 + cg * 16) = pack8((f32x4){o0[0], o0[1], o0[2], o0[3]}, (f32x4){o0[4], o0[5], o0[6], o0[7]});
            *(LAS bf16x8*)(lds + img + (t0 + 1) * 272 + cg * 16) = pack8((f32x4){o1[0], o1[1], o1[2], o1[3]}, (f32x4){o1[4], o1[5], o1[6], o1[7]});
            __builtin_amdgcn_sched_barrier(0);
        }
    }
    d1_prefetch(p, F, unext, P);
    __syncthreads();
#define D1_TILE_JOB(job_) do { const int job = (job_), kind = job >> 4, ti = (job >> 2) & 3, tj = job & 3; \
        const int icol = 16 * ti + fr, j0 = 16 * tj + 4 * fq; \
        if (tj > ti) { if (kind == 1) *(u32x2*)(outc + DN_QK + icol * 144 + j0 * 2) = (u32x2){0u, 0u}; break; } \
        f32x4 acc = {0.f, 0.f, 0.f, 0.f}; \
        const int ybase = kind ? D1_QN : D1_KN; \
        _Pragma("unroll") for (int s = 0; s < 4; ++s) { \
            const bf16x8 a = *(const LAS bf16x8*)(lds + D1_KN + (16 * tj + fr) * 272 + (32 * s + 8 * fq) * 2); \
            const bf16x8 bb = *(const LAS bf16x8*)(lds + ybase + (16 * ti + fr) * 272 + (32 * s + 8 * fq) * 2); \
            acc = mfma16(a, bb, acc); } \
        const float Gi = Gs[icol]; const f32x4 Gj = *(const LAS f32x4*)(Gs + j0); \
        f32x4 v; \
        if (kind == 0) { const float bi = Bs[icol]; \
            _Pragma("unroll") for (int e = 0; e < 4; ++e) v[e] = (j0 + e < icol) ? bi * acc[e] * __expf(Gi - Gj[e]) : 0.f; \
            if (tj < ti) *(LAS u32x2*)(lds + D1_AOFF + icol * 144 + j0 * 2) = pack4(v); \
            else *(LAS f32x4*)(lds + D1_ADIAG + ti * 1040 + fr * 64 + fq * 16) = v; \
        } else { \
            _Pragma("unroll") for (int e = 0; e < 4; ++e) v[e] = (j0 + e <= icol) ? acc[e] * __expf(Gi - Gj[e]) * QSCALE : 0.f; \
            *(u32x2*)(outc + DN_QK + icol * 144 + j0 * 2) = pack4(v); \
        } } while (0)
#pragma unroll 1
    for (int jj = 0; jj < 2; ++jj) D1_TILE_JOB(wave + 8 * jj);
    __syncthreads();
    if (wave == 0) {
        { const int blk = lane >> 4, jc = lane & 15; float t[16];
#pragma unroll
          for (int i = 0; i < 16; ++i) { float a = (jc == i) ? 1.f : 0.f;
#pragma unroll
              for (int m4 = 0; m4 < (i + 3) / 4; ++m4) { const f32x4 ar = *(const LAS f32x4*)(lds + D1_ADIAG + blk * 1040 + i * 64 + m4 * 16);
#pragma unroll
                  for (int e = 0; e < 4; ++e) if (4 * m4 + e < i) a -= ar[e] * t[4 * m4 + e]; }
              t[i] = a; if ((i & 3) == 3) __builtin_amdgcn_sched_barrier(0); }
          const int j = 16 * blk + jc; const float bj = Bs[j], bgj = bj * EGs[j];
#pragma unroll
          for (int i = 0; i < 16; ++i) { const int off = (16 * blk + i) * 144 + j * 2;
              *(LAS bf16_t*)(lds + D1_TM + off) = f2bf(t[i]); *(LAS bf16_t*)(lds + D1_TB + off) = f2bf(t[i] * bj); *(LAS bf16_t*)(lds + D1_TG + off) = f2bf(t[i] * bgj); } }
        LGKM0();
        const int tmaddr = (int)(uintptr_t)(lds + D1_TM);
#pragma unroll
        for (int bb = 1; bb < 4; ++bb) {
            constexpr int NS_MAX = 2;
            bf16x8 a[NS_MAX]; s16x4 l[3][NS_MAX], hh[3][NS_MAX];
            const int ns = bb == 3 ? 2 : 1;
#pragma unroll
            for (int s_ = 0; s_ < NS_MAX; ++s_) if (s_ < ns) a[s_] = *(const LAS bf16x8*)(lds + D1_AOFF + (16 * bb + fr) * 144 + (32 * s_ + 8 * fq) * 2);
#pragma unroll
            for (int cc = 0; cc < 3; ++cc) if (cc < bb)
#pragma unroll
                for (int s_ = 0; s_ < NS_MAX; ++s_) if (s_ < ns) { const int ad = tmaddr + (32 * s_ + 8 * fq + (fr >> 2)) * 144 + (16 * cc + 4 * (fr & 3)) * 2; TRRD(l[cc][s_], ad, 0); TRRD(hh[cc][s_], ad, 576); }
            const u32x2 t2 = *(const LAS u32x2*)(lds + D1_TM + (16 * bb + fr) * 144 + (16 * bb + 4 * fq) * 2);
            LGKM0();
            f32x4 X[3];
#pragma unroll
            for (int cc = 0; cc < 3; ++cc) if (cc < bb) { X[cc] = (f32x4){0.f, 0.f, 0.f, 0.f};
#pragma unroll
                for (int s_ = 0; s_ < NS_MAX; ++s_) if (s_ < ns) X[cc] = mfma16(a[s_], join8(l[cc][s_], hh[cc][s_]), X[cc]); }
#pragma unroll
            for (int cc = 0; cc < 3; ++cc) if (cc < bb) {
                u32x4 aw = {t2.x, t2.y, 0u, 0u}, bw = {cvtpk(X[cc][0], X[cc][1]), cvtpk(X[cc][2], X[cc][3]), 0u, 0u};
                const f32x4 Tn = mfma16(*reinterpret_cast<bf16x8*>(&aw), *reinterpret_cast<bf16x8*>(&bw), (f32x4){0.f, 0.f, 0.f, 0.f});
                const int j = 16 * cc + fr; const float bj = Bs[j], bgj = bj * EGs[j];
#pragma unroll
                for (int e = 0; e < 4; ++e) { const int off = (16 * bb + 4 * fq + e) * 144 + j * 2; const float tv = -Tn[e];
                    *(LAS bf16_t*)(lds + D1_TM + off) = f2bf(tv); *(LAS bf16_t*)(lds + D1_TB + off) = f2bf(tv * bj); *(LAS bf16_t*)(lds + D1_TG + off) = f2bf(tv * bgj); }
            }
            LGKM0();
        }
    } else {
        const int t7 = tid - 64; const float Glast = Gs[63];
        for (int i = t7; i < 1024; i += 448) { const int r = i >> 4, ch = i & 15; float f[8]; unpack8(*(const LAS u32x4*)(lds + D1_QN + r * 272 + ch * 16), f); const float sc = EGs[r] * QSCALE;
            *(bf16x8*)(outc + DN_Q + r * 272 + ch * 16) = pack8((f32x4){f[0] * sc, f[1] * sc, f[2] * sc, f[3] * sc}, (f32x4){f[4] * sc, f[5] * sc, f[6] * sc, f[7] * sc}); }
        for (int i = t7; i < 1024; i += 448) { const int dk = i & 127, ich = i >> 7; float f[8];
#pragma unroll
            for (int e = 0; e < 8; ++e) f[e] = bf1(*(const LAS bf16_t*)(lds + D1_KN + (8 * ich + e) * 272 + dk * 2)) * __expf(Glast - Gs[8 * ich + e]);
            *(bf16x8*)(outc + DN_KT + dk * 144 + ich * 16) = pack8((f32x4){f[0], f[1], f[2], f[3]}, (f32x4){f[4], f[5], f[6], f[7]}); }
        if (t7 == 0) *(float*)(outc + DN_MISC) = __expf(Glast);
#pragma unroll 1
        for (int jq = 16 + wave - 1; jq < 32; jq += 7) D1_TILE_JOB(jq);
    }
#undef D1_TILE_JOB
    __syncthreads();
    { const int vnaddr = (int)(uintptr_t)(lds + D1_VN), knaddr = (int)(uintptr_t)(lds + D1_KN);
#pragma unroll
      for (int jp = 0; jp < 2; ++jp) {
        bf16x8 a[2][2]; s16x4 l[2][2], hh[2][2];
#pragma unroll
        for (int q = 0; q < 2; ++q)
#pragma unroll
            for (int s_ = 0; s_ < 2; ++s_) { const int it = 2 * jp + q;
                a[q][s_] = *(const LAS bf16x8*)(lds + D1_TB + (16 * it + fr) * 144 + (32 * s_ + 8 * fq) * 2);
                const int ad = vnaddr + (32 * s_ + 8 * fq + (fr >> 2)) * 272 + (16 * wave + 4 * (fr & 3)) * 2;
                TRRD(l[q][s_], ad, 0); TRRD(hh[q][s_], ad, 1088); }
        LGKM0();
#pragma unroll
        for (int q = 0; q < 2; ++q) { const int it = 2 * jp + q; f32x4 acc = {0.f, 0.f, 0.f, 0.f};
            acc = mfma16(a[q][0], join8(l[q][0], hh[q][0]), acc); acc = mfma16(a[q][1], join8(l[q][1], hh[q][1]), acc);
            *(u32x2*)(outc + DN_UT + (16 * wave + fr) * 128 + (16 * it + 4 * fq) * 2) = pack4(acc); }
      }
#pragma unroll
      for (int jp = 0; jp < 2; ++jp) {
        const int it = wave & 3;
        bf16x8 bb[2]; s16x4 l[2][2], hh[2][2];
#pragma unroll
        for (int s_ = 0; s_ < 2; ++s_) bb[s_] = *(const LAS bf16x8*)(lds + D1_TG + (16 * it + fr) * 144 + (32 * s_ + 8 * fq) * 2);
#pragma unroll
        for (int q = 0; q < 2; ++q)
#pragma unroll
            for (int s_ = 0; s_ < 2; ++s_) { const int dkt = 4 * jp + 2 * q + (wave >> 2);
                const int ad = knaddr + (32 * s_ + 8 * fq + (fr >> 2)) * 272 + (16 * dkt + 4 * (fr & 3)) * 2;
                TRRD(l[q][s_], ad, 0); TRRD(hh[q][s_], ad, 1088); }
        LGKM0();
#pragma unroll
        for (int q = 0; q < 2; ++q) { const int dkt = 4 * jp + 2 * q + (wave >> 2); f32x4 acc = {0.f, 0.f, 0.f, 0.f};
            acc = mfma16(join8(l[q][0], hh[q][0]), bb[0], acc); acc = mfma16(join8(l[q][1], hh[q][1]), bb[1], acc);
            *(u32x2*)(outc + DN_W + (16 * it + fr) * 272 + (16 * dkt + 4 * fq) * 2) = pack4(-acc); }
      } }
    __syncthreads();
}
__device__ __forceinline__ void fcum_unit(const Params& p, const Frame& F, int bh) {
    const float* sm = (const float*)(p.ws + WS_SM); float* fc = (float*)(p.ws + WS_FCUM) + (size_t)bh * SEQ;
    const int b = bh >> 3, h = bh & 7; const float fb = p.f_bias[h];
    LAS float* red = (LAS float*)F.lds;
    float v[8], s = 0.f;
#pragma unroll
    for (int e = 0; e < 8; ++e) { const float z = sm[(size_t)(b * SEQ + F.tid * 8 + e) * 32 + 16 + h] + fb; const float ls = fminf(z, 0.f) - log1pf(__expf(-fabsf(z))); s += ls; v[e] = s; }
    float inc = s;
#pragma unroll
    for (int o = 1; o < 64; o <<= 1) { const float t = __shfl_up(inc, o); if (F.lane >= o) inc += t; }
    if (F.lane == 63) red[F.wave] = inc;
    __syncthreads();
    float base = inc - s;
    for (int w = 0; w < F.wave; ++w) base += red[w];
#pragma unroll
    for (int e = 0; e < 8; ++e) fc[F.tid * 8 + e] = -(base + v[e]) * 11.313708498984761f;
    __syncthreads();
}
__device__ __forceinline__ int d1_unit(int bid, int i) { const int h = bid & 7, j = (bid >> 3) + 32 * i, b = j >> 6, c = j & 63; return ((b * 8 + h) << 6) + c; }
__device__ __forceinline__ void p3_dnprep(const Params& p, const Frame& F) {
    if (F.G == 256) {
        const int h = F.bid & 7;
        for (int i = F.tid; i < 3 * 4 * 128; i += 512) { const int part = i / 512, tp = (i >> 7) & 3, ch = i & 127; ((LAS float*)(F.lds + D1_CW))[i] = p.conv_w[tp * 3072 + part * 1024 + h * HD + ch]; }
        D1Pre P; d1_prefetch(p, F, d1_unit(F.bid, 0), P);
        __syncthreads();
#pragma unroll 1
        for (int i = 0; i < 16; ++i) d1_chunk(p, F, d1_unit(F.bid, i), P, d1_unit(F.bid, i < 15 ? i + 1 : i));
    } else {
        for (int u = F.bid; u < 4096; u += F.G) { const int h = (u >> 6) & 7;
            __syncthreads();
            for (int i = F.tid; i < 3 * 4 * 128; i += 512) { const int part = i / 512, tp = (i >> 7) & 3, ch = i & 127; ((LAS float*)(F.lds + D1_CW))[i] = p.conv_w[tp * 3072 + part * 1024 + h * HD + ch]; }
            D1Pre P; d1_prefetch(p, F, u, P);
            __syncthreads();
            d1_chunk(p, F, u, P, u); }
    }
    if (F.bid < 64) fcum_unit(p, F, F.bid);
    for (int u = F.bid; u < 256; u += F.G) { const int bh = u >> 2, seg = u & 3, b = bh >> 3, h = bh & 7;
        const bf16_t* proj = (const bf16_t*)(p.ws + WS_PROJ); float q2m = 0.f, k2m = 0.f;
        for (int r = F.tid >> 4; r < 1024; r += 32) { const bf16_t* rowp = proj + (size_t)(b * SEQ + seg * 1024 + r) * LDP + h * HD + 8 * (F.tid & 15);
            float qf[8], kf[8]; unpack8(*(const u32x4*)(rowp + FQ), qf); unpack8(*(const u32x4*)(rowp + FK), kf);
            float q2 = 0.f, k2 = 0.f;
#pragma unroll
            for (int e = 0; e < 8; ++e) { q2 += qf[e] * qf[e]; k2 += kf[e] * kf[e]; }
#pragma unroll
            for (int m = 1; m < 16; m <<= 1) { q2 += __shfl_xor(q2, m); k2 += __shfl_xor(k2, m); }
            q2m = fmaxf(q2m, q2); k2m = fmaxf(k2m, k2); }
#pragma unroll
        for (int m = 16; m < 64; m <<= 1) { q2m = fmaxf(q2m, __shfl_xor(q2m, m)); k2m = fmaxf(k2m, __shfl_xor(k2m, m)); }
        if (F.lane == 0) { unsigned* mx = (unsigned*)(p.ws + WS_CTL) + CW_QKMAX + 2 * bh; atomicMax(mx, __float_as_uint(q2m)); atomicMax(mx + 1, __float_as_uint(k2m)); } }
}

constexpr int SC_W = 0, SC_KT = 17408, SC_Q = 35840, SC_QK = 53248, SC_ST = 62464, SC_VT = 97280, SC_OB = 115712, SC_END = 133120, SC_UT = 133120, SC_DC = SC_UT + 16384, SC_NW = SC_DC + 64;
__device__ __forceinline__ void scan_unit(const Params& p, const Frame& F, int bh) {
    LAS unsigned char* lds = F.lds;
    const int tid = F.tid, lane = F.lane, wave = F.wave, fr = lane & 15, fq = lane >> 4;
    const int b = bh >> 3, h = bh & 7;
    const unsigned char* dn = p.ws + WS_DN + (size_t)bh * 64 * DN_CHUNK;
    const bf16_t* proj = (const bf16_t*)(p.ws + WS_PROJ); bf16_t* cat = (bf16_t*)(p.ws + WS_HBUF);
    if (wave < 4) {
        LAS unsigned char* ST = lds + SC_ST + wave * 8704; LAS unsigned char* VT = lds + SC_VT + wave * 4608;
        f32x4 S[8][2];
#pragma unroll
        for (int a = 0; a < 8; ++a) { S[a][0] = (f32x4){0.f, 0.f, 0.f, 0.f}; S[a][1] = (f32x4){0.f, 0.f, 0.f, 0.f}; }
#define LDF(base, pitch, rt, s) (*(const LAS bf16x8*)(lds + (base) + (16 * (rt) + fr) * (pitch) + (32 * (s) + 8 * fq) * 2))
#define SCHED() __builtin_amdgcn_sched_barrier(0)
#define SSTEP(c) do { \
            _Pragma("unroll") for (int dkt = 0; dkt < 8; ++dkt) _Pragma("unroll") for (int dvt = 0; dvt < 2; ++dvt) *(LAS u32x2*)(ST + (16 * dvt + fr) * 272 + (16 * dkt + 4 * fq) * 2) = pack4(S[dkt][dvt]); \
            __syncthreads();                                                                       \
            bf16x8 bs[2][4], fa[8], fb[8]; \
            _Pragma("unroll") for (int dvt = 0; dvt < 2; ++dvt) _Pragma("unroll") for (int s = 0; s < 4; ++s) bs[dvt][s] = *(const LAS bf16x8*)(ST + (16 * dvt + fr) * 272 + (32 * s + 8 * fq) * 2); \
            _Pragma("unroll") for (int i = 0; i < 8; ++i) fa[i] = LDF(SC_W, 272, i >> 2, i & 3); \
            SCHED(); \
            f32x4 va[2][2], vb[2][2]; \
            const float DC = *(const LAS float*)(lds + SC_DC); \
            _Pragma("unroll") for (int it = 0; it < 2; ++it) _Pragma("unroll") for (int dvt = 0; dvt < 2; ++dvt) { \
                const u32x2 ua = *(const LAS u32x2*)(lds + SC_UT + (32 * wave + 16 * dvt + fr) * 128 + (16 * it + 4 * fq) * 2), ub = *(const LAS u32x2*)(lds + SC_UT + (32 * wave + 16 * dvt + fr) * 128 + (16 * (2 + it) + 4 * fq) * 2); \
                va[it][dvt] = (f32x4){bflo(ua.x), bfhi(ua.x), bflo(ua.y), bfhi(ua.y)}; vb[it][dvt] = (f32x4){bflo(ub.x), bfhi(ub.x), bflo(ub.y), bfhi(ub.y)}; } \
            _Pragma("unroll") for (int i = 0; i < 8; ++i) fb[i] = LDF(SC_W, 272, 2 + (i >> 2), i & 3); \
            SCHED(); \
            _Pragma("unroll") for (int i = 0; i < 8; ++i) { va[i >> 2][0] = mfma16(fa[i], bs[0][i & 3], va[i >> 2][0]); va[i >> 2][1] = mfma16(fa[i], bs[1][i & 3], va[i >> 2][1]); } \
            SCHED(); \
            _Pragma("unroll") for (int i = 0; i < 8; ++i) fa[i] = LDF(SC_KT, 144, i >> 1, i & 1); \
            _Pragma("unroll") for (int it = 0; it < 2; ++it) _Pragma("unroll") for (int dvt = 0; dvt < 2; ++dvt) *(LAS u32x2*)(VT + (16 * dvt + fr) * 144 + (16 * it + 4 * fq) * 2) = pack4(va[it][dvt]); \
            SCHED(); \
            _Pragma("unroll") for (int i = 0; i < 8; ++i) { vb[i >> 2][0] = mfma16(fb[i], bs[0][i & 3], vb[i >> 2][0]); vb[i >> 2][1] = mfma16(fb[i], bs[1][i & 3], vb[i >> 2][1]); } \
            _Pragma("unroll") for (int it = 0; it < 2; ++it) _Pragma("unroll") for (int dvt = 0; dvt < 2; ++dvt) *(LAS u32x2*)(VT + (16 * dvt + fr) * 144 + (16 * (2 + it) + 4 * fq) * 2) = pack4(vb[it][dvt]); \
            bf16x8 bv[2][2]; \
            _Pragma("unroll") for (int dvt = 0; dvt < 2; ++dvt) _Pragma("unroll") for (int s = 0; s < 2; ++s) bv[dvt][s] = *(const LAS bf16x8*)(VT + (16 * dvt + fr) * 144 + (32 * s + 8 * fq) * 2); \
            _Pragma("unroll") for (int i = 0; i < 8; ++i) fb[i] = LDF(SC_KT, 144, 4 + (i >> 1), i & 1); \
            SCHED(); \
            _Pragma("unroll") for (int dkt = 0; dkt < 8; ++dkt) { S[dkt][0] *= DC; S[dkt][1] *= DC; } \
            _Pragma("unroll") for (int i = 0; i < 8; ++i) { S[i >> 1][0] = mfma16(fa[i], bv[0][i & 1], S[i >> 1][0]); S[i >> 1][1] = mfma16(fa[i], bv[1][i & 1], S[i >> 1][1]); } \
            _Pragma("unroll") for (int i = 0; i < 8; ++i) { S[4 + (i >> 1)][0] = mfma16(fb[i], bv[0][i & 1], S[4 + (i >> 1)][0]); S[4 + (i >> 1)][1] = mfma16(fb[i], bv[1][i & 1], S[4 + (i >> 1)][1]); } \
            __syncthreads();                                                                       \
              \
            bf16x8 bq[2][4];                                                                       \
            _Pragma("unroll") for (int dvt = 0; dvt < 2; ++dvt) _Pragma("unroll") for (int s = 0; s < 4; ++s) bq[dvt][s] = *(const LAS bf16x8*)(ST + (16 * dvt + fr) * 272 + (32 * s + 8 * fq) * 2); \
            _Pragma("unroll") for (int i = 0; i < 4; ++i) fa[i] = LDF(SC_Q, 272, 0, i); \
            fa[4] = LDF(SC_QK, 144, 0, 0); fa[5] = LDF(SC_QK, 144, 0, 1); \
            _Pragma("unroll") for (int i = 0; i < 4; ++i) fb[i] = LDF(SC_Q, 272, 1, i); \
            fb[4] = LDF(SC_QK, 144, 1, 0); fb[5] = LDF(SC_QK, 144, 1, 1); \
            SCHED(); \
            _Pragma("unroll") for (int it = 0; it < 4; ++it) { \
                f32x4 o0 = {0.f, 0.f, 0.f, 0.f}, o1 = {0.f, 0.f, 0.f, 0.f}; \
                if ((it & 1) == 0) { \
                    _Pragma("unroll") for (int i = 0; i < 4; ++i) { o0 = mfma16(fa[i], bq[0][i], o0); o1 = mfma16(fa[i], bq[1][i], o1); } \
                    _Pragma("unroll") for (int i = 0; i < 2; ++i) { o0 = mfma16(fa[4 + i], bv[0][i], o0); o1 = mfma16(fa[4 + i], bv[1][i], o1); } \
                    SCHED(); \
                    if (it + 2 < 4) { _Pragma("unroll") for (int i = 0; i < 4; ++i) fa[i] = LDF(SC_Q, 272, it + 2, i); fa[4] = LDF(SC_QK, 144, it + 2, 0); fa[5] = LDF(SC_QK, 144, it + 2, 1); } \
                } else { \
                    _Pragma("unroll") for (int i = 0; i < 4; ++i) { o0 = mfma16(fb[i], bq[0][i], o0); o1 = mfma16(fb[i], bq[1][i], o1); } \
                    _Pragma("unroll") for (int i = 0; i < 2; ++i) { o0 = mfma16(fb[4 + i], bv[0][i], o0); o1 = mfma16(fb[4 + i], bv[1][i], o1); } \
                    SCHED(); \
                    if (it + 2 < 4) { _Pragma("unroll") for (int i = 0; i < 4; ++i) fb[i] = LDF(SC_Q, 272, it + 2, i); fb[4] = LDF(SC_QK, 144, it + 2, 0); fb[5] = LDF(SC_QK, 144, it + 2, 1); } \
                } \
                _Pragma("unroll") for (int e = 0; e < 4; ++e) { const int i_ = 16 * it + 4 * fq + e; \
                    *(LAS bf16_t*)(lds + SC_OB + i_ * 272 + (32 * wave + fr) * 2) = f2bf(o0[e]); *(LAS bf16_t*)(lds + SC_OB + i_ * 272 + (32 * wave + 16 + fr) * 2) = f2bf(o1[e]); } \
                SCHED(); \
            } } while (0)
#pragma unroll 1
        for (int c2 = 0; c2 < 64; ++c2) { SSTEP(c2); }
#undef SSTEP
#undef LDF
#undef SCHED
        __syncthreads();
    } else {
        const int ht = tid - 256;
        u32x4 ra0[9], ra1[9], rb0[7], ru0[4], ru1[4]; float rd0, rd1;
#define LOADA(ra, ru, rd, cc) do { const int cc_ = (cc) < 64 ? (cc) : 63; const unsigned char* s_ = dn + (size_t)cc_ * DN_CHUNK; \
        _Pragma("unroll") for (int i = 0; i < 9; ++i) ra[i] = *(const u32x4*)(s_ + DN_W + (size_t)(ht + 256 * i) * 16); \
        _Pragma("unroll") for (int i = 0; i < 4; ++i) ru[i] = *(const u32x4*)(s_ + DN_UT + (size_t)(ht + 256 * i) * 16); rd = *(const float*)(s_ + DN_MISC); } while (0)
#define WRITEA(ra, ru, rd) do { _Pragma("unroll") for (int i = 0; i < 9; ++i) if (i < 8 || ht < 192) *(LAS u32x4*)(lds + SC_W + (ht + 256 * i) * 16) = ra[i]; \
        _Pragma("unroll") for (int i = 0; i < 4; ++i) *(LAS u32x4*)(lds + SC_UT + (ht + 256 * i) * 16) = ru[i]; if (ht == 0) *(LAS float*)(lds + SC_DC) = rd; } while (0)
#define LOADB(rb, cc) do { const int cc_ = (cc) < 64 ? (cc) : 63; const unsigned char* s_ = dn + (size_t)cc_ * DN_CHUNK + DN_Q; _Pragma("unroll") for (int i = 0; i < 7; ++i) rb[i] = *(const u32x4*)(s_ + (size_t)(ht + 256 * i) * 16); } while (0)
#define WRITEB(rb) do { _Pragma("unroll") for (int i = 0; i < 7; ++i) if (i < 6 || ht < 128) *(LAS u32x4*)(lds + SC_Q + (ht + 256 * i) * 16) = rb[i]; } while (0)
        LOADA(ra0, ru0, rd0, 0); WRITEA(ra0, ru0, rd0); LOADA(ra1, ru1, rd1, 1); LOADA(ra0, ru0, rd0, 2); LOADB(rb0, 0);
        const int ei = ht >> 2, ecg = ht & 3;
        const bf16_t* zbase = proj + (size_t)(b * SEQ + ei) * LDP + PZ + h * HD + 32 * ecg;
        if (ht < 32) *(LAS f32x4*)(lds + SC_NW + ht * 16) = *(const f32x4*)(p.norm_w + 4 * ht);
        u32x4 zr0[4];
#pragma unroll
        for (int k = 0; k < 4; ++k) zr0[k] = *(const u32x4*)(zbase + 8 * k);
#define EPILOG(ce) do { \
                const int row = b * SEQ + (ce) * 64 + ei; \
                float ss = 0.f; \
                _Pragma("unroll") for (int k = 0; k < 4; ++k) { float o[8]; unpack8(*(const LAS u32x4*)(lds + SC_OB + ei * 272 + (32 * ecg + 8 * k) * 2), o); \
                    _Pragma("unroll") for (int e = 0; e < 8; ++e) ss += o[e] * o[e]; } \
                ss += __shfl_xor(ss, 1); ss += __shfl_xor(ss, 2); \
                const float rs = rsqrtf(ss * (1.f / 128.f) + NORM_EPS); \
                bf16_t* op = cat + (size_t)row * DM + h * HD + 32 * ecg; \
                _Pragma("unroll") for (int k = 0; k < 4; ++k) { float z[8], o[8]; unpack8(zr0[k], z); unpack8(*(const LAS u32x4*)(lds + SC_OB + ei * 272 + (32 * ecg + 8 * k) * 2), o); float r[8]; \
                    const f32x4 nw0 = *(const LAS f32x4*)(lds + SC_NW + (32 * ecg + 8 * k) * 4), nw1 = *(const LAS f32x4*)(lds + SC_NW + (32 * ecg + 8 * k + 4) * 4); \
                    _Pragma("unroll") for (int e = 0; e < 8; ++e) r[e] = o[e] * rs * (e < 4 ? nw0[e] : nw1[e - 4]) * silu_f(z[e]); \
                    *(bf16x8*)(op + 8 * k) = pack8((f32x4){r[0], r[1], r[2], r[3]}, (f32x4){r[4], r[5], r[6], r[7]}); } } while (0)
#define HSTEP(c, RBX, RAY, RUY, RDY) do { \
            __syncthreads();                                                                       \
            WRITEB(RBX); LOADB(RBX, (c) + 1); \
            { const int ce = (c) > 0 ? (c) - 1 : 0; EPILOG(ce); } \
            { _Pragma("unroll") for (int k = 0; k < 4; ++k) zr0[k] = *(const u32x4*)(zbase + (size_t)(c) * 64 * LDP + 8 * k); }     \
            __syncthreads();                                                                       \
            WRITEA(RAY, RUY, RDY); LOADA(RAY, RUY, RDY, (c) + 3); \
            } while (0)
#pragma unroll 1
        for (int c2 = 0; c2 < 64; c2 += 2) { HSTEP(c2, rb0, ra1, ru1, rd1); HSTEP(c2 + 1, rb0, ra0, ru0, rd0); }
        __syncthreads();
        EPILOG(63);
#undef HSTEP
#undef EPILOG
#undef LOADA
#undef WRITEA
#undef LOADB
#undef WRITEB
    }
    __syncthreads();
}

namespace fox {
constexpr int D = 128, NW = 8, QBLK = 32, KVBLK = 64, QB = NW * QBLK;
constexpr int SHM_V = KVBLK * D * 2, SHM_K = KVBLK * D * 2;
constexpr int OFF_WS = 2 * SHM_V + 2 * SHM_K, OFF_BIAS = OFF_WS + NW * 64 * 4, OFF_Q = OFF_BIAS + 2 * 64 * 4, LDS_NEED = OFF_Q + NW * 8192;
constexpr float SCALE = 0.08838834764831845f, INV_SCALE = 11.313708498984761f, THR = 8.f;
constexpr int W = SEQ;
#define KSWZ(row, colB) ((row) * 256 + ((colB) ^ (((row) & 7) << 4)))
#define SBAR() __builtin_amdgcn_sched_barrier(0)
__device__ __forceinline__ int v_st(int k, int c) { const int kk = (k & ~0xC) | ((k & 4) << 1) | ((k & 8) >> 1); return ((kk >> 3) * 4 + (c >> 5)) * 512 + ((kk & 7) * 32 + (c & 31)) * 2; }
__device__ __forceinline__ int v_rd_base(int lane) { return ((lane & 3) << 3) | (((lane >> 2) & 3) << 6) | (((lane >> 4) & 1) << 5) | (((lane >> 5) & 1) << 8); }
constexpr int v_rd_off(int d0, int ks, int half) { return d0 * 512 + ks * 4096 + half * 2048; }
__device__ __forceinline__ int crow(int r, int hi) { return (r & 3) + 8 * (r >> 2) + 4 * hi; }
__device__ __forceinline__ void mask_tile(f32x16& p0, f32x16& p1, int dq, unsigned Wm) {
    const float NEG = -__builtin_inff();
#pragma unroll
    for (int r = 0; r < 16; ++r) {
        const int c = (r & 3) + 8 * (r >> 2);
        if ((unsigned)(dq - c) >= Wm) p0[r] = NEG;
        if ((unsigned)(dq - c - 32) >= Wm) p1[r] = NEG;
    }
}
__device__ __forceinline__ void partialSM(f32x16& p0, f32x16& p1, float& m_reg, float& mn, float& alpha) {
    float pmax = p0[0]; for (int r = 1; r < 16; ++r) pmax = fmaxf(pmax, p0[r]); for (int r = 0; r < 16; ++r) pmax = fmaxf(pmax, p1[r]);
    { auto rr = __builtin_amdgcn_permlane32_swap(__float_as_uint(pmax), __float_as_uint(pmax), false, false);
      pmax = fmaxf(__uint_as_float(rr[0]), __uint_as_float(rr[1])); }
    constexpr float C2 = 1.4426950408889634f * SCALE;
    if (__builtin_expect(__all((pmax - m_reg) * SCALE <= THR), 1)) { mn = m_reg; alpha = 1.f; }
    else { mn = fmaxf(m_reg, pmax); alpha = __builtin_amdgcn_exp2f((m_reg - mn) * C2); m_reg = mn; }
    const float mnL = -mn * C2;
    for (int r = 0; r < 16; ++r) p0[r] = fmaf(p0[r], C2, mnL); for (int r = 0; r < 16; ++r) p1[r] = fmaf(p1[r], C2, mnL);
    for (int r = 0; r < 16; ++r) p0[r] = __builtin_amdgcn_exp2f(p0[r]);
}
__device__ __forceinline__ void finishSM(f32x16& p0, f32x16& p1, float alpha, float& l_reg, bf16x8& pa0, bf16x8& pa1, bf16x8& pa2, bf16x8& pa3) {
    for (int r = 0; r < 16; ++r) p1[r] = __builtin_amdgcn_exp2f(p1[r]);
    float ps = 0; for (int r = 0; r < 16; ++r) ps += p0[r]; for (int r = 0; r < 16; ++r) ps += p1[r];
    { auto rr = __builtin_amdgcn_permlane32_swap(__float_as_uint(ps), __float_as_uint(ps), false, false);
      ps = __uint_as_float(rr[0]) + __uint_as_float(rr[1]); }
    l_reg = l_reg * alpha + ps;
#define PK4(P, B_, OUT) do { unsigned a0 = cvtpk(P[B_+0], P[B_+1]), a1 = cvtpk(P[B_+2], P[B_+3]);                          \
        unsigned b0 = cvtpk(P[B_+4], P[B_+5]), b1 = cvtpk(P[B_+6], P[B_+7]);                                             \
        auto r0 = __builtin_amdgcn_permlane32_swap(a0, b0, false, false); auto r1 = __builtin_amdgcn_permlane32_swap(a1, b1, false, false); \
        u32x4 w = {r0[0], r1[0], r0[1], r1[1]}; OUT = *reinterpret_cast<bf16x8*>(&w); } while (0)
    PK4(p0, 0, pa0); PK4(p0, 8, pa1); PK4(p1, 0, pa2); PK4(p1, 8, pa3);
#undef PK4
}
template <int KB>
__device__ __forceinline__ void qkt(f32x16& p0, f32x16& p1, const char* K_lds, const char* bias_lds, int r32, int hi, const char* qf) {
    const char* bb = bias_lds + KB * 256 + hi * 16;
#pragma unroll
    for (int g = 0; g < 4; ++g) { const f32x4 b0 = *reinterpret_cast<const f32x4*>(bb + g * 32), b1 = *reinterpret_cast<const f32x4*>(bb + 128 + g * 32);
        p0[4 * g] = b0[0]; p0[4 * g + 1] = b0[1]; p0[4 * g + 2] = b0[2]; p0[4 * g + 3] = b0[3];
        p1[4 * g] = b1[0]; p1[4 * g + 1] = b1[1]; p1[4 * g + 2] = b1[2]; p1[4 * g + 3] = b1[3]; }
    const char* kb[4];
#pragma unroll
    for (int dd = 0; dd < 4; ++dd) kb[dd] = K_lds + KB * SHM_K + KSWZ(r32, (dd * 16 + hi * 8) * 2);
#pragma unroll
    for (int d0 = 0; d0 < 8; ++d0) { const char* a = kb[d0 & 3] + (d0 >> 2) * 128;
        bf16x8 b0 = *reinterpret_cast<const bf16x8*>(a);
        bf16x8 b1 = *reinterpret_cast<const bf16x8*>(a + 32 * 256);
        const bf16x8 q = *reinterpret_cast<const bf16x8*>(qf + d0 * 1024);
        p0 = __builtin_amdgcn_mfma_f32_32x32x16_bf16(b0, q, p0, 0, 0, 0);
        p1 = __builtin_amdgcn_mfma_f32_32x32x16_bf16(b1, q, p1, 0, 0, 0); }
}
template <int VB>
__device__ __forceinline__ void pv_tile(f32x16* o, int vb0, bf16x8 pa0, bf16x8 pa1, bf16x8 pa2, bf16x8 pa3) {
#define PV_D0(d0) do { constexpr int b_ = VB * SHM_V + v_rd_off(d0, 0, 0); \
        { s16x4 l0, l1, h0, h1; TRRD(l0, vb0, b_); TRRD(h0, vb0, b_ + 2048); TRRD(l1, vb0, b_ + 4096); TRRD(h1, vb0, b_ + 6144); \
        asm volatile("s_waitcnt lgkmcnt(0)" ::: "memory"); SBAR();   \
        o[d0] = __builtin_amdgcn_mfma_f32_32x32x16_bf16(pa0, join8(l0, h0), o[d0], 0, 0, 0);   \
        o[d0] = __builtin_amdgcn_mfma_f32_32x32x16_bf16(pa1, join8(l1, h1), o[d0], 0, 0, 0); }   \
        { s16x4 l2, l3, h2, h3; TRRD(l2, vb0, b_ + 8192); TRRD(h2, vb0, b_ + 10240); TRRD(l3, vb0, b_ + 12288); TRRD(h3, vb0, b_ + 14336); \
        asm volatile("s_waitcnt lgkmcnt(0)" ::: "memory"); SBAR();   \
        o[d0] = __builtin_amdgcn_mfma_f32_32x32x16_bf16(pa2, join8(l2, h2), o[d0], 0, 0, 0);   \
        o[d0] = __builtin_amdgcn_mfma_f32_32x32x16_bf16(pa3, join8(l3, h3), o[d0], 0, 0, 0); } } while (0)
    PV_D0(0); PV_D0(1); PV_D0(2); PV_D0(3);
#undef PV_D0
}
struct BlockRef { int bh, qb, jlo; };
__device__ __forceinline__ const bf16_t* ref_Q(unsigned char* ws, BlockRef r) { return (const bf16_t*)(ws + WS_PROJ) + (size_t)((r.bh >> 3) * SEQ + r.qb * QB) * LDP + FQ + (r.bh & 7) * HD; }
__device__ __forceinline__ const bf16_t* ref_K(unsigned char* ws, BlockRef r) { return (const bf16_t*)(ws + WS_PROJ) + (size_t)((r.bh >> 3) * SEQ) * LDP + FK + (r.bh & 7) * HD; }
__device__ __forceinline__ bf16_t* ref_O(unsigned char* ws, BlockRef r) { return (bf16_t*)(ws + WS_HBUF) + (size_t)((r.bh >> 3) * SEQ + r.qb * QB) * DM + 1024 + (r.bh & 7) * HD; }
__device__ __forceinline__ const float* ref_F(unsigned char* ws, BlockRef r) { return (const float*)(ws + WS_FCUM) + (size_t)r.bh * SEQ; }
struct Seam { bf16x8 qr[8]; bf16x8 st_v0, st_v1, st_k0, st_k1; };
#define ROW(p_, k0, rr) ((p_) + (unsigned)(((k0) + (rr)) * LDP + sc))
#define VMWN(n) asm volatile("s_waitcnt vmcnt(%0)" :: "i"(n) : "memory")
#define LD8(ptr) (*reinterpret_cast<const bf16x8*>(ptr))
#define SLOAD_H(Kp, Vp, Fp, k0, bf) do { const bf16_t* r0_ = ROW(Kp, k0, sr); const bf16_t* r1_ = ROW(Kp, k0, 32 + sr);             \
                         S.st_v0 = LD8(r0_ + (FV - FK)); S.st_v1 = LD8(r1_ + (FV - FK)); S.st_k0 = LD8(r0_); S.st_k1 = LD8(r1_); \
                         if (wid == 0) __builtin_amdgcn_global_load_lds((const unsigned*)((Fp) + (k0) + lane), (LAS unsigned*)(lds_las + OFF_BIAS + (bf) * 256), 4, 0, 0); } while (0)
#define SWRITE_HK(bf) do { *(bf16x8*)(K_lds + (bf) * SHM_K + kws) = S.st_k0; *(bf16x8*)(K_lds + (bf) * SHM_K + kws + 32 * 256) = S.st_k1; } while (0)
#define SWRITE_HV(bf) do { *(bf16x8*)(V_lds + (bf) * SHM_V + vst0) = S.st_v0; *(bf16x8*)(V_lds + (bf) * SHM_V + vst1) = S.st_v1; } while (0)
#define SWRITE_H(bf) do { SWRITE_HV(bf); SWRITE_HK(bf); } while (0)
__device__ __forceinline__ void prime(unsigned char* wsb, const BlockRef cur, char* lds, LAS unsigned char* lds_las, Seam& S, int wv) {
    const int wid = wv, lane = lane_id(), tid = wid * 64 + lane, r32 = lane & 31, hi = lane >> 5;
    const int sr = tid >> 4, sc = (tid & 15) * 8, kws = KSWZ(sr, sc * 2); char* K_lds = lds + 2 * SHM_V; char* bias_lds = lds + OFF_BIAS;
    { const bf16_t* q_ = ref_Q(wsb, cur); for (int d0 = 0; d0 < 8; ++d0) S.qr[d0] = LD8(q_ + (unsigned)((wid * QBLK + r32) * LDP + d0 * 16 + hi * 8)); }
    SLOAD_H(ref_K(wsb, cur), 0, ref_F(wsb, cur), cur.jlo * KVBLK, 0); VM0(); SWRITE_HK(0);
    for (int d0 = 0; d0 < 8; ++d0) *(bf16x8*)(lds + OFF_Q + wid * 8192 + d0 * 1024 + lane * 16) = S.qr[d0];
    __syncthreads();
}
__device__ __forceinline__ void block(unsigned char* wsb, const BlockRef cur, const BlockRef nxt, char* lds, LAS unsigned char* lds_las, Seam& S, int wv) {
    const int wid = wv, lane = lane_id(), tid = wid * 64 + lane, r32 = lane & 31, hi = lane >> 5;
    const int P0 = cur.qb * QB;
    const int j_hi = (P0 + QB - 1) / KVBLK + 1, j_lo = cur.jlo;
    const int NT = j_hi - j_lo;
    const int qlo = P0 + wid * QBLK, qm = qlo + r32 - 4 * hi;
    char* V_lds = lds; char* K_lds = lds + 2 * SHM_V; char* bias_lds = lds + OFF_BIAS; const char* qf = lds + OFF_Q + wid * 8192 + lane * 16;
    float* ws = (float*)(lds + OFF_WS) + wid * 64; float* li_l = ws, * al_l = ws + 32;
    float m_reg = -1e30f, l_reg = 0; f32x16 o[4] = {};
    const int sr = tid >> 4, sc = (tid & 15) * 8, vst0 = v_st(sr, sc), vst1 = v_st(32 + sr, sc), kws = KSWZ(sr, sc * 2);
    const int vb0 = (int)(uintptr_t)V_lds + v_rd_base(lane);
    const bf16_t* Kh = ref_K(wsb, cur); const float* Fh = ref_F(wsb, cur);
#define RESC(a) do { if (__any((a) < 1.f)) { if (hi == 0) al_l[r32] = (a); asm volatile("s_waitcnt lgkmcnt(0)" ::: "memory");              \
                     for (int d_ = 0; d_ < 4; ++d_) for (int r = 0; r < 16; ++r) o[d_][r] *= al_l[crow(r, hi)]; } } while (0)
#define KBASE(t) ((j_lo + (t)) * KVBLK)
#define MASKT(P0_, P1_, t) do { const int kb_ = KBASE(t); if (kb_ + KVBLK - 1 > qlo) mask_tile(P0_, P1_, qm - kb_, (unsigned)W); } while (0)
    constexpr int NQL = 8;
#define SEAM_K0() do { VMWN(NQL); SWRITE_HK(0); SBAR(); } while (0)
    f32x16 pA0, pA1, pB0, pB1; float mnA, mnB, alA, alB; bf16x8 pa0, pa1, pa2, pa3;
    SWRITE_HV(0); SBAR();
    if (NT > 1) { SLOAD_H(Kh, 0, Fh, KBASE(1), 1); }
    SBAR(); qkt<0>(pA0, pA1, K_lds, bias_lds, r32, hi, qf);
    MASKT(pA0, pA1, 0); partialSM(pA0, pA1, m_reg, mnA, alA);
    if (NT > 1) { VM0(); SWRITE_H(1); }
    __syncthreads();
#define HALF_STEP(PX0, PX1, mnX, alX, PY0, PY1, alY, t, KB, VB, SB) do {                                                      \
        SBAR(); qkt<KB>(PX0, PX1, K_lds, bias_lds, r32, hi, qf);                                             \
        finishSM(PY0, PY1, alY, l_reg, pa0, pa1, pa2, pa3); SBAR();                                                           \
        if ((t) + 1 < NT) { SLOAD_H(Kh, 0, Fh, KBASE((t) + 1), SB); SBAR(); }                                               \
        pv_tile<VB>(o, vb0, pa0, pa1, pa2, pa3); MASKT(PX0, PX1, (t)); partialSM(PX0, PX1, m_reg, mnX, alX);                                        \
        __syncthreads();                                                                                                      \
        if ((t) + 1 < NT) { VM0(); SWRITE_H(SB); }                                                                          \
        RESC(alX); __syncthreads(); } while (0)
    for (int t = 1; t + 1 < NT; t += 2) {
        HALF_STEP(pB0, pB1, mnB, alB, pA0, pA1, alA, t, 1, 0, 0);
        HALF_STEP(pA0, pA1, mnA, alA, pB0, pB1, alB, t + 1, 0, 1, 1);
    }
    const bool even = (NT & 1) == 0;
    if (even) { SBAR(); qkt<1>(pB0, pB1, K_lds, bias_lds, r32, hi, qf); SBAR(); }
    SLOAD_H(ref_K(wsb, nxt), 0, ref_F(wsb, nxt), nxt.jlo * KVBLK, 0); SBAR();
    { const bf16_t* q_ = ref_Q(wsb, nxt);
#pragma unroll
    for (int d0 = 0; d0 < 8; ++d0) S.qr[d0] = LD8(q_ + (unsigned)((wid * QBLK + r32) * LDP + d0 * 16 + hi * 8)); }
    SBAR();
    finishSM(pA0, pA1, alA, l_reg, pa0, pa1, pa2, pa3); SBAR();
    pv_tile<0>(o, vb0, pa0, pa1, pa2, pa3);
    if (even) { MASKT(pB0, pB1, NT - 1); partialSM(pB0, pB1, m_reg, mnB, alB); __syncthreads(); RESC(alB);
        finishSM(pB0, pB1, alB, l_reg, pa0, pa1, pa2, pa3); SBAR(); pv_tile<1>(o, vb0, pa0, pa1, pa2, pa3); }
    SBAR(); SEAM_K0();
    if (hi == 0) li_l[r32] = l_reg; asm volatile("s_waitcnt lgkmcnt(0)" ::: "memory");
    float rli[16];
#pragma unroll
    for (int r = 0; r < 16; ++r) rli[r] = __builtin_amdgcn_rcpf(li_l[crow(r, hi)]);
    bf16_t* Ow = ref_O(wsb, cur) + (size_t)(wid * QBLK) * DM;
#pragma unroll
    for (int r = 0; r < 16; ++r) { const int orow = crow(r, hi);
#pragma unroll
        for (int d0 = 0; d0 < 4; ++d0) { const float v = o[d0][r] * rli[r];
            const float vn = __shfl_xor(v, 1);
            if ((r32 & 1) == 0) *(unsigned*)(Ow + (unsigned)(orow * DM + d0 * 32 + r32)) = cvtpk(v, vn); } }
#pragma unroll
    for (int d0 = 0; d0 < 8; ++d0) *(bf16x8*)(lds + OFF_Q + wid * 8192 + d0 * 1024 + lane * 16) = S.qr[d0];
    __syncthreads();
#undef RESC
#undef KBASE
#undef MASKT
#undef SEAM_K0
#undef HALF_STEP
}
#undef ROW
#undef VMWN
#undef SLOAD_H
#undef SWRITE_HK
#undef SWRITE_HV
#undef SWRITE_H
#undef LD8
}

__device__ __forceinline__ int attn_pull(unsigned* qbase, int& qx, int x0, bool& dead) {
    if (dead) return -1;
    for (;;) {
        const int k = (int)__hip_atomic_fetch_add(qbase + 64 * qx, 1u, __ATOMIC_RELAXED, __HIP_MEMORY_SCOPE_AGENT);
        if (k < 128) return qx * 128 + k;
        qx = (qx + 1) & 7; if (qx == x0) { dead = true; return -1; }
    }
}
__device__ __forceinline__ int fox_jlo(const Params& p, int bh, int qb, int lane) {
    const float* Bv = (const float*)(p.ws + WS_FCUM) + (size_t)bh * SEQ;
    const unsigned* mx = (const unsigned*)(p.ws + WS_CTL) + CW_QKMAX + 2 * bh;
    const float q2 = __uint_as_float(__hip_atomic_load(mx, __ATOMIC_RELAXED, __HIP_MEMORY_SCOPE_AGENT)), k2 = __uint_as_float(__hip_atomic_load(mx + 1, __ATOMIC_RELAXED, __HIP_MEMORY_SCOPE_AGENT));
    const float thr = (40.f + 2.f * fox::SCALE * sqrtf(q2 * k2) * 1.01f) * fox::INV_SCALE;
    const float b1 = Bv[64 * lane + 63], b0 = Bv[qb * fox::QB];
    const unsigned long long m = __ballot(b1 < b0 - thr);
    return __builtin_popcountll(m);
}
__device__ __forceinline__ fox::BlockRef attn_ref(const Params& p, int item, int lane) { fox::BlockRef r; const int x = item >> 7, k = item & 127; r.bh = 8 * x + (k & 7); r.qb = 15 - (k >> 3);
    r.jlo = __builtin_amdgcn_readfirstlane(fox_jlo(p, r.bh, r.qb, lane)); return r; }
__device__ __forceinline__ void p4_attention(const Params& p, const Frame& F, char* lds_generic) {
    using namespace fox;
    unsigned* qbase = (unsigned*)(p.ws + WS_CTL) + CW_QUEUE;
    volatile LAS int* qslot = (volatile LAS int*)(F.lds + LDS_MISC + 64);
    const int x0 = (int)(xb_xcc_id() & 7u); int qx = x0; bool dead = false;
    if (F.tid == 0) { qslot[0] = attn_pull(qbase, qx, x0, dead); qslot[1] = attn_pull(qbase, qx, x0, dead); }
    __syncthreads();
    int L = qslot[0], Ln = qslot[1];
    if (L < 0) { __syncthreads(); return; }
    BlockRef cur = attn_ref(p, L, F.lane);
    Seam S;
    prime(p.ws, cur, lds_generic, F.lds, S, F.wave);
    for (int it = 0;; ++it) {
        const bool last = Ln < 0;
        const BlockRef nxt = last ? cur : attn_ref(p, Ln, F.lane);
        if (F.tid == 0) qslot[it & 1] = attn_pull(qbase, qx, x0, dead);
        block(p.ws, cur, nxt, lds_generic, F.lds, S, F.wave);
        if (last) break;
        cur = nxt; L = Ln; Ln = qslot[it & 1];
    }
    __syncthreads();
}

constexpr int L1_G1P = 0, L1_LNG = 8192, L1_LNB = 16384, L1_SC2P = 24576, L1_SH2 = 32768, L1_LG = 40960;
__device__ __forceinline__ void p6_ln1_router(const Params& p, const Frame& F) {
    const float* mod = (const float*)(p.ws + WS_MOD); const bf16_t* y1 = (const bf16_t*)(p.ws + WS_Y1); bf16_t* x1 = (bf16_t*)(p.ws + WS_X1); bf16_t* h2 = (bf16_t*)(p.ws + WS_H2);
    const bf16_t* rw = (const bf16_t*)(p.ws + WS_RTW); unsigned char* h2f8 = p.ws + WS_H2F8;
    unsigned* cnt = (unsigned*)(p.ws + WS_CTL) + CW_CNT;
    int* rt_e = (int*)(p.ws + WS_RT + RT_E); float* rt_w = (float*)(p.ws + WS_RT + RT_W); int* rt_pos = (int*)(p.ws + WS_RT + RT_POS); int* elist = (int*)(p.ws + WS_ELIST);
    LAS float* lg = (LAS float*)(F.lds + L1_LG + F.wave * 4096);
    const int fr = F.lane & 15, fq = F.lane >> 4;
    int bcur = -1;
    for (int g0 = F.bid; g0 < NTOK / 128; g0 += F.G) {
        const int b = (g0 * 128) / SEQ;
        if (b != bcur) { __syncthreads(); bcur = b; const float* mb = mod + (size_t)b * (6 * DM);
            for (unsigned i = (unsigned)F.tid; i < (unsigned)DM; i += 512u) { LAS float* L = (LAS float*)F.lds; const float* m2 = mb + 2 * DM; const float* m3 = mb + 3 * DM; const float* m4 = mb + 4 * DM;
                L[L1_G1P / 4 + i] = 1.f + m2[i]; L[L1_LNG / 4 + i] = p.ln1_g[i]; L[L1_LNB / 4 + i] = p.ln1_b[i]; L[L1_SC2P / 4 + i] = 1.f + m4[i]; L[L1_SH2 / 4 + i] = m3[i]; }
            __syncthreads(); }
        const int row0 = g0 * 128 + F.wave * 16;
#pragma unroll 1
        for (int pr = 0; pr < 8; ++pr) {
            f32x4 xa[2][8]; u32x4 ya[2][4];
#pragma unroll
            for (int r = 0; r < 2; ++r)
#pragma unroll
                for (int i = 0; i < 4; ++i) { const size_t o = (size_t)(row0 + 2 * pr + r) * DM + i * 512 + F.lane * 8;
                    xa[r][2 * i] = __builtin_nontemporal_load((const f32x4*)(p.x + o)); xa[r][2 * i + 1] = __builtin_nontemporal_load((const f32x4*)(p.x + o + 4)); ya[r][i] = *(const u32x4*)(y1 + o); }
#pragma unroll
            for (int r = 0; r < 2; ++r) {
                float v[32]; float s = 0.f;
#pragma unroll
                for (int i = 0; i < 4; ++i) { const int col = i * 512 + F.lane * 8; float yf[8]; unpack8(ya[r][i], yf);
                    const f32x4 ga = *(const LAS f32x4*)(F.lds + L1_G1P + col * 4), gb = *(const LAS f32x4*)(F.lds + L1_G1P + col * 4 + 16);
#pragma unroll
                    for (int e = 0; e < 4; ++e) { v[i * 8 + e] = ALPHA * xa[r][2 * i][e] + ga[e] * yf[e]; v[i * 8 + 4 + e] = ALPHA * xa[r][2 * i + 1][e] + gb[e] * yf[4 + e]; }
#pragma unroll
                    for (int e = 0; e < 8; ++e) s += v[i * 8 + e]; }
                const float mean = wave_sum(s) * (1.f / DM);
                float q = 0.f;
#pragma unroll
                for (int k = 0; k < 32; ++k) { const float d = v[k] - mean; q += d * d; }
                const float rstd = rsqrtf(wave_sum(q) * (1.f / DM) + LN_EPS);
#pragma unroll
                for (int i = 0; i < 4; ++i) { const int col = i * 512 + F.lane * 8; const size_t o = (size_t)(row0 + 2 * pr + r) * DM + col;
                    const f32x4 g0v = *(const LAS f32x4*)(F.lds + L1_LNG + col * 4), g1v = *(const LAS f32x4*)(F.lds + L1_LNG + col * 4 + 16), b0 = *(const LAS f32x4*)(F.lds + L1_LNB + col * 4), b1 = *(const LAS f32x4*)(F.lds + L1_LNB + col * 4 + 16);
                    const f32x4 c0 = *(const LAS f32x4*)(F.lds + L1_SC2P + col * 4), c1 = *(const LAS f32x4*)(F.lds + L1_SC2P + col * 4 + 16), s0 = *(const LAS f32x4*)(F.lds + L1_SH2 + col * 4), s1 = *(const LAS f32x4*)(F.lds + L1_SH2 + col * 4 + 16);
                    f32x4 o0, o1, h0, h1;
#pragma unroll
                    for (int e = 0; e < 4; ++e) { o0[e] = (v[i * 8 + e] - mean) * rstd * g0v[e] + b0[e]; o1[e] = (v[i * 8 + 4 + e] - mean) * rstd * g1v[e] + b1[e];
                        h0[e] = o0[e] * c0[e] + s0[e]; h1[e] = o1[e] * c1[e] + s1[e]; }
                    __builtin_nontemporal_store(pack8(o0, o1), (bf16x8*)(x1 + o));
                    *(bf16x8*)(h2 + o) = pack8(h0, h1); }
                __builtin_amdgcn_sched_barrier(0);
            }
        }
        VM0();
        f32x4 acc[3]; acc[0] = acc[1] = acc[2] = (f32x4){0.f, 0.f, 0.f, 0.f};
        const bf16_t* ar = h2 + (size_t)(row0 + fr) * DM + 8 * fq;
#pragma unroll 2
        for (int s_ = 0; s_ < 64; ++s_) {
            const bf16x8 a = *(const bf16x8*)(ar + 32 * s_);
            { float af[8]; unpack8(*reinterpret_cast<const u32x4*>(&a), af);
              *(u32x2*)(h2f8 + (unsigned)((row0 + fr) * DM + 32 * s_ + 8 * fq)) = (u32x2){pack_fp8x4(af[0], af[1], af[2], af[3]), pack_fp8x4(af[4], af[5], af[6], af[7])}; }
#pragma unroll
            for (int ct = 0; ct < 3; ++ct) { const bf16_t* bp = rw + (size_t)(16 * ct + fr) * DM + 32 * s_ + 8 * fq;
                acc[ct] = mfma16(a, *(const bf16x8*)bp, acc[ct]); acc[ct] = mfma16(a, *(const bf16x8*)(bp + 48 * DM), acc[ct]); }
        }
#pragma unroll
        for (int ct = 0; ct < 3; ++ct)
#pragma unroll
            for (int j = 0; j < 4; ++j) lg[(4 * fq + j) * 48 + 16 * ct + fr] = acc[ct][j];
        asm volatile("s_waitcnt lgkmcnt(0)" ::: "memory");
        if (F.lane < 16) {
            const int t = row0 + F.lane; const LAS float* l = lg + F.lane * 48;
            float gl[4];
#pragma unroll
            for (int g = 0; g < 4; ++g) gl[g] = l[g] + p.b_rg[g];
            float gm = gl[0]; int gi = 0;
#pragma unroll
            for (int g = 1; g < 4; ++g) if (gl[g] > gm) { gm = gl[g]; gi = g; }
            float gs = 0.f;
#pragma unroll
            for (int g = 0; g < 4; ++g) gs += __expf(gl[g] - gm);
            const float gw = 1.f / gs;
            float el[8];
#pragma unroll
            for (int e = 0; e < 8; ++e) el[e] = l[4 + 8 * gi + e] + p.b_re[8 * gi + e];
            float m0 = el[0]; int e0 = 0;
#pragma unroll
            for (int e = 1; e < 8; ++e) if (el[e] > m0) { m0 = el[e]; e0 = e; }
            float m1 = -__builtin_inff(); int e1 = 0;
#pragma unroll
            for (int e = 0; e < 8; ++e) if (e != e0 && el[e] > m1) { m1 = el[e]; e1 = e; }
            const float p1 = __expf(m1 - m0); const float w0 = gw / (1.f + p1), w1 = gw * p1 / (1.f + p1);
            const int x0 = 8 * gi + e0, x1i = 8 * gi + e1;
            const unsigned q0 = atomicAdd(cnt + x0, 1u), q1 = atomicAdd(cnt + x1i, 1u);
            rt_e[2 * t] = x0; rt_e[2 * t + 1] = x1i; rt_w[2 * t] = w0; rt_w[2 * t + 1] = w1; rt_pos[2 * t] = (int)q0; rt_pos[2 * t + 1] = (int)q1;
            elist[(unsigned)x0 * (unsigned)NTOK + q0] = t; elist[(unsigned)x1i * (unsigned)NTOK + q1] = t;
        }
    }
    __syncthreads();
}
__device__ __forceinline__ void slot_prefix(const Params& p, const Frame& F, LAS int* ps) {
    if (F.tid == 0) { const unsigned* cnt = (const unsigned*)(p.ws + WS_CTL) + CW_CNT; int run = 0;
        for (int e = 0; e < NEXP; ++e) { const int c = (int)__hip_atomic_load(cnt + e, __ATOMIC_RELAXED, __HIP_MEMORY_SCOPE_AGENT); ps[e] = run; ps[32 + e] = c; run += (c + 255) / 256 * 256; } ps[64] = run; }
}
constexpr int L2_G2P = 0, L2_LNG = 8192, L2_LNB = 16384, L2_PS = 24576;
__device__ __forceinline__ void p11_final(const Params& p, const Frame& F) {
    const float* mod = (const float*)(p.ws + WS_MOD); const bf16_t* x1 = (const bf16_t*)(p.ws + WS_X1); const unsigned char* yb = p.ws + WS_YB; const int* rt_e = (const int*)(p.ws + WS_RT + RT_E); const int* rt_pos = (const int*)(p.ws + WS_RT + RT_POS); const float* rt_w = (const float*)(p.ws + WS_RT + RT_W);
    LAS int* ps = (LAS int*)(F.lds + L2_PS);
    slot_prefix(p, F, ps);
    int bcur = -1;
    for (int g0 = F.bid; g0 < NTOK / 128; g0 += F.G) {
        const int b = (g0 * 128) / SEQ;
        if (b != bcur) { __syncthreads(); bcur = b; const float* mb = mod + (size_t)b * (6 * DM);
            for (unsigned i = (unsigned)F.tid; i < (unsigned)DM; i += 512u) { LAS float* L = (LAS float*)F.lds; const float* m5 = mb + 5 * DM; L[L2_G2P / 4 + i] = 1.f + m5[i]; L[L2_LNG / 4 + i] = p.ln2_g[i]; L[L2_LNB / 4 + i] = p.ln2_b[i]; }
            __syncthreads(); }
        const int row0 = g0 * 128 + F.wave * 16;
#pragma unroll 1
        for (int pr = 0; pr < 8; ++pr) {
            u32x4 xv[2][4]; u32x2 ya[2][4], yc[2][4]; float wa[2], wc[2];
#pragma unroll
            for (int r = 0; r < 2; ++r) { const int row = row0 + 2 * pr + r; const int sa = ps[rt_e[2 * row]] + rt_pos[2 * row], sb = ps[rt_e[2 * row + 1]] + rt_pos[2 * row + 1]; wa[r] = rt_w[2 * row] * Y8_INV; wc[r] = rt_w[2 * row + 1] * Y8_INV;
#pragma unroll
                for (int i = 0; i < 4; ++i) { const int col = i * 512 + F.lane * 8;
                    xv[r][i] = *(const u32x4*)(x1 + (size_t)row * DM + col); ya[r][i] = *(const u32x2*)(yb + (size_t)sa * DM + col); yc[r][i] = *(const u32x2*)(yb + (size_t)sb * DM + col); } }
#pragma unroll
            for (int r = 0; r < 2; ++r) { const int row = row0 + 2 * pr + r;
                float v[32]; float s = 0.f;
#pragma unroll
                for (int i = 0; i < 4; ++i) { const int col = i * 512 + F.lane * 8; float xf[8], yf[8], zf[8]; unpack8(xv[r][i], xf); unpack8_fp8(ya[r][i], yf); unpack8_fp8(yc[r][i], zf);
                    const f32x4 ga = *(const LAS f32x4*)(F.lds + L2_G2P + col * 4), gb = *(const LAS f32x4*)(F.lds + L2_G2P + col * 4 + 16);
#pragma unroll
                    for (int e = 0; e < 4; ++e) { v[i * 8 + e] = ALPHA * xf[e] + ga[e] * (wa[r] * yf[e] + wc[r] * zf[e]); v[i * 8 + 4 + e] = ALPHA * xf[4 + e] + gb[e] * (wa[r] * yf[4 + e] + wc[r] * zf[4 + e]); }
#pragma unroll
                    for (int e = 0; e < 8; ++e) s += v[i * 8 + e]; }
                const float mean = wave_sum(s) * (1.f / DM);
                float q = 0.f;
#pragma unroll
                for (int k = 0; k < 32; ++k) { const float d = v[k] - mean; q += d * d; }
                const float rstd = rsqrtf(wave_sum(q) * (1.f / DM) + LN_EPS);
#pragma unroll
                for (int i = 0; i < 4; ++i) { const int col = i * 512 + F.lane * 8;
                    const f32x4 g0v = *(const LAS f32x4*)(F.lds + L2_LNG + col * 4), g1v = *(const LAS f32x4*)(F.lds + L2_LNG + col * 4 + 16), b0 = *(const LAS f32x4*)(F.lds + L2_LNB + col * 4), b1 = *(const LAS f32x4*)(F.lds + L2_LNB + col * 4 + 16);
                    f32x4 o0, o1;
#pragma unroll
                    for (int e = 0; e < 4; ++e) { o0[e] = (v[i * 8 + e] - mean) * rstd * g0v[e] + b0[e]; o1[e] = (v[i * 8 + 4 + e] - mean) * rstd * g1v[e] + b1[e]; }
                    __builtin_nontemporal_store(o0, (f32x4*)(p.out + (size_t)row * DM + col)); __builtin_nontemporal_store(o1, (f32x4*)(p.out + (size_t)row * DM + col + 4)); }
                __builtin_amdgcn_sched_barrier(0);
            }
        }
    }
    __syncthreads();
}

typedef const __attribute__((address_space(4))) Params* kparams_t;
__device__ __forceinline__ Params load_params() {
#if defined(__HIP_DEVICE_COMPILE__)
    kparams_t pp = (kparams_t)__builtin_amdgcn_kernarg_segment_ptr(); asm volatile("" : "+s"(pp)); return *pp;
#else
    return Params{};
#endif
}
__device__ __forceinline__ Frame make_frame(unsigned char* lds_raw, int wv) {
    Frame F; F.lds = (LAS unsigned char*)lds_raw; F.lane = lane_id(); F.wave = wv; F.tid = wv * 64 + F.lane; F.G = gridDim.x; F.bid = blockIdx.x; return F;
}
constexpr int MOE_TL = 320, MOE_GI = 448;
template <bool TOK> __device__ __forceinline__ LAS int* moe_tables(const Params& p, const Frame& F, int& ntiles, int ntl) {
    LAS int* tl = (LAS int*)(F.lds + pg8::STAGE_BYTES); LAS int* ps = tl + MOE_TL;
    slot_prefix(p, F, ps);
    __syncthreads();
    ntiles = ps[64] / 256;
    for (int i = F.tid; i < ntiles; i += 512) { int e = 0;
#pragma unroll 1
        for (int x = 1; x < NEXP; ++x) if (ps[x] <= 256 * i) e = x;
        tl[i] = e; }
    __syncthreads();
    if constexpr (TOK) { const int* elist = (const int*)(p.ws + WS_ELIST);
        for (int u = 0; u < 24; ++u) { const int L = u * F.G + F.bid; if (L >= ntiles * ntl) break;
            if (F.tid < 256) { const int t = L / ntl, e = tl[t], pos = 256 * t - ps[e] + F.tid; tl[MOE_GI + u * 256 + F.tid] = pos < ps[32 + e] ? elist[(unsigned)e * (unsigned)NTOK + (unsigned)pos] : 0; } }
        __syncthreads(); }
    return tl;
}
template <unsigned MASK> __global__ void __launch_bounds__(512, 2) fwd(Params p_unused) {
    extern __shared__ __attribute__((aligned(16))) unsigned char lds_raw[];
    volatile LAS unsigned* misc = (volatile LAS unsigned*)((LAS unsigned char*)lds_raw + LDS_MISC);
    const int wv = __builtin_amdgcn_readfirstlane((int)threadIdx.x >> 6);
    __builtin_assume(wv >= 0 && wv < 8);
    if (wv == 0) misc[lane_id()] = 0u;
    __syncthreads();
    int lo, hi; unsigned* barw;
    { const Params p = load_params(); lo = p.ph_lo; hi = p.ph_hi; barw = (unsigned*)(p.ws + WS_CTL); }
    XcdBarrier bar; bar.bar = barw; bar.x = 0; bar.st = misc;
    bar.wv = wv;
    if (hi - lo > 1) bar = xcd_barrier_post(barw, misc, wv);
#define IN(k) (((MASK >> (k)) & 1u) && lo <= (k) && (k) < hi)
#define SEAM(k) do { if (IN(k) && IN((k) + 1)) xcd_barrier(bar); } while (0)
#ifndef PROBE_REP
#define PROBE_REP 0u
#endif
#define PHASE(k, ...) if (IN(k)) __VA_ARGS__ if (((PROBE_REP >> (k)) & 1u) && IN(k)) { xcd_barrier(bar); __VA_ARGS__ } SEAM(k);
    PHASE(0, { const Params p = load_params(); const Frame F = make_frame(lds_raw, wv); p0_prologue(p, F); })
    PHASE(1, { const Params p = load_params(); const Frame F = make_frame(lds_raw, wv); p1_hpass(p, F); })
    PHASE(2, { const Params p = load_params(); const Frame F = make_frame(lds_raw, wv); pg8::Gemm g{(const bf16_t*)(p.ws + WS_HBUF), (const bf16_t*)(p.ws + WS_WIN), NTOK, LDP, DM}; pg8::StaticOrder S; S.init(NTOK, LDP, F.G, F.bid);
        pg8::EpiBf16T<true> E{(bf16_t*)(p.ws + WS_PROJ), LDP}; pg8::gemm_phase<pg8::EpiBf16T<true>, pg8::StaticOrder, false>(F.lds, g, S, E, nullptr, F.wave); })
    PHASE(3, { const Params p = load_params(); const Frame F = make_frame(lds_raw, wv); p3_dnprep(p, F); })
    PHASE(4, { const Params p = load_params(); const Frame F = make_frame(lds_raw, wv); if (F.bid < 64) scan_unit(p, F, F.bid); else if (F.bid < 64 + CVT_WGS) moe_weight_tiles(p, F, F.bid - 64, CVT_WGS);
        p4_attention(p, F, (char*)lds_raw); })
    PHASE(6, { const Params p = load_params(); const Frame F = make_frame(lds_raw, wv); pg8::Gemm g{(const bf16_t*)(p.ws + WS_HBUF), (const bf16_t*)(p.ws + WS_WOUT), NTOK, DM, DM}; pg8::StaticOrder S; S.init(NTOK, DM, F.G, F.bid);
        pg8::EpiBf16 E{(bf16_t*)(p.ws + WS_Y1), DM}; pg8::gemm_phase<pg8::EpiBf16, pg8::StaticOrder, false>(F.lds, g, S, E, nullptr, F.wave); })
    PHASE(7, { const Params p = load_params(); const Frame F = make_frame(lds_raw, wv); p6_ln1_router(p, F); })
    PHASE(10, { const Params p = load_params(); const Frame F = make_frame(lds_raw, wv); int ntiles;
        LAS int* tl = moe_tables<true>(p, F, ntiles, 4);
        pg8::Gemm g{(const bf16_t*)(p.ws + WS_H2F8), (const bf16_t*)((const unsigned char*)p.out + OUT_W1), 0, 0, DM / 2};
        pg8::MoeOrder S{tl, ntiles, 4, F.G, F.bid};
        pg8::EpiSwiglu E{p.ws + WS_HID}; pg8::gemm_phase<pg8::EpiSwiglu, pg8::MoeOrder, true, true>(F.lds, g, S, E, tl + MOE_GI, F.wave); })
    PHASE(11, { const Params p = load_params(); const Frame F = make_frame(lds_raw, wv); int ntiles;
        LAS int* tl = moe_tables<false>(p, F, ntiles, 8);
        pg8::Gemm g{(const bf16_t*)(p.ws + WS_HID), (const bf16_t*)((const unsigned char*)p.out + OUT_W2), 0, 0, DEXP / 2};
        pg8::MoeOrder S{tl, ntiles, 8, F.G, F.bid};
        pg8::EpiY8 E{p.ws + WS_YB}; pg8::gemm_phase<pg8::EpiY8, pg8::MoeOrder, false, true>(F.lds, g, S, E, nullptr, F.wave); })
    PHASE(12, { const Params p = load_params(); const Frame F = make_frame(lds_raw, wv); p11_final(p, F); })
#undef IN
#undef SEAM
#undef PHASE
}

typedef void (*kern_t)(Params);
template <int K> struct PhaseTab { static void fill(kern_t* t) { t[K] = fwd<(1u << K)>; PhaseTab<K - 1>::fill(t); } };
template <> struct PhaseTab<-1> { static void fill(kern_t*) {} };
extern "C" void kernel_launch(void* const* d_in, const int* in_sizes, int n_in, void* d_out, int out_size, void* d_ws, size_t ws_size, hipStream_t stream) {
    static int grid = 0; static kern_t tab[NPHASE + 1];
    if (grid == 0) {
        if (n_in != 22 || out_size != NTOK * DM || ws_size < WS_END) { fprintf(stderr, "kernel_launch: unexpected shapes (n_in %d, out %d, ws %zu)\n", n_in, out_size, ws_size); grid = -1; return; }
        int dev = 0, cus = 0, per_cu = 0;
        if (hipGetDevice(&dev) != hipSuccess || hipDeviceGetAttribute(&cus, hipDeviceAttributeMultiprocessorCount, dev) != hipSuccess) { grid = -1; return; }
#if MK_ONE_LAUNCH
        tab[NPHASE] = fwd<0xffffu>;
        const int k0 = NPHASE, k1 = NPHASE + 1;
#else
        PhaseTab<NPHASE - 1>::fill(tab);
        const int k0 = 0, k1 = NPHASE;
#endif
        for (int k = k0; k < k1; ++k) {
            if (hipFuncSetAttribute((const void*)tab[k], hipFuncAttributeMaxDynamicSharedMemorySize, LDS_BYTES) != hipSuccess) { fprintf(stderr, "kernel_launch: hipFuncSetAttribute failed\n"); grid = -1; return; }
            if (hipOccupancyMaxActiveBlocksPerMultiprocessor(&per_cu, (const void*)tab[k], 512, LDS_BYTES) != hipSuccess || per_cu < 1) { fprintf(stderr, "kernel_launch: occupancy query says %d\n", per_cu); (void)hipGetLastError(); }
        }
        grid = cus;
        if (grid < 128) { fprintf(stderr, "kernel_launch: built for a 256-CU device (got %d CUs)\n", cus); grid = -1; return; }
    }
    if (grid < 0) return;
    (void)hipMemsetAsync((char*)d_ws + WS_CTL, 0, CTL_BYTES, stream);
    Params p{};
    p.x = (const float*)d_in[0]; p.c = (const float*)d_in[1]; p.w_ada = (const float*)d_in[2]; p.b_ada = (const float*)d_in[3]; p.w_in = (const float*)d_in[4]; p.conv_w = (const float*)d_in[5];
    p.a_log = (const float*)d_in[6]; p.dt_bias = (const float*)d_in[7]; p.norm_w = (const float*)d_in[8]; p.f_bias = (const float*)d_in[9]; p.w_out = (const float*)d_in[10];
    p.ln1_g = (const float*)d_in[11]; p.ln1_b = (const float*)d_in[12]; p.w_rg = (const float*)d_in[13]; p.b_rg = (const float*)d_in[14]; p.w_re = (const float*)d_in[15]; p.b_re = (const float*)d_in[16];
    p.w_gate = (const float*)d_in[17]; p.w_up = (const float*)d_in[18]; p.w_down = (const float*)d_in[19]; p.ln2_g = (const float*)d_in[20]; p.ln2_b = (const float*)d_in[21];
    p.out = (float*)d_out; p.ws = (unsigned char*)d_ws;
#if MK_ONE_LAUNCH
    p.ph_lo = 0; p.ph_hi = NPHASE;
    hipLaunchKernelGGL(tab[NPHASE], dim3(grid), dim3(512), LDS_BYTES, stream, p);
#else
    for (int k = 0; k < NPHASE; ++k) { p.ph_lo = k; p.ph_hi = k + 1; hipLaunchKernelGGL(tab[k], dim3(grid), dim3(512), LDS_BYTES, stream, p); }
#endif
}
```

```cpp
#include <hip/hip_runtime.h>
#include <cstdio>
#include <cstdint>

#ifndef MK_ONE_LAUNCH
#define MK_ONE_LAUNCH 1
#endif

#define LAS __attribute__((address_space(3)))
typedef unsigned short bf16_t;
typedef short bf16x8 __attribute__((ext_vector_type(8)));
typedef short s16x4 __attribute__((ext_vector_type(4)));
typedef float f32x4 __attribute__((ext_vector_type(4)));
typedef float f32x2 __attribute__((ext_vector_type(2)));
typedef float f32x16 __attribute__((ext_vector_type(16)));
typedef unsigned u32x4 __attribute__((ext_vector_type(4)));
typedef unsigned u32x2 __attribute__((ext_vector_type(2)));

constexpr int NB = 8, SEQ = 4096, DM = 2048, NTOK = NB * SEQ;
constexpr int NH = 8, HD = 128;
constexpr int LDP = 7168;
constexpr int PQ = 0, PK = 1024, PV = 2048, PZ = 3072, FQ = 4096, FK = 5120, FV = 6144;
constexpr int WIN_LD = 7192;
constexpr int NEXP = 32, DEXP = 512, PMAX = 2 * NTOK + NEXP * 256;
constexpr float LN_EPS = 1e-5f, NORM_EPS = 1e-6f;
constexpr float ALPHA = 1.189207115002721f;
constexpr float QSCALE = 0.08838834764831845f;
constexpr int NPHASE = 13;

constexpr size_t WS_CTL   = 0;
constexpr size_t CTL_BYTES = 65536;
constexpr int CW_CNT = 4096, CW_QUEUE = 5120, CW_NTILES = 6144, CW_TILE_E = 7168, CW_QKMAX = 8192;
constexpr size_t WS_MOD   = 65536;
constexpr size_t WS_SMALLW= WS_MOD + 393216;
constexpr size_t WS_RTW   = WS_SMALLW + 131072;
constexpr size_t WS_WOUT  = WS_RTW + 393216;
constexpr size_t WS_WIN   = WS_WOUT + 8388608;
constexpr size_t WS_SM    = WS_WIN + 29360128;
constexpr size_t WS_FCUM  = WS_SM + 4194304;
constexpr size_t WS_HBUF  = WS_FCUM + 1048576;
constexpr size_t WS_PROJ  = WS_HBUF + 134217728;
constexpr size_t WS_DN    = WS_PROJ + 469762048;
constexpr int DN_W = 0, DN_KT = 17408, DN_Q = 35840, DN_QK = 53248, DN_UT = 62464, DN_MISC = 78848, DN_CHUNK = 79104;
constexpr size_t WS_RT    = WS_DN + (size_t)4096 * DN_CHUNK;
constexpr size_t RT_E = 0, RT_W = 262144, RT_POS = 524288, RT_SLOT = 786432, RT_TOK = 1048576, RT_WB = 1048576 + 294912;
constexpr size_t WS_ELIST = WS_RT + 1048576 + 2 * 294912;
constexpr size_t WS_END   = WS_ELIST + (size_t)NEXP * NTOK * 4;
constexpr size_t WS_H2    = WS_PROJ;
constexpr size_t WS_X1    = WS_H2 + 134217728;
constexpr size_t WS_H2F8  = WS_X1 + 134217728;
constexpr size_t WS_HID   = WS_X1 + 268435456;
constexpr size_t WS_YB    = WS_HID + (size_t)PMAX * 512 * 2;
constexpr size_t WS_Y1    = WS_YB;
static_assert(WS_YB + (size_t)PMAX * 2048 * 2 <= WS_RT, "overlay");
static_assert(WS_END <= (size_t)1 << 30, "workspace");
constexpr size_t OUT_W1 = 0;
constexpr size_t OUT_W2 = 134217728;
constexpr float Y8_SCALE = 16.f, Y8_INV = 1.f / 16.f;
constexpr float W2_SCALE = 32.f, HID_SCALE = 8.f, Y2_INV = 1.f / (32.f * 8.f), W1_SCALE = 32.f, W1_INV = 1.f / 32.f;

constexpr int LDS_BYTES = 160 * 1024 - 512;
constexpr int LDS_MISC = LDS_BYTES - 256;

struct Params {
    const float* x; const float* c; const float* w_ada; const float* b_ada; const float* w_in; const float* conv_w; const float* a_log; const float* dt_bias;
    const float* norm_w; const float* f_bias; const float* w_out; const float* ln1_g; const float* ln1_b; const float* w_rg; const float* b_rg; const float* w_re;
    const float* b_re; const float* w_gate; const float* w_up; const float* w_down; const float* ln2_g; const float* ln2_b;
    float* out; unsigned char* ws; int ph_lo, ph_hi;
};

typedef __bf16 bf16v2 __attribute__((ext_vector_type(2)));
__device__ __forceinline__ unsigned cvtpk(float lo, float hi) { bf16v2 v; v[0] = (__bf16)lo; v[1] = (__bf16)hi; return __builtin_bit_cast(unsigned, v); }
__device__ __forceinline__ float bflo(unsigned w) { return __uint_as_float(w << 16); }
__device__ __forceinline__ float bfhi(unsigned w) { return __uint_as_float(w & 0xffff0000u); }
__device__ __forceinline__ float bf1(bf16_t h) { return __uint_as_float(((unsigned)h) << 16); }
__device__ __forceinline__ bf16_t f2bf(float f) { return (bf16_t)(cvtpk(f, 0.f) & 0xffffu); }
__device__ __forceinline__ float silu_f(float x) { return x * __builtin_amdgcn_rcpf(1.f + __expf(-x)); }
__device__ __forceinline__ f32x4 mfma16(bf16x8 a, bf16x8 b, f32x4 c) { return __builtin_amdgcn_mfma_f32_16x16x32_bf16(a, b, c, 0, 0, 0); }
__device__ __forceinline__ u32x2 pack4(f32x4 v) { u32x2 r; r.x = cvtpk(v[0], v[1]); r.y = cvtpk(v[2], v[3]); return r; }
__device__ __forceinline__ bf16x8 pack8(f32x4 a, f32x4 b) { u32x4 w = {cvtpk(a[0], a[1]), cvtpk(a[2], a[3]), cvtpk(b[0], b[1]), cvtpk(b[2], b[3])}; return *reinterpret_cast<bf16x8*>(&w); }
__device__ __forceinline__ void unpack8(u32x4 w, float* f) { f[0] = bflo(w.x); f[1] = bfhi(w.x); f[2] = bflo(w.y); f[3] = bfhi(w.y); f[4] = bflo(w.z); f[5] = bfhi(w.z); f[6] = bflo(w.w); f[7] = bfhi(w.w); }
typedef int i32x8 __attribute__((ext_vector_type(8)));
typedef int i32x4 __attribute__((ext_vector_type(4)));
typedef float f32x2_t __attribute__((ext_vector_type(2)));
__device__ __forceinline__ void unpack8_fp8(u32x2 w, float* f) { const f32x2_t a = __builtin_amdgcn_cvt_pk_f32_fp8((int)w.x, false), b = __builtin_amdgcn_cvt_pk_f32_fp8((int)w.x, true), c = __builtin_amdgcn_cvt_pk_f32_fp8((int)w.y, false), d = __builtin_amdgcn_cvt_pk_f32_fp8((int)w.y, true);
    f[0] = a[0]; f[1] = a[1]; f[2] = b[0]; f[3] = b[1]; f[4] = c[0]; f[5] = c[1]; f[6] = d[0]; f[7] = d[1]; }
__device__ __forceinline__ unsigned pack_fp8x4(float a, float b, float c, float d) { int w = __builtin_amdgcn_cvt_pk_fp8_f32(a, b, 0, false); w = __builtin_amdgcn_cvt_pk_fp8_f32(c, d, w, true); return (unsigned)w; }
__device__ __forceinline__ float wave_sum(float v) {
#pragma unroll
    for (int o = 32; o >= 1; o >>= 1) v += __shfl_xor(v, o);
    return v;
}
#define TRRD(dst, addr, off) asm volatile("ds_read_b64_tr_b16 %0, %1 offset:%2" : "=&v"(dst) : "v"(addr), "i"(off) : "memory")
#define LGKM0() do { asm volatile("s_waitcnt lgkmcnt(0)" ::: "memory"); __builtin_amdgcn_sched_barrier(0); } while (0)
#define VM0() asm volatile("s_waitcnt vmcnt(0)" ::: "memory")
__device__ __forceinline__ bf16x8 join8(s16x4 l, s16x4 h) { return (bf16x8){l[0], l[1], l[2], l[3], h[0], h[1], h[2], h[3]}; }

__device__ __forceinline__ int lane_id() { int l; asm volatile("v_mbcnt_lo_u32_b32 %0, -1, 0\n\tv_mbcnt_hi_u32_b32 %0, -1, %0" : "=v"(l)); __builtin_assume(l >= 0 && l < 64); return l; }
#define TID(wv) ((wv) * 64 + lane_id())
#define XB_TMO      128
#define XB_XCNT(j)  (256  + 64 * (j))
#define XB_XSUB(j)  (1280 + 64 * (j))
#define XB_XGEN(j)  (2304 + 64 * (j))
#define XB_TOP      3328
#define XB_TOPGEN   3392
#define XCD_BAR_WORDS 3456
#define XB_SPIN_CAP (1u << 18)
__device__ __forceinline__ unsigned xb_ld(unsigned* p)              { return __hip_atomic_load(p, __ATOMIC_RELAXED, __HIP_MEMORY_SCOPE_AGENT); }
__device__ __forceinline__ unsigned xb_add(unsigned* p, unsigned v) { return __hip_atomic_fetch_add(p, v, __ATOMIC_RELAXED, __HIP_MEMORY_SCOPE_AGENT); }
__device__ __forceinline__ unsigned xb_xcc_id() { return (unsigned)__builtin_amdgcn_s_getreg((3 << 11) | 20) & 0xFu; }
#define XB_SPIN(cond, bar) do { unsigned _sp = 0; while (cond) { __builtin_amdgcn_s_sleep(1); \
    if ((++_sp & 255u) == 0u) { if (xb_ld(&(bar)[XB_TMO])) break; if (_sp > XB_SPIN_CAP) { atomicAdd(&(bar)[XB_TMO], 1u); break; } } } } while (0)
struct XcdBarrier { unsigned* bar; unsigned x; volatile LAS unsigned* st; int wv; };
__device__ __forceinline__ XcdBarrier xcd_barrier_post(unsigned* bar, volatile LAS unsigned* st, int wv) {
    XcdBarrier b; b.bar = bar; b.x = xb_xcc_id(); b.st = st; b.wv = wv;
    if (TID(wv) == 0) (void)xb_add(&bar[XB_XCNT(b.x)], 1u);
    return b;
}
__device__ __forceinline__ void xcd_barrier_complete(unsigned* bar, unsigned x, unsigned& nloc, unsigned& nx) {
    const unsigned G = gridDim.x * gridDim.y * gridDim.z;
    unsigned sum, cnt, mine, sp = 0u;
    for (;;) {
        sum = 0u; cnt = 0u; mine = 0u;
#pragma unroll
        for (unsigned j = 0; j < 16; ++j) { const unsigned c = xb_ld(&bar[XB_XCNT(j)]); sum += c; cnt += (c > 0u) ? 1u : 0u; mine = (j == x) ? c : mine; }
        if (sum == G) break;
        __builtin_amdgcn_s_sleep(1);
        if ((++sp & 255u) == 0u) { if (xb_ld(&bar[XB_TMO])) break; if (sp > XB_SPIN_CAP) { atomicAdd(&bar[XB_TMO], 1u); break; } }
    }
    nloc = mine > 0u ? mine : 1u; nx = cnt > 0u ? cnt : 1u;
}
__device__ __forceinline__ void xcd_barrier(const XcdBarrier& b) {
    asm volatile("s_waitcnt vmcnt(0)" ::: "memory");
    __syncthreads();
    if (TID(b.wv) == 0) {
        unsigned* bar = b.bar;
        __builtin_amdgcn_s_waitcnt(0);
        unsigned nloc = b.st[0], nx = b.st[1];
        if (nloc == 0u) { xcd_barrier_complete(bar, b.x, nloc, nx); b.st[0] = nloc; b.st[1] = nx; }
        const unsigned old = xb_add(&bar[XB_XSUB(b.x)], 1u);
        const unsigned gen = old / nloc;
        if (old + 1u == (gen + 1u) * nloc) {
            __builtin_amdgcn_fence(__ATOMIC_RELEASE, "agent");
            asm volatile("s_waitcnt vmcnt(0)" ::: "memory");
            const unsigned og = xb_add(&bar[XB_TOP], 1u);
            const unsigned tg = og / nx;
            if (og + 1u == (tg + 1u) * nx) xb_add(&bar[XB_TOPGEN], 1u);
            else XB_SPIN(xb_ld(&bar[XB_TOPGEN]) == tg, bar);
            __builtin_amdgcn_fence(__ATOMIC_ACQUIRE, "agent");
            xb_add(&bar[XB_XGEN(b.x)], 1u);
            asm volatile("s_waitcnt vmcnt(0)" ::: "memory");
        } else {
            XB_SPIN(xb_ld(&bar[XB_XGEN(b.x)]) == gen, bar);
            __builtin_amdgcn_fence(__ATOMIC_ACQUIRE, "agent");
            asm volatile("s_waitcnt vmcnt(0)" ::: "memory");
        }
    }
    __syncthreads();
}

namespace pg8 {
constexpr int BM = 256, BK = 64, HALF = 128, HTB = HALF * BK * 2, STAGE_BYTES = 8 * HTB, NXCD = 8, WGM = 8;
__host__ __device__ __forceinline__ int lds_byte(int r, int c) { const int st = (r >> 4) * 2 + (c >> 5), rr = r & 15, cc = c & 31, ob = rr * 64 + cc * 2; return st * 1024 + (ob ^ (((ob >> 9) & 1) << 5)); }
__host__ __device__ __forceinline__ void stage_rc(int b, int& R, int& C) { const int st = b / 1024, sb = b % 1024, swz = sb ^ (((sb >> 9) & 1) << 5); R = (st >> 1) * 16 + swz / 64; C = (st & 1) * 32 + (swz % 64) / 2; }
__host__ __device__ __forceinline__ int perm32(int rho) { const int n = rho >> 4, i = rho & 15; return 8 * (i >> 2) + 4 * n + (i & 3); }
struct Unit { int pm, pn; };
struct Gemm { const bf16_t* A; const bf16_t* Bt; int M, N, K; };
struct StaticOrder {
    int nM, nN, nwg, G, c;
    __device__ void init(int M, int N, int G_, int c_) { nM = M / BM; nN = N / BM; nwg = nM * nN; G = G_; c = c_; }
    __device__ bool next(int i, Unit& u) const {
        const long L = (long)i * G + c; if (L >= nwg) return false;
        int wgid = (int)L; { const int q = nwg / NXCD, r = nwg % NXCD, xcd = wgid % NXCD, off = wgid / NXCD; wgid = (xcd < r ? xcd * (q + 1) : r * (q + 1) + (xcd - r) * q) + off; }
        const int nig = WGM * nN, gid = wgid / nig, fm = gid * WGM, gsz = (nM - fm) < WGM ? (nM - fm) : WGM;
        u.pm = fm + ((wgid % nig) % gsz); u.pn = (wgid % nig) / gsz; return true;
    }
};
struct MoeOrder {
    const LAS int* tile_e; int ntiles, ntl, G, c;
    __device__ bool next(int i, Unit& u) const {
        const long L = (long)i * G + c; if (L >= (long)ntiles * ntl) return false;
        const int t = (int)(L / ntl), j = (int)(L % ntl); u.pm = t; u.pn = tile_e[t] * ntl + j; return true;
    }
};
template <bool NT> struct EpiBf16T {
    static constexpr bool PERM = true; static constexpr int NST = 16;
    bf16_t* O; int ldc;
    __device__ __forceinline__ void operator()(const f32x4 (&acc)[2][2][4][2], const Unit& u, int wr, int wc, int fr, int fq) const {
        const int row0 = u.pm * BM + wr * 64 + fr, col0 = u.pn * BM + wc * 32 + 8 * fq;
#pragma unroll
        for (int ai = 0; ai < 2; ++ai)
#pragma unroll
            for (int m = 0; m < 4; ++m) { bf16_t* rowp = O + (size_t)(row0 + ai * HALF + m * 16) * ldc + col0;
#pragma unroll
                for (int bj = 0; bj < 2; ++bj) { const f32x4 v0 = acc[ai][bj][m][0], v1 = acc[ai][bj][m][1];
                    u32x4 w; w.x = cvtpk(v0[0], v0[1]); w.y = cvtpk(v0[2], v0[3]); w.z = cvtpk(v1[0], v1[1]); w.w = cvtpk(v1[2], v1[3]);
                    if constexpr (NT) __builtin_nontemporal_store(w, (u32x4*)(rowp + bj * HALF)); else *(u32x4*)(rowp + bj * HALF) = w; } }
    }
};
typedef EpiBf16T<false> EpiBf16;
struct EpiSwiglu {
    static constexpr bool PERM = true; static constexpr int NST = 8;
    unsigned char* O;
    __device__ __forceinline__ void operator()(const f32x4 (&acc)[2][2][4][2], const Unit& u, int wr, int wc, int fr, int fq) const {
        const int row0 = u.pm * BM + wr * 64 + fr, col0 = (u.pn & 3) * 128 + wc * 32 + 8 * fq;
#pragma unroll
        for (int ai = 0; ai < 2; ++ai)
#pragma unroll
            for (int m = 0; m < 4; ++m) { unsigned char* rowp = O + (size_t)(row0 + ai * HALF + m * 16) * DEXP + col0;
                float h[8];
#pragma unroll
                for (int n = 0; n < 2; ++n)
#pragma unroll
                    for (int j = 0; j < 4; ++j) { const float g = acc[ai][0][m][n][j] * W1_INV, up = acc[ai][1][m][n][j] * (W1_INV * HID_SCALE); h[n * 4 + j] = g * __builtin_amdgcn_rcpf(1.f + __expf(-g)) * up; }
                *(u32x2*)rowp = (u32x2){pack_fp8x4(h[0], h[1], h[2], h[3]), pack_fp8x4(h[4], h[5], h[6], h[7])}; }
    }
};
struct EpiY8 {
    static constexpr bool PERM = true, BJ8 = true; static constexpr int NST = 8;
    unsigned char* O;
    __device__ __forceinline__ void operator()(const f32x4 (&acc)[2][2][4][2], const Unit& u, int wr, int wc, int fr, int fq) const {
        const int row0 = u.pm * BM + wr * 64 + fr, col0 = (u.pn & 7) * BM + wc * 64 + 16 * fq;
#pragma unroll
        for (int ai = 0; ai < 2; ++ai)
#pragma unroll
            for (int m = 0; m < 4; ++m) { unsigned char* rowp = O + (size_t)(row0 + ai * HALF + m * 16) * DM + col0;
                u32x4 w;
#pragma unroll
                for (int bj = 0; bj < 2; ++bj)
#pragma unroll
                    for (int n = 0; n < 2; ++n) { f32x4 v = acc[ai][bj][m][n] * (Y2_INV * Y8_SCALE);
#pragma unroll
                        for (int e = 0; e < 4; ++e) v[e] = __builtin_amdgcn_fmed3f(v[e], -448.f, 448.f);
                        w[bj * 2 + n] = pack_fp8x4(v[0], v[1], v[2], v[3]); }
                *(u32x4*)rowp = w; }
    }
};

template <class E, class = void> struct EpiBj8 { static constexpr bool value = false; };
template <class E> struct EpiBj8<E, decltype((void)E::BJ8)> { static constexpr bool value = E::BJ8; };
template <class Epi, class Sched, bool GATHER, bool FP8 = false>
__device__ __forceinline__ void gemm_phase(LAS unsigned char* lds, const Gemm g, const Sched& S, const Epi& E, const LAS int* gidx, int wv) {
    const int wid = wv, lane = lane_id(), tid = wid * 64 + lane, wr = wid >> 2, wc = wid & 3, fr = lane & 15, fq = lane >> 4;
    const int K = g.K, nt = K / BK;
    unsigned voffA[2], voffB[2]; int RA[2], CA[2];
#pragma unroll
    for (int i = 0; i < 2; ++i) { int R, C; stage_rc(tid * 16 + i * 8192, R, C); const int Rb = EpiBj8<Epi>::value ? (64 * (R >> 5) + 16 * ((R & 15) >> 2) + 4 * ((R >> 4) & 1) + (R & 3)) : Epi::PERM ? ((R & ~31) + perm32(R & 31)) : R;
        voffA[i] = (unsigned)(R * K + C) * 2u; voffB[i] = (unsigned)(Rb * K + C) * 2u; RA[i] = R; CA[i] = C; }
    const size_t kstep = (size_t)(BK * 2);
    const size_t hstep = (size_t)HALF * K * 2;
    const size_t tstep = 2 * hstep;
    const size_t bstep = EpiBj8<Epi>::value ? (size_t)8 * K * 2 : hstep;
    const unsigned ldsw = (unsigned)wid * 1024u;
    const int aoff = lds_byte(wr * 64 + fr, fq * 8), boff = lds_byte(wc * 32 + fr, fq * 8);
    const int c8 = 32 * (fq >> 1) + 16 * (fq & 1);
    const int aoff8[2] = {lds_byte(wr * 64 + fr, c8), lds_byte(wr * 64 + fr, c8 + 8)}, boff8[2] = {lds_byte(wc * 32 + fr, c8), lds_byte(wc * 32 + fr, c8 + 8)};
#define PG8_SA(b, h) (((b) * 2 + (h)) * HTB)
#define PG8_SB(b, h) ((4 + (b) * 2 + (h)) * HTB)
#define PG8_STAGE(bufoff, gbase, voff) do { _Pragma("unroll") for (int _i = 0; _i < 2; ++_i) \
        __builtin_amdgcn_global_load_lds((const unsigned*)((const char*)(gbase) + (voff)[_i]), (LAS unsigned*)(lds + (bufoff) + ldsw + _i * 8192), 16, 0, 0); } while (0)
#define PG8_STAGE_A(bufoff, kbase, ubase, h, gv) do { if constexpr (GATHER) { PG8_STAGE(bufoff, kbase, gv[h]); } else { PG8_STAGE(bufoff, (ubase) + (h) * hstep, voffA); } } while (0)
#define PG8_LDA(dst, b, h) do { if constexpr (FP8) { _Pragma("unroll") for (int m = 0; m < 4; ++m) { const i32x4 lo_ = *(const LAS i32x4*)(lds + PG8_SA(b, h) + aoff8[0] + m * 2048), hi_ = *(const LAS i32x4*)(lds + PG8_SA(b, h) + aoff8[1] + m * 2048); dst##8[m] = __builtin_shufflevector(lo_, hi_, 0, 1, 2, 3, 4, 5, 6, 7); } } \
        else { _Pragma("unroll") for (int m = 0; m < 4; ++m) _Pragma("unroll") for (int k = 0; k < 2; ++k) dst[m][k] = *(const LAS bf16x8*)(lds + PG8_SA(b, h) + aoff + m * 2048 + k * 1024); } } while (0)
#define PG8_LDB(dst, b, h) do { if constexpr (FP8) { _Pragma("unroll") for (int n = 0; n < 2; ++n) { const i32x4 lo_ = *(const LAS i32x4*)(lds + PG8_SB(b, h) + boff8[0] + n * 2048), hi_ = *(const LAS i32x4*)(lds + PG8_SB(b, h) + boff8[1] + n * 2048); dst##8[n] = __builtin_shufflevector(lo_, hi_, 0, 1, 2, 3, 4, 5, 6, 7); } } \
        else { _Pragma("unroll") for (int n = 0; n < 2; ++n) _Pragma("unroll") for (int k = 0; k < 2; ++k) dst[n][k] = *(const LAS bf16x8*)(lds + PG8_SB(b, h) + boff + n * 2048 + k * 1024); } } while (0)
#define PG8_MMA(ai, bj, At, Bt) do { __builtin_amdgcn_s_setprio(1); \
        if constexpr (FP8) { _Pragma("unroll") for (int m = 0; m < 4; ++m) _Pragma("unroll") for (int n = 0; n < 2; ++n) \
            asm volatile("s_nop 1\n\tv_mfma_f32_16x16x128_f8f6f4 %0, %1, %2, %0" : "+v"(acc[ai][bj][m][n]) : "v"(Bt##8[n]), "v"(At##8[m])); }     \
        else { _Pragma("unroll") for (int m = 0; m < 4; ++m) _Pragma("unroll") for (int n = 0; n < 2; ++n) _Pragma("unroll") for (int k = 0; k < 2; ++k) \
            acc[ai][bj][m][n] = __builtin_amdgcn_mfma_f32_16x16x32_bf16(Bt[n][k], At[m][k], acc[ai][bj][m][n], 0, 0, 0); } \
        __builtin_amdgcn_s_setprio(0); } while (0)
#define PG8_WAIT_V(n) asm volatile("s_waitcnt vmcnt(" #n ")" ::: "memory")
#define PG8_WAIT_L(n) asm volatile("s_waitcnt lgkmcnt(" #n ")" ::: "memory")
#define PG8_BAR __builtin_amdgcn_s_barrier()
#define PG8_SCHED __builtin_amdgcn_sched_barrier(0)
    Unit cur, nxt; int ui = 0;
    if (!S.next(0, cur)) return;
    f32x4 acc[2][2][4][2];
#pragma unroll
    for (int a = 0; a < 2; ++a)
#pragma unroll
        for (int b = 0; b < 2; ++b)
#pragma unroll
            for (int m = 0; m < 4; ++m)
#pragma unroll
                for (int n = 0; n < 2; ++n) acc[a][b][m][n] = (f32x4){0.f, 0.f, 0.f, 0.f};
    bf16x8 At[4][2], B0[2][2], B1[2][2]; i32x8 At8[4], B08[2], B18[2];
    unsigned gc[2][2], gn[2][2];
#define PG8_GLOAD(dst, pm_) do { _Pragma("unroll") for (int h_ = 0; h_ < 2; ++h_) _Pragma("unroll") for (int i_ = 0; i_ < 2; ++i_) \
        dst[h_][i_] = ((unsigned)gidx[(pm_) * BM + h_ * HALF + RA[i_]] * (unsigned)K + (unsigned)CA[i_]) * 2u; } while (0)
    if constexpr (GATHER) { PG8_GLOAD(gc, 0); } else { gc[0][0] = gc[0][1] = gc[1][0] = gc[1][1] = 0u; }
    gn[0][0] = gc[0][0]; gn[0][1] = gc[0][1]; gn[1][0] = gc[1][0]; gn[1][1] = gc[1][1];
    const char* cA = (const char*)g.A + (GATHER ? (size_t)0 : (size_t)cur.pm * tstep); const char* cB = (const char*)g.Bt + (size_t)cur.pn * tstep;
    PG8_STAGE(PG8_SB(0, 0), cB, voffB); PG8_STAGE_A(PG8_SA(0, 0), cA, cA, 0, gc); PG8_STAGE(PG8_SB(0, 1), cB + bstep, voffB); PG8_STAGE_A(PG8_SA(0, 1), cA, cA, 1, gc);
    if (wr == 1) PG8_BAR;
    PG8_WAIT_V(4); PG8_BAR;
    PG8_STAGE(PG8_SB(1, 0), cB + kstep, voffB); PG8_STAGE_A(PG8_SA(1, 0), cA + kstep, cA + kstep, 0, gc); PG8_STAGE(PG8_SB(1, 1), cB + bstep + kstep, voffB);
    PG8_WAIT_V(6); PG8_BAR;
    PG8_STAGE_A(PG8_SA(1, 1), cA + kstep, cA + kstep, 1, gc);
    for (;;) {
        const bool has_next = S.next(ui + 1, nxt);
        const char* nA = has_next ? (const char*)g.A + (GATHER ? (size_t)0 : (size_t)nxt.pm * tstep) : cA; const char* nB = has_next ? (const char*)g.Bt + (size_t)nxt.pn * tstep : cB;
        if constexpr (GATHER) { if (has_next) { PG8_GLOAD(gn, ui + 1); } }
        for (int t = 0; t < nt; t += 2) {
            const bool last = (t == nt - 2);
            const char* a1 = cA + (size_t)(t + 1) * kstep;
            const char* a2 = last ? nA : cA + (size_t)(t + 2) * kstep; const char* b2 = last ? nB : cB + (size_t)(t + 2) * kstep;
            const char* a3 = a2 + kstep; const char* b3 = b2 + kstep;
            unsigned g2[2][2];
            if constexpr (GATHER) {
#pragma unroll
                for (int h_ = 0; h_ < 2; ++h_)
#pragma unroll
                    for (int i_ = 0; i_ < 2; ++i_) g2[h_][i_] = last ? gn[h_][i_] : gc[h_][i_];
            }
            PG8_LDB(B0, 0, 0); PG8_SCHED; PG8_LDA(At, 0, 0);
            PG8_WAIT_L(8); PG8_BAR; PG8_WAIT_L(0); PG8_MMA(0, 0, At, B0); PG8_BAR; PG8_SCHED;
            PG8_LDB(B1, 0, 1); PG8_STAGE(PG8_SB(0, 0), b2, voffB);
            PG8_BAR; PG8_WAIT_L(0); PG8_MMA(0, 1, At, B1); PG8_BAR;
            PG8_LDA(At, 0, 1); PG8_STAGE_A(PG8_SA(0, 0), a2, a2, 0, g2);
            PG8_BAR; PG8_WAIT_L(0); PG8_MMA(1, 0, At, B0); PG8_BAR; PG8_SCHED;
            PG8_STAGE(PG8_SB(0, 1), b2 + bstep, voffB);
            if (t == 0 && ui > 0) asm volatile("s_waitcnt vmcnt(%0)" :: "i"(6 + Epi::NST) : "memory"); else PG8_WAIT_V(6);
            PG8_BAR; PG8_MMA(1, 1, At, B1); PG8_BAR;
            PG8_LDB(B0, 1, 0); PG8_SCHED; PG8_LDA(At, 1, 0); PG8_STAGE_A(PG8_SA(0, 1), a2, a2, 1, g2);
            PG8_WAIT_L(8); PG8_BAR; PG8_WAIT_L(0); PG8_MMA(0, 0, At, B0); PG8_BAR; PG8_SCHED;
            PG8_LDB(B1, 1, 1); PG8_STAGE(PG8_SB(1, 0), b3, voffB);
            PG8_BAR; PG8_WAIT_L(0); PG8_MMA(0, 1, At, B1); PG8_BAR;
            PG8_LDA(At, 1, 1); PG8_STAGE_A(PG8_SA(1, 0), a3, a3, 0, g2);
            PG8_BAR; PG8_WAIT_L(0); PG8_MMA(1, 0, At, B0); PG8_BAR; PG8_SCHED;
            PG8_STAGE(PG8_SB(1, 1), b3 + bstep, voffB);
            PG8_WAIT_V(6); PG8_BAR; PG8_MMA(1, 1, At, B1); PG8_BAR;
            PG8_STAGE_A(PG8_SA(1, 1), a3, a3, 1, g2);
        }
        if constexpr (FP8) { asm volatile("s_nop 15\n\ts_nop 15" ::: "memory"); }
        E(acc, cur, wr, wc, fr, fq);
        if (!has_next) break;
#pragma unroll
        for (int a = 0; a < 2; ++a)
#pragma unroll
            for (int b = 0; b < 2; ++b)
#pragma unroll
                for (int m = 0; m < 4; ++m)
#pragma unroll
                    for (int n = 0; n < 2; ++n) acc[a][b][m][n] = (f32x4){0.f, 0.f, 0.f, 0.f};
        cur = nxt; cA = nA; cB = nB; ++ui;
        gc[0][0] = gn[0][0]; gc[0][1] = gn[0][1]; gc[1][0] = gn[1][0]; gc[1][1] = gn[1][1];
    }
    PG8_WAIT_V(0);
    if (wr == 0) PG8_BAR;
    PG8_BAR;
#undef PG8_SA
#undef PG8_SB
#undef PG8_STAGE
#undef PG8_STAGE_A
#undef PG8_LDA
#undef PG8_LDB
#undef PG8_MMA
#undef PG8_WAIT_V
#undef PG8_WAIT_L
#undef PG8_BAR
#undef PG8_SCHED
#undef PG8_GLOAD
}
}

struct Frame { LAS unsigned char* lds; int tid, lane, wave, G, bid; };

__device__ __forceinline__ void p0_mod_unit(const Params& p, const Frame& F, int u) {
    LAS float* st = (LAS float*)F.lds;
    LAS float* red = (LAS float*)(F.lds + 67584);
    for (int idx = F.tid; idx < NB * DM; idx += 512) { const int b = idx >> 11, k = idx & 2047; st[(k + (k >> 6)) * 8 + b] = silu_f(p.c[idx]); }
    __syncthreads();
    if (F.tid < 384) {
        const int cgp = F.tid % 12, kg = F.tid / 12;
        f32x4 acc[8];
#pragma unroll
        for (int b = 0; b < 8; ++b) acc[b] = (f32x4){0.f, 0.f, 0.f, 0.f};
        const char* wbase = (const char*)(p.w_ada + 48 * u); const unsigned woff = (unsigned)((kg * 64) * (6 * DM) + 4 * cgp) * 4u;
#define MOD_LOAD8(dst, j) do { _Pragma("unroll") for (int q = 0; q < 8; ++q) dst[q] = __builtin_nontemporal_load((const f32x4*)(wbase + (woff + (unsigned)((j) * 8 + q) * (unsigned)(6 * DM * 4)))); } while (0)
#define MOD_USE8(src, j) do { _Pragma("unroll") for (int q = 0; q < 8; ++q) { const int kk = (j) * 8 + q; const f32x4 w = src[q]; \
            const f32x4 s0 = *(const LAS f32x4*)(st + (kg * 65 + kk) * 8), s1 = *(const LAS f32x4*)(st + (kg * 65 + kk) * 8 + 4); \
            acc[0] += w * s0[0]; acc[1] += w * s0[1]; acc[2] += w * s0[2]; acc[3] += w * s0[3]; acc[4] += w * s1[0]; acc[5] += w * s1[1]; acc[6] += w * s1[2]; acc[7] += w * s1[3]; } } while (0)
        f32x4 wa[8], wb[8];
        MOD_LOAD8(wa, 0); __builtin_amdgcn_sched_barrier(0);
#pragma unroll 1
        for (int j = 0; j < 8; j += 2) {
            MOD_LOAD8(wb, j + 1); __builtin_amdgcn_sched_barrier(0);
            MOD_USE8(wa, j); __builtin_amdgcn_sched_barrier(0);
            { const int jn = j + 2 < 8 ? j + 2 : 7; MOD_LOAD8(wa, jn); } __builtin_amdgcn_sched_barrier(0);
            MOD_USE8(wb, j + 1); __builtin_amdgcn_sched_barrier(0);
        }
#undef MOD_LOAD8
#undef MOD_USE8
#pragma unroll
        for (int b = 0; b < 8; ++b) *(LAS f32x4*)(red + (kg * 8 + b) * 48 + 4 * cgp) = acc[b];
    }
    __syncthreads();
    if (F.tid < 384) {
        const int b = F.tid / 48, col = F.tid % 48; float s = p.b_ada[48 * u + col];
#pragma unroll
        for (int kg = 0; kg < 32; ++kg) s += red[(kg * 8 + b) * 48 + col];
        ((float*)(p.ws + WS_MOD))[b * (6 * DM) + 48 * u + col] = s;
    }
    __syncthreads();
}
struct CvtJob { const float* src; bf16_t* dst; int ld_src, ld_dst, qrows; float f8scale; };
constexpr int CVT_NT = 4;
#ifndef CVT_WGS
#define CVT_WGS 192
#endif
template <class JobFn>
__device__ __forceinline__ void cvt_stream(const Frame& F, int first, int stride, int total, JobFn job) {
    int v = first; if (v >= total) return;
    const int kr = F.tid >> 5, nc = (F.tid & 31) * 4, n = F.tid >> 2, kc = (F.tid & 3) * 16;
    CvtJob cur = job(v); f32x4 r[CVT_NT][4];
#define CVT_LOAD(jb) do { _Pragma("unroll") for (int q = 0; q < CVT_NT; ++q) _Pragma("unroll") for (int i = 0; i < 4; ++i) r[q][i] = __builtin_nontemporal_load((const f32x4*)((jb).src + (size_t)(kr + 16 * i) * (jb).ld_src + 128 * q + nc)); } while (0)
    CVT_LOAD(cur);
    int buf = 0;
    for (;;) {
        LAS unsigned char* t = F.lds + buf * (CVT_NT * 16384);
#pragma unroll
        for (int q = 0; q < CVT_NT; ++q)
#pragma unroll
            for (int i = 0; i < 4; ++i) *(LAS u32x2*)(t + q * 16384 + (kr + 16 * i) * 256 + nc * 2) = pack4(r[q][i]);
        const int vn = v + stride; const bool more = vn < total; CvtJob nx = cur;
        if (more) { nx = job(vn); CVT_LOAD(nx); }
        asm volatile("s_waitcnt lgkmcnt(0)" ::: "memory"); __builtin_amdgcn_s_barrier(); asm volatile("" ::: "memory");
#pragma unroll
        for (int q = 0; q < CVT_NT; ++q) { unsigned w[8];
#pragma unroll
          for (int e = 0; e < 8; ++e) { const unsigned lo = *(const LAS bf16_t*)(t + q * 16384 + (kc + 2 * e) * 256 + n * 2), hi = *(const LAS bf16_t*)(t + q * 16384 + (kc + 2 * e + 1) * 256 + n * 2); w[e] = lo | (hi << 16); }
          if (cur.f8scale != 0.f) { const float sc = cur.f8scale; unsigned f[4];
#pragma unroll
              for (int e = 0; e < 4; ++e) f[e] = pack_fp8x4(bflo(w[2 * e]) * sc, bfhi(w[2 * e]) * sc, bflo(w[2 * e + 1]) * sc, bfhi(w[2 * e + 1]) * sc);
              *(u32x4*)((unsigned char*)cur.dst + (size_t)(q * cur.qrows + n) * cur.ld_dst + kc) = (u32x4){f[0], f[1], f[2], f[3]}; }
          else { u32x4* d = (u32x4*)(cur.dst + (size_t)(q * cur.qrows + n) * cur.ld_dst + kc); d[0] = (u32x4){w[0], w[1], w[2], w[3]}; d[1] = (u32x4){w[4], w[5], w[6], w[7]}; } }
        if (!more) break;
        v = vn; buf ^= 1; cur = nx;
    }
#undef CVT_LOAD
    __syncthreads();
}
constexpr int P0_MOD = 256, P0_WIN = 1792, P0_WOUT = 512, P0_GU = 8192, P0_DOWN = 4096, P0_SMALL = 16, P0_RT = 24;
__device__ __forceinline__ void p0_prologue(const Params& p, const Frame& F) {
    bf16_t* wout_t = (bf16_t*)(p.ws + WS_WOUT); bf16_t* win_t = (bf16_t*)(p.ws + WS_WIN);
    for (int v = F.bid; v < P0_MOD; v += F.G) p0_mod_unit(p, F, v);
    cvt_stream(F, F.bid, F.G, (P0_WIN + P0_WOUT) / CVT_NT, [&](int g) -> CvtJob {
        int idx = g * CVT_NT;
        if (idx < P0_WIN) { const int kt = idx / 56, nt = idx % 56, n0 = 128 * nt, oc = n0 + (n0 >= 4096 ? 16 : 0);
            return CvtJob{p.w_in + (size_t)kt * 64 * WIN_LD + oc, win_t + (size_t)n0 * DM + kt * 64, WIN_LD, DM, 128, 0.f}; }
        idx -= P0_WIN; const int kt = idx / 16, nt = idx % 16;
        return CvtJob{p.w_out + (size_t)kt * 64 * DM + 128 * nt, wout_t + (size_t)(128 * nt) * DM + kt * 64, DM, DM, 128, 0.f}; });
    for (int v = F.bid; v < P0_SMALL + P0_RT; v += F.G) {
        int idx = v;
        if (idx < P0_SMALL) { bf16_t* sw = (bf16_t*)(p.ws + WS_SMALLW);
            for (int j = 0; j < 8; ++j) { const int i = idx * 4096 + j * 512 + F.tid, s = i >> 11, k = i & 2047;
                const float val = s < 24 ? p.w_in[(size_t)k * WIN_LD + (s < 16 ? 4096 + s : 7184 + s - 16)] : 0.f; sw[i] = f2bf(val); }
            continue; } idx -= P0_SMALL;
        { bf16_t* rw = (bf16_t*)(p.ws + WS_RTW);
            for (int j = 0; j < 8; ++j) { const int i = idx * 4096 + j * 512 + F.tid, n = i >> 11, k = i & 2047;
                const float val = n < 4 ? p.w_rg[k * 4 + n] : (n < 36 ? p.w_re[(size_t)((n - 4) >> 3) * DM * 8 + k * 8 + ((n - 4) & 7)] : 0.f);
                const bf16_t hi = f2bf(val); rw[i] = hi; rw[48 * DM + i] = f2bf(val - bf1(hi)); } }
    }
}
__device__ __forceinline__ void moe_weight_tiles(const Params& p, const Frame& F, int first, int stride) {
    bf16_t* w1 = (bf16_t*)((unsigned char*)p.out + OUT_W1); bf16_t* w2 = (bf16_t*)((unsigned char*)p.out + OUT_W2);
    cvt_stream(F, first, stride, (P0_GU + P0_DOWN) / CVT_NT, [&](int g) -> CvtJob {
        int idx = g * CVT_NT;
        if (idx < P0_GU) { const int e = idx >> 8, r = idx & 255, which = r >> 7, r2 = r & 127, kt = r2 >> 2;
            return CvtJob{(which ? p.w_up : p.w_gate) + (size_t)e * DM * DEXP + (size_t)kt * 64 * DEXP, (bf16_t*)((unsigned char*)w1 + (size_t)(e * 1024 + which * 128) * DM + kt * 64), DEXP, DM, 256, W1_SCALE}; }
        idx -= P0_GU; const int e = idx >> 7, r = idx & 127, kt = r >> 4, nt = r & 15;
        return CvtJob{p.w_down + (size_t)e * DEXP * DM + (size_t)kt * 64 * DM + 128 * nt, (bf16_t*)((unsigned char*)w2 + (size_t)(e * 2048 + 128 * nt) * DEXP + kt * 64), DM, DEXP, 128, W2_SCALE}; });
}

constexpr int H1_SW = 16384, H1_SWLD = 4112;
__device__ __forceinline__ void p1_hpass(const Params& p, const Frame& F) {
    const float* mod = (const float*)(p.ws + WS_MOD); bf16_t* hb = (bf16_t*)(p.ws + WS_HBUF); const bf16_t* sw = (const bf16_t*)(p.ws + WS_SMALLW); float* sm = (float*)(p.ws + WS_SM);
    const int fr = F.lane & 15, fq = F.lane >> 4;
    for (int i = F.tid; i < 32 * 256; i += 512) { const int r = i >> 8, ch = i & 255; *(LAS u32x4*)(F.lds + H1_SW + r * H1_SWLD + ch * 16) = *(const u32x4*)(sw + (size_t)r * DM + ch * 8); }
    int bcur = -1;
    for (int wt0 = F.bid * 8; wt0 < NTOK / 16; wt0 += F.G * 8) {
        const int wt = wt0 + F.wave, row0 = wt * 16, b = (wt0 * 16) / SEQ;
        if (b != bcur) { __syncthreads(); bcur = b;
            for (int i = F.tid; i < DM; i += 512) { ((LAS float*)F.lds)[i] = 1.f + mod[(size_t)b * (6 * DM) + DM + i]; ((LAS float*)F.lds)[DM + i] = mod[(size_t)b * (6 * DM) + i]; }
            __syncthreads(); }
        const float* xr = p.x + (size_t)(row0 + fr) * DM + 8 * fq; bf16_t* hr = hb + (size_t)(row0 + fr) * DM + 8 * fq;
        f32x4 a0 = {0.f, 0.f, 0.f, 0.f}, a1 = {0.f, 0.f, 0.f, 0.f};
        f32x4 xa[8][2], xn[8][2];
#define H1_LOAD(dst, blk_) do { _Pragma("unroll") for (int j = 0; j < 8; ++j) { dst[j][0] = __builtin_nontemporal_load((const f32x4*)(xr + 32 * (8 * (blk_) + j))); dst[j][1] = __builtin_nontemporal_load((const f32x4*)(xr + 32 * (8 * (blk_) + j) + 4)); } } while (0)
#define H1_COMP(src, blk_) do { _Pragma("unroll") for (int j = 0; j < 8; ++j) { const int s = 8 * (blk_) + j; \
                const f32x4 c0 = *(const LAS f32x4*)(F.lds + (32 * s + 8 * fq) * 4), c1 = *(const LAS f32x4*)(F.lds + (32 * s + 8 * fq) * 4 + 16); \
                const f32x4 h0 = *(const LAS f32x4*)(F.lds + 8192 + (32 * s + 8 * fq) * 4), h1 = *(const LAS f32x4*)(F.lds + 8192 + (32 * s + 8 * fq) * 4 + 16); \
                const bf16x8 af = pack8(src[j][0] * c0 + h0, src[j][1] * c1 + h1); \
                *(bf16x8*)(hr + 32 * s) = af; \
                const bf16x8 b0 = *(const LAS bf16x8*)(F.lds + H1_SW + fr * H1_SWLD + (32 * s + 8 * fq) * 2), b1 = *(const LAS bf16x8*)(F.lds + H1_SW + (16 + fr) * H1_SWLD + (32 * s + 8 * fq) * 2); \
                a0 = mfma16(af, b0, a0); a1 = mfma16(af, b1, a1); } } while (0)
        H1_LOAD(xa, 0);
#pragma unroll 1
        for (int bp = 0; bp < 4; ++bp) {
            H1_LOAD(xn, 2 * bp + 1); H1_COMP(xa, 2 * bp);
            if (bp < 3) H1_LOAD(xa, 2 * bp + 2);
            H1_COMP(xn, 2 * bp + 1);
        }
#undef H1_LOAD
#undef H1_COMP
#pragma unroll
        for (int j = 0; j < 4; ++j) { float* o = sm + (size_t)(row0 + 4 * fq + j) * 32; o[fr] = a0[j]; o[16 + fr] = a1[j]; }
    }
    __syncthreads();
}

constexpr int D1_KN = 0, D1_QN = 17408, D1_VN = 34816, D1_AOFF = 52224, D1_TM = 61440, D1_TB = 70656, D1_TG = 79872, D1_ADIAG = 89088, D1_GATES = 93440;
constexpr int D1_CW = 94464;
struct D1Pre { u32x4 x[3][5]; float gb, ga; };
__device__ __forceinline__ void d1_prefetch(const Params& p, const Frame& F, int u, D1Pre& P) {
    const int bh = u >> 6, c = u & 63, b = bh >> 3, h = bh & 7, row0 = b * SEQ + c * 64;
    const bf16_t* proj = (const bf16_t*)(p.ws + WS_PROJ); const float* sm = (const float*)(p.ws + WS_SM);
    const int cg = F.tid & 15, t0 = 2 * (F.tid >> 4);
#pragma unroll
    for (int part = 0; part < 3; ++part)
#pragma unroll
        for (int j = 0; j < 5; ++j) { const int tt = c * 64 + t0 - 3 + j; const int tc = tt >= 0 ? t0 - 3 + j : 0;
            P.x[part][j] = *(const u32x4*)(proj + (size_t)(row0 + tc) * LDP + part * 1024 + h * HD + 8 * cg); }
    const float* r = sm + (size_t)(row0 + F.lane) * 32; P.gb = r[h]; P.ga = r[8 + h];
}
__device__ __forceinline__ void d1_chunk(const Params& p, const Frame& F, int u, D1Pre& P, int unext) {
    LAS unsigned char* lds = F.lds;
    const int tid = F.tid, lane = F.lane, wave = F.wave, fr = lane & 15, fq = lane >> 4;
    const int bh = u >> 6, c = u & 63, h = bh & 7;
    unsigned char* outc = p.ws + WS_DN + (size_t)u * DN_CHUNK;
    LAS float* Gs = (LAS float*)(lds + D1_GATES); LAS float* Bs = Gs + 64; LAS float* EGs = Gs + 128;
    if (wave == 0) {
        const float bl = P.gb, al = P.ga;
        const float beta = __builtin_amdgcn_rcpf(1.f + __expf(-bl));
        const float xs = al + p.dt_bias[h];
        const float sp = xs > 20.f ? xs : log1pf(__expf(xs));
        float G = -__expf(p.a_log[h]) * sp;
#pragma unroll
        for (int o = 1; o < 64; o <<= 1) { const float v = __shfl_up(G, o); if (lane >= o) G += v; }
        Gs[lane] = G; Bs[lane] = beta; EGs[lane] = __expf(G);
    }
    {
        const int cg = tid & 15, rp = tid >> 4, t0 = 2 * rp;
#pragma unroll
        for (int part = 0; part < 3; ++part) {
            float cw[4][8];
#pragma unroll
            for (int tp = 0; tp < 4; ++tp) { const f32x4 w0 = *(const LAS f32x4*)(lds + D1_CW + ((part * 4 + tp) * 128 + 8 * cg) * 4), w1 = *(const LAS f32x4*)(lds + D1_CW + ((part * 4 + tp) * 128 + 8 * cg + 4) * 4);
                cw[tp][0] = w0[0]; cw[tp][1] = w0[1]; cw[tp][2] = w0[2]; cw[tp][3] = w0[3]; cw[tp][4] = w1[0]; cw[tp][5] = w1[1]; cw[tp][6] = w1[2]; cw[tp][7] = w1[3]; }
            float o0[8], o1[8];
#pragma unroll
            for (int e = 0; e < 8; ++e) { o0[e] = 0.f; o1[e] = 0.f; }
#pragma unroll
            for (int j = 0; j < 5; ++j) { u32x4 xr = P.x[part][j];
                if (j < 3) { const bool valid = c * 64 + t0 - 3 + j >= 0; xr.x = valid ? xr.x : 0u; xr.y = valid ? xr.y : 0u; xr.z = valid ? xr.z : 0u; xr.w = valid ? xr.w : 0u; }
                float xf[8]; unpack8(xr, xf);
#pragma unroll
                for (int e = 0; e < 8; ++e) { const float xv = xf[e]; if (j < 4) o0[e] += cw[j][e] * xv; if (j >= 1) o1[e] += cw[j - 1][e] * xv; } }
            float s0 = 0.f, s1 = 0.f;
#pragma unroll
            for (int e = 0; e < 8; ++e) { o0[e] = silu_f(o0[e]); o1[e] = silu_f(o1[e]); s0 += o0[e] * o0[e]; s1 += o1[e] * o1[e]; }
            if (part < 2) {
#pragma unroll
                for (int o = 1; o < 16; o <<= 1) { s0 += __shfl_xor(s0, o); s1 += __shfl_xor(s1, o); }
                const float r0 = rsqrtf(s0 + NORM_EPS), r1 = rsqrtf(s1 + NORM_EPS);
#pragma unroll
                for (int e = 0; e < 8; ++e) { o0[e] *= r0; o1[e] *= r1; }
            }
            const int img = part == 0 ? D1_QN : (part == 1 ? D1_KN : D1_VN);
            *(LAS bf16x8*)(lds + img + t0 * 272 + cg * 16) = pack8((f32x4){o0[0], o0[1], o0[2], o0[3]}, (f32x4){o0[4], o0[5], o0[6], o0[7]});
            *(LAS bf16x8*)(lds + img + (t0 + 1) * 272 + cg * 16) = pack8((f32x4){o1[0], o1[1], o1[2], o1[3]}, (f32x4){o1[4], o1[5], o1[6], o1[7]});
            __builtin_amdgcn_sched_barrier(0);
        }
    }
    d1_prefetch(p, F, unext, P);
    __syncthreads();
#define D1_TILE_JOB(job_) do { const int job = (job_), kind = job >> 4, ti = (job >> 2) & 3, tj = job & 3; \
        const int icol = 16 * ti + fr, j0 = 16 * tj + 4 * fq; \
        if (tj > ti) { if (kind == 1) *(u32x2*)(outc + DN_QK + icol * 144 + j0 * 2) = (u32x2){0u, 0u}; break; } \
        f32x4 acc = {0.f, 0.f, 0.f, 0.f}; \
        const int ybase = kind ? D1_QN : D1_KN; \
        _Pragma("unroll") for (int s = 0; s < 4; ++s) { \
            const bf16x8 a = *(const LAS bf16x8*)(lds + D1_KN + (16 * tj + fr) * 272 + (32 * s + 8 * fq) * 2); \
            const bf16x8 bb = *(const LAS bf16x8*)(lds + ybase + (16 * ti + fr) * 272 + (32 * s + 8 * fq) * 2); \
            acc = mfma16(a, bb, acc); } \
        const float Gi = Gs[icol]; const f32x4 Gj = *(const LAS f32x4*)(Gs + j0); \
        f32x4 v; \
        if (kind == 0) { const float bi = Bs[icol]; \
            _Pragma("unroll") for (int e = 0; e < 4; ++e) v[e] = (j0 + e < icol) ? bi * acc[e] * __expf(Gi - Gj[e]) : 0.f; \
            if (tj < ti) *(LAS u32x2*)(lds + D1_AOFF + icol * 144 + j0 * 2) = pack4(v); \
            else *(LAS f32x4*)(lds + D1_ADIAG + ti * 1040 + fr * 64 + fq * 16) = v; \
        } else { \
            _Pragma("unroll") for (int e = 0; e < 4; ++e) v[e] = (j0 + e <= icol) ? acc[e] * __expf(Gi - Gj[e]) * QSCALE : 0.f; \
            *(u32x2*)(outc + DN_QK + icol * 144 + j0 * 2) = pack4(v); \
        } } while (0)
#pragma unroll 1
    for (int jj = 0; jj < 2; ++jj) D1_TILE_JOB(wave + 8 * jj);
    __syncthreads();
    if (wave == 0) {
        { const int blk = lane >> 4, jc = lane & 15; float t[16];
#pragma unroll
          for (int i = 0; i < 16; ++i) { float a4[4] = {(jc == i) ? 1.f : 0.f, 0.f, 0.f, 0.f};
#pragma unroll
              for (int m4 = 0; m4 < (i + 3) / 4; ++m4) { const f32x4 ar = *(const LAS f32x4*)(lds + D1_ADIAG + blk * 1040 + i * 64 + m4 * 16);
#pragma unroll
                  for (int e = 0; e < 4; ++e) if (4 * m4 + e < i) a4[e] -= ar[e] * t[4 * m4 + e]; }
              t[i] = (a4[0] + a4[1]) + (a4[2] + a4[3]); if ((i & 3) == 3) __builtin_amdgcn_sched_barrier(0); }
          const int j = 16 * blk + jc; const float bj = Bs[j], bgj = bj * EGs[j];
#pragma unroll
          for (int i = 0; i < 16; ++i) { const int off = (16 * blk + i) * 144 + j * 2;
              *(LAS bf16_t*)(lds + D1_TM + off) = f2bf(t[i]); *(LAS bf16_t*)(lds + D1_TB + off) = f2bf(t[i] * bj); *(LAS bf16_t*)(lds + D1_TG + off) = f2bf(t[i] * bgj); } }
        LGKM0();
        const int tmaddr = (int)(uintptr_t)(lds + D1_TM);
#pragma unroll
        for (int bb = 1; bb < 4; ++bb) {
            constexpr int NS_MAX = 2;
            bf16x8 a[NS_MAX]; s16x4 l[3][NS_MAX], hh[3][NS_MAX];
            const int ns = bb == 3 ? 2 : 1;
#pragma unroll
            for (int s_ = 0; s_ < NS_MAX; ++s_) if (s_ < ns) a[s_] = *(const LAS bf16x8*)(lds + D1_AOFF + (16 * bb + fr) * 144 + (32 * s_ + 8 * fq) * 2);
#pragma unroll
            for (int cc = 0; cc < 3; ++cc) if (cc < bb)
#pragma unroll
                for (int s_ = 0; s_ < NS_MAX; ++s_) if (s_ < ns) { const int ad = tmaddr + (32 * s_ + 8 * fq + (fr >> 2)) * 144 + (16 * cc + 4 * (fr & 3)) * 2; TRRD(l[cc][s_], ad, 0); TRRD(hh[cc][s_], ad, 576); }
            const u32x2 t2 = *(const LAS u32x2*)(lds + D1_TM + (16 * bb + fr) * 144 + (16 * bb + 4 * fq) * 2);
            LGKM0();
            f32x4 X[3];
#pragma unroll
            for (int cc = 0; cc < 3; ++cc) if (cc < bb) { X[cc] = (f32x4){0.f, 0.f, 0.f, 0.f};
#pragma unroll
                for (int s_ = 0; s_ < NS_MAX; ++s_) if (s_ < ns) X[cc] = mfma16(a[s_], join8(l[cc][s_], hh[cc][s_]), X[cc]); }
#pragma unroll
            for (int cc = 0; cc < 3; ++cc) if (cc < bb) {
                u32x4 aw = {t2.x, t2.y, 0u, 0u}, bw = {cvtpk(X[cc][0], X[cc][1]), cvtpk(X[cc][2], X[cc][3]), 0u, 0u};
                const f32x4 Tn = mfma16(*reinterpret_cast<bf16x8*>(&aw), *reinterpret_cast<bf16x8*>(&bw), (f32x4){0.f, 0.f, 0.f, 0.f});
                const int j = 16 * cc + fr; const float bj = Bs[j], bgj = bj * EGs[j];
#pragma unroll
                for (int e = 0; e < 4; ++e) { const int off = (16 * bb + 4 * fq + e) * 144 + j * 2; const float tv = -Tn[e];
                    *(LAS bf16_t*)(lds + D1_TM + off) = f2bf(tv); *(LAS bf16_t*)(lds + D1_TB + off) = f2bf(tv * bj); *(LAS bf16_t*)(lds + D1_TG + off) = f2bf(tv * bgj); }
            }
            LGKM0();
        }
    } else {
        const int t7 = tid - 64; const float Glast = Gs[63];
        for (int i = t7; i < 1024; i += 448) { const int r = i >> 4, ch = i & 15; float f[8]; unpack8(*(const LAS u32x4*)(lds + D1_QN + r * 272 + ch * 16), f); const float sc = EGs[r] * QSCALE;
            *(bf16x8*)(outc + DN_Q + r * 272 + ch * 16) = pack8((f32x4){f[0] * sc, f[1] * sc, f[2] * sc, f[3] * sc}, (f32x4){f[4] * sc, f[5] * sc, f[6] * sc, f[7] * sc}); }
        for (int i = t7; i < 1024; i += 448) { const int dk = i & 127, ich = i >> 7; float f[8];
#pragma unroll
            for (int e = 0; e < 8; ++e) f[e] = bf1(*(const LAS bf16_t*)(lds + D1_KN + (8 * ich + e) * 272 + dk * 2)) * __expf(Glast - Gs[8 * ich + e]);
            *(bf16x8*)(outc + DN_KT + dk * 144 + ich * 16) = pack8((f32x4){f[0], f[1], f[2], f[3]}, (f32x4){f[4], f[5], f[6], f[7]}); }
        if (t7 == 0) *(float*)(outc + DN_MISC) = __expf(Glast);
#pragma unroll 1
        for (int jq = 16 + wave - 1; jq < 32; jq += 7) D1_TILE_JOB(jq);
    }
#undef D1_TILE_JOB
    __syncthreads();
    { const int vnaddr = (int)(uintptr_t)(lds + D1_VN), knaddr = (int)(uintptr_t)(lds + D1_KN);
#pragma unroll
      for (int jp = 0; jp < 2; ++jp) {
        bf16x8 a[2][2]; s16x4 l[2][2], hh[2][2];
#pragma unroll
        for (int q = 0; q < 2; ++q)
#pragma unroll
            for (int s_ = 0; s_ < 2; ++s_) { const int it = 2 * jp + q;
                a[q][s_] = *(const LAS bf16x8*)(lds + D1_TB + (16 * it + fr) * 144 + (32 * s_ + 8 * fq) * 2);
                const int ad = vnaddr + (32 * s_ + 8 * fq + (fr >> 2)) * 272 + (16 * wave + 4 * (fr & 3)) * 2;
                TRRD(l[q][s_], ad, 0); TRRD(hh[q][s_], ad, 1088); }
        LGKM0();
#pragma unroll
        for (int q = 0; q < 2; ++q) { const int it = 2 * jp + q; f32x4 acc = {0.f, 0.f, 0.f, 0.f};
            acc = mfma16(a[q][0], join8(l[q][0], hh[q][0]), acc); acc = mfma16(a[q][1], join8(l[q][1], hh[q][1]), acc);
            *(u32x2*)(outc + DN_UT + (16 * wave + fr) * 128 + (16 * it + 4 * fq) * 2) = pack4(acc); }
      }
#pragma unroll
      for (int jp = 0; jp < 2; ++jp) {
        const int it = wave & 3;
        bf16x8 bb[2]; s16x4 l[2][2], hh[2][2];
#pragma unroll
        for (int s_ = 0; s_ < 2; ++s_) bb[s_] = *(const LAS bf16x8*)(lds + D1_TG + (16 * it + fr) * 144 + (32 * s_ + 8 * fq) * 2);
#pragma unroll
        for (int q = 0; q < 2; ++q)
#pragma unroll
            for (int s_ = 0; s_ < 2; ++s_) { const int dkt = 4 * jp + 2 * q + (wave >> 2);
                const int ad = knaddr + (32 * s_ + 8 * fq + (fr >> 2)) * 272 + (16 * dkt + 4 * (fr & 3)) * 2;
                TRRD(l[q][s_], ad, 0); TRRD(hh[q][s_], ad, 1088); }
        LGKM0();
#pragma unroll
        for (int q = 0; q < 2; ++q) { const int dkt = 4 * jp + 2 * q + (wave >> 2); f32x4 acc = {0.f, 0.f, 0.f, 0.f};
            acc = mfma16(join8(l[q][0], hh[q][0]), bb[0], acc); acc = mfma16(join8(l[q][1], hh[q][1]), bb[1], acc);
            *(u32x2*)(outc + DN_W + (16 * it + fr) * 272 + (16 * dkt + 4 * fq) * 2) = pack4(-acc); }
      } }
    __syncthreads();
}
__device__ __forceinline__ void fcum_unit(const Params& p, const Frame& F, int bh) {
    const float* sm = (const float*)(p.ws + WS_SM); float* fc = (float*)(p.ws + WS_FCUM) + (size_t)bh * SEQ;
    const int b = bh >> 3, h = bh & 7; const float fb = p.f_bias[h];
    LAS float* red = (LAS float*)F.lds;
    float v[8], s = 0.f;
#pragma unroll
    for (int e = 0; e < 8; ++e) { const float z = sm[(size_t)(b * SEQ + F.tid * 8 + e) * 32 + 16 + h] + fb; const float ls = fminf(z, 0.f) - log1pf(__expf(-fabsf(z))); s += ls; v[e] = s; }
    float inc = s;
#pragma unroll
    for (int o = 1; o < 64; o <<= 1) { const float t = __shfl_up(inc, o); if (F.lane >= o) inc += t; }
    if (F.lane == 63) red[F.wave] = inc;
    __syncthreads();
    float base = inc - s;
    for (int w = 0; w < F.wave; ++w) base += red[w];
#pragma unroll
    for (int e = 0; e < 8; ++e) fc[F.tid * 8 + e] = -(base + v[e]) * 11.313708498984761f;
    __syncthreads();
}
__device__ __forceinline__ int d1_unit(int bid, int i) { const int h = bid & 7, j = (bid >> 3) + 32 * i, b = j >> 6, c = j & 63; return ((b * 8 + h) << 6) + c; }
__device__ __forceinline__ void p3_dnprep(const Params& p, const Frame& F) {
    if (F.G == 256) {
        const int h = F.bid & 7;
        for (int i = F.tid; i < 3 * 4 * 128; i += 512) { const int part = i / 512, tp = (i >> 7) & 3, ch = i & 127; ((LAS float*)(F.lds + D1_CW))[i] = p.conv_w[tp * 3072 + part * 1024 + h * HD + ch]; }
        for (int i = F.tid; i < 2304; i += 512) *(LAS u32x4*)(F.lds + D1_AOFF + i * 16) = (u32x4){0u, 0u, 0u, 0u};
        D1Pre P; d1_prefetch(p, F, d1_unit(F.bid, 0), P);
        __syncthreads();
#pragma unroll 1
        for (int i = 0; i < 16; ++i) d1_chunk(p, F, d1_unit(F.bid, i), P, d1_unit(F.bid, i < 15 ? i + 1 : i));
    } else {
        for (int u = F.bid; u < 4096; u += F.G) { const int h = (u >> 6) & 7;
            __syncthreads();
            for (int i = F.tid; i < 3 * 4 * 128; i += 512) { const int part = i / 512, tp = (i >> 7) & 3, ch = i & 127; ((LAS float*)(F.lds + D1_CW))[i] = p.conv_w[tp * 3072 + part * 1024 + h * HD + ch]; }
            for (int i = F.tid; i < 2304; i += 512) *(LAS u32x4*)(F.lds + D1_AOFF + i * 16) = (u32x4){0u, 0u, 0u, 0u};
            D1Pre P; d1_prefetch(p, F, u, P);
            __syncthreads();
            d1_chunk(p, F, u, P, u); }
    }
    if (F.bid < 64) fcum_unit(p, F, F.bid);
    for (int u = F.bid; u < 256; u += F.G) { const int bh = u >> 2, seg = u & 3, b = bh >> 3, h = bh & 7;
        const bf16_t* proj = (const bf16_t*)(p.ws + WS_PROJ); float q2m = 0.f, k2m = 0.f;
        for (int r = F.tid >> 4; r < 1024; r += 32) { const bf16_t* rowp = proj + (size_t)(b * SEQ + seg * 1024 + r) * LDP + h * HD + 8 * (F.tid & 15);
            float qf[8], kf[8]; unpack8(*(const u32x4*)(rowp + FQ), qf); unpack8(*(const u32x4*)(rowp + FK), kf);
            float q2 = 0.f, k2 = 0.f;
#pragma unroll
            for (int e = 0; e < 8; ++e) { q2 += qf[e] * qf[e]; k2 += kf[e] * kf[e]; }
#pragma unroll
            for (int m = 1; m < 16; m <<= 1) { q2 += __shfl_xor(q2, m); k2 += __shfl_xor(k2, m); }
            q2m = fmaxf(q2m, q2); k2m = fmaxf(k2m, k2); }
#pragma unroll
        for (int m = 16; m < 64; m <<= 1) { q2m = fmaxf(q2m, __shfl_xor(q2m, m)); k2m = fmaxf(k2m, __shfl_xor(k2m, m)); }
        if (F.lane == 0) { unsigned* mx = (unsigned*)(p.ws + WS_CTL) + CW_QKMAX + 2 * bh; atomicMax(mx, __float_as_uint(q2m)); atomicMax(mx + 1, __float_as_uint(k2m)); } }
}

constexpr int SC_W = 0, SC_KT = 17408, SC_Q = 35840, SC_QK = 53248, SC_ST = 62464, SC_VT = 97280, SC_OB = 115712, SC_END = 133120, SC_UT = 133120, SC_DC = SC_UT + 16384, SC_NW = SC_DC + 64;
__device__ __forceinline__ void scan_unit(const Params& p, const Frame& F, int bh) {
    LAS unsigned char* lds = F.lds;
    const int tid = F.tid, lane = F.lane, wave = F.wave, fr = lane & 15, fq = lane >> 4;
    const int b = bh >> 3, h = bh & 7;
    const unsigned char* dn = p.ws + WS_DN + (size_t)bh * 64 * DN_CHUNK;
    const bf16_t* proj = (const bf16_t*)(p.ws + WS_PROJ); bf16_t* cat = (bf16_t*)(p.ws + WS_HBUF);
    if (wave < 4) {
        LAS unsigned char* ST = lds + SC_ST + wave * 8704; LAS unsigned char* VT = lds + SC_VT + wave * 4608;
        f32x4 S[8][2];
#pragma unroll
        for (int a = 0; a < 8; ++a) { S[a][0] = (f32x4){0.f, 0.f, 0.f, 0.f}; S[a][1] = (f32x4){0.f, 0.f, 0.f, 0.f}; }
#define LDF(base, pitch, rt, s) (*(const LAS bf16x8*)(lds + (base) + (16 * (rt) + fr) * (pitch) + (32 * (s) + 8 * fq) * 2))
#define SCHED() __builtin_amdgcn_sched_barrier(0)
#define SSTEP(c) do { \
            _Pragma("unroll") for (int dkt = 0; dkt < 8; ++dkt) _Pragma("unroll") for (int dvt = 0; dvt < 2; ++dvt) *(LAS u32x2*)(ST + (16 * dvt + fr) * 272 + (16 * dkt + 4 * fq) * 2) = pack4(S[dkt][dvt]); \
            __syncthreads();                                                                       \
            bf16x8 bs[2][4], fa[8], fb[8]; \
            _Pragma("unroll") for (int dvt = 0; dvt < 2; ++dvt) _Pragma("unroll") for (int s = 0; s < 4; ++s) bs[dvt][s] = *(const LAS bf16x8*)(ST + (16 * dvt + fr) * 272 + (32 * s + 8 * fq) * 2); \
            _Pragma("unroll") for (int i = 0; i < 8; ++i) fa[i] = LDF(SC_W, 272, i >> 2, i & 3); \
            SCHED(); \
            f32x4 va[2][2], vb[2][2]; \
            const float DC = *(const LAS float*)(lds + SC_DC); \
            _Pragma("unroll") for (int it = 0; it < 2; ++it) _Pragma("unroll") for (int dvt = 0; dvt < 2; ++dvt) { \
                const u32x2 ua = *(const LAS u32x2*)(lds + SC_UT + (32 * wave + 16 * dvt + fr) * 128 + (16 * it + 4 * fq) * 2), ub = *(const LAS u32x2*)(lds + SC_UT + (32 * wave + 16 * dvt + fr) * 128 + (16 * (2 + it) + 4 * fq) * 2); \
                va[it][dvt] = (f32x4){bflo(ua.x), bfhi(ua.x), bflo(ua.y), bfhi(ua.y)}; vb[it][dvt] = (f32x4){bflo(ub.x), bfhi(ub.x), bflo(ub.y), bfhi(ub.y)}; } \
            _Pragma("unroll") for (int i = 0; i < 8; ++i) fb[i] = LDF(SC_W, 272, 2 + (i >> 2), i & 3); \
            SCHED(); \
            _Pragma("unroll") for (int i = 0; i < 8; ++i) { va[i >> 2][0] = mfma16(fa[i], bs[0][i & 3], va[i >> 2][0]); va[i >> 2][1] = mfma16(fa[i], bs[1][i & 3], va[i >> 2][1]); } \
            SCHED(); \
            _Pragma("unroll") for (int i = 0; i < 8; ++i) fa[i] = LDF(SC_KT, 144, i >> 1, i & 1); \
            _Pragma("unroll") for (int it = 0; it < 2; ++it) _Pragma("unroll") for (int dvt = 0; dvt < 2; ++dvt) *(LAS u32x2*)(VT + (16 * dvt + fr) * 144 + (16 * it + 4 * fq) * 2) = pack4(va[it][dvt]); \
            SCHED(); \
            _Pragma("unroll") for (int i = 0; i < 8; ++i) { vb[i >> 2][0] = mfma16(fb[i], bs[0][i & 3], vb[i >> 2][0]); vb[i >> 2][1] = mfma16(fb[i], bs[1][i & 3], vb[i >> 2][1]); } \
            _Pragma("unroll") for (int it = 0; it < 2; ++it) _Pragma("unroll") for (int dvt = 0; dvt < 2; ++dvt) *(LAS u32x2*)(VT + (16 * dvt + fr) * 144 + (16 * (2 + it) + 4 * fq) * 2) = pack4(vb[it][dvt]); \
            bf16x8 bv[2][2]; \
            _Pragma("unroll") for (int dvt = 0; dvt < 2; ++dvt) _Pragma("unroll") for (int s = 0; s < 2; ++s) bv[dvt][s] = *(const LAS bf16x8*)(VT + (16 * dvt + fr) * 144 + (32 * s + 8 * fq) * 2); \
            _Pragma("unroll") for (int i = 0; i < 8; ++i) fb[i] = LDF(SC_KT, 144, 4 + (i >> 1), i & 1); \
            SCHED(); \
            _Pragma("unroll") for (int dkt = 0; dkt < 8; ++dkt) { S[dkt][0] *= DC; S[dkt][1] *= DC; } \
            _Pragma("unroll") for (int i = 0; i < 8; ++i) { S[i >> 1][0] = mfma16(fa[i], bv[0][i & 1], S[i >> 1][0]); S[i >> 1][1] = mfma16(fa[i], bv[1][i & 1], S[i >> 1][1]); } \
            _Pragma("unroll") for (int i = 0; i < 8; ++i) { S[4 + (i >> 1)][0] = mfma16(fb[i], bv[0][i & 1], S[4 + (i >> 1)][0]); S[4 + (i >> 1)][1] = mfma16(fb[i], bv[1][i & 1], S[4 + (i >> 1)][1]); } \
            __syncthreads();                                                                       \
              \
            bf16x8 bq[2][4];                                                                       \
            _Pragma("unroll") for (int dvt = 0; dvt < 2; ++dvt) _Pragma("unroll") for (int s = 0; s < 4; ++s) bq[dvt][s] = *(const LAS bf16x8*)(ST + (16 * dvt + fr) * 272 + (32 * s + 8 * fq) * 2); \
            _Pragma("unroll") for (int i = 0; i < 4; ++i) fa[i] = LDF(SC_Q, 272, 0, i); \
            fa[4] = LDF(SC_QK, 144, 0, 0); fa[5] = LDF(SC_QK, 144, 0, 1); \
            _Pragma("unroll") for (int i = 0; i < 4; ++i) fb[i] = LDF(SC_Q, 272, 1, i); \
            fb[4] = LDF(SC_QK, 144, 1, 0); fb[5] = LDF(SC_QK, 144, 1, 1); \
            SCHED(); \
            _Pragma("unroll") for (int it = 0; it < 4; ++it) { \
                f32x4 o0 = {0.f, 0.f, 0.f, 0.f}, o1 = {0.f, 0.f, 0.f, 0.f}; \
                if ((it & 1) == 0) { \
                    _Pragma("unroll") for (int i = 0; i < 4; ++i) { o0 = mfma16(fa[i], bq[0][i], o0); o1 = mfma16(fa[i], bq[1][i], o1); } \
                    _Pragma("unroll") for (int i = 0; i < 2; ++i) { o0 = mfma16(fa[4 + i], bv[0][i], o0); o1 = mfma16(fa[4 + i], bv[1][i], o1); } \
                    SCHED(); \
                    if (it + 2 < 4) { _Pragma("unroll") for (int i = 0; i < 4; ++i) fa[i] = LDF(SC_Q, 272, it + 2, i); fa[4] = LDF(SC_QK, 144, it + 2, 0); fa[5] = LDF(SC_QK, 144, it + 2, 1); } \
                } else { \
                    _Pragma("unroll") for (int i = 0; i < 4; ++i) { o0 = mfma16(fb[i], bq[0][i], o0); o1 = mfma16(fb[i], bq[1][i], o1); } \
                    _Pragma("unroll") for (int i = 0; i < 2; ++i) { o0 = mfma16(fb[4 + i], bv[0][i], o0); o1 = mfma16(fb[4 + i], bv[1][i], o1); } \
                    SCHED(); \
                    if (it + 2 < 4) { _Pragma("unroll") for (int i = 0; i < 4; ++i) fb[i] = LDF(SC_Q, 272, it + 2, i); fb[4] = LDF(SC_QK, 144, it + 2, 0); fb[5] = LDF(SC_QK, 144, it + 2, 1); } \
                } \
                _Pragma("unroll") for (int e = 0; e < 4; ++e) { const int i_ = 16 * it + 4 * fq + e; \
                    *(LAS bf16_t*)(lds + SC_OB + i_ * 272 + (32 * wave + fr) * 2) = f2bf(o0[e]); *(LAS bf16_t*)(lds + SC_OB + i_ * 272 + (32 * wave + 16 + fr) * 2) = f2bf(o1[e]); } \
                SCHED(); \
            } } while (0)
#pragma unroll 1
        for (int c2 = 0; c2 < 64; ++c2) { SSTEP(c2); }
#undef SSTEP
#undef LDF
#undef SCHED
        __syncthreads();
    } else {
        const int ht = tid - 256;
        u32x4 ra0[9], ra1[9], rb0[7], ru0[4], ru1[4]; float rd0, rd1;
#define LOADA(ra, ru, rd, cc) do { const int cc_ = (cc) < 64 ? (cc) : 63; const unsigned char* s_ = dn + (size_t)cc_ * DN_CHUNK; \
        _Pragma("unroll") for (int i = 0; i < 9; ++i) ra[i] = *(const u32x4*)(s_ + DN_W + (size_t)(ht + 256 * i) * 16); \
        _Pragma("unroll") for (int i = 0; i < 4; ++i) ru[i] = *(const u32x4*)(s_ + DN_UT + (size_t)(ht + 256 * i) * 16); rd = *(const float*)(s_ + DN_MISC); } while (0)
#define WRITEA(ra, ru, rd) do { _Pragma("unroll") for (int i = 0; i < 9; ++i) if (i < 8 || ht < 192) *(LAS u32x4*)(lds + SC_W + (ht + 256 * i) * 16) = ra[i]; \
        _Pragma("unroll") for (int i = 0; i < 4; ++i) *(LAS u32x4*)(lds + SC_UT + (ht + 256 * i) * 16) = ru[i]; if (ht == 0) *(LAS float*)(lds + SC_DC) = rd; } while (0)
#define LOADB(rb, cc) do { const int cc_ = (cc) < 64 ? (cc) : 63; const unsigned char* s_ = dn + (size_t)cc_ * DN_CHUNK + DN_Q; _Pragma("unroll") for (int i = 0; i < 7; ++i) rb[i] = *(const u32x4*)(s_ + (size_t)(ht + 256 * i) * 16); } while (0)
#define WRITEB(rb) do { _Pragma("unroll") for (int i = 0; i < 7; ++i) if (i < 6 || ht < 128) *(LAS u32x4*)(lds + SC_Q + (ht + 256 * i) * 16) = rb[i]; } while (0)
        LOADA(ra0, ru0, rd0, 0); WRITEA(ra0, ru0, rd0); LOADA(ra1, ru1, rd1, 1); LOADA(ra0, ru0, rd0, 2); LOADB(rb0, 0);
        const int ei = ht >> 2, ecg = ht & 3;
        const bf16_t* zbase = proj + (size_t)(b * SEQ + ei) * LDP + PZ + h * HD + 32 * ecg;
        if (ht < 32) *(LAS f32x4*)(lds + SC_NW + ht * 16) = *(const f32x4*)(p.norm_w + 4 * ht);
        u32x4 zr0[4];
#pragma unroll
        for (int k = 0; k < 4; ++k) zr0[k] = *(const u32x4*)(zbase + 8 * k);
#define EPILOG(ce) do { \
                const int row = b * SEQ + (ce) * 64 + ei; \
                float ss = 0.f; \
                _Pragma("unroll") for (int k = 0; k < 4; ++k) { float o[8]; unpack8(*(const LAS u32x4*)(lds + SC_OB + ei * 272 + (32 * ecg + 8 * k) * 2), o); \
                    _Pragma("unroll") for (int e = 0; e < 8; ++e) ss += o[e] * o[e]; } \
                ss += __shfl_xor(ss, 1); ss += __shfl_xor(ss, 2); \
                const float rs = rsqrtf(ss * (1.f / 128.f) + NORM_EPS); \
                bf16_t* op = cat + (size_t)row * DM + h * HD + 32 * ecg; \
                _Pragma("unroll") for (int k = 0; k < 4; ++k) { float z[8], o[8]; unpack8(zr0[k], z); unpack8(*(const LAS u32x4*)(lds + SC_OB + ei * 272 + (32 * ecg + 8 * k) * 2), o); float r[8]; \
                    const f32x4 nw0 = *(const LAS f32x4*)(lds + SC_NW + (32 * ecg + 8 * k) * 4), nw1 = *(const LAS f32x4*)(lds + SC_NW + (32 * ecg + 8 * k + 4) * 4); \
                    _Pragma("unroll") for (int e = 0; e < 8; ++e) r[e] = o[e] * rs * (e < 4 ? nw0[e] : nw1[e - 4]) * silu_f(z[e]); \
                    *(bf16x8*)(op + 8 * k) = pack8((f32x4){r[0], r[1], r[2], r[3]}, (f32x4){r[4], r[5], r[6], r[7]}); } } while (0)
#define HSTEP(c, RBX, RAY, RUY, RDY) do { \
            __syncthreads();                                                                       \
            WRITEB(RBX); LOADB(RBX, (c) + 1); \
            { const int ce = (c) > 0 ? (c) - 1 : 0; EPILOG(ce); } \
            { _Pragma("unroll") for (int k = 0; k < 4; ++k) zr0[k] = *(const u32x4*)(zbase + (size_t)(c) * 64 * LDP + 8 * k); }     \
            __syncthreads();                                                                       \
            WRITEA(RAY, RUY, RDY); LOADA(RAY, RUY, RDY, (c) + 3); \
            } while (0)
#pragma unroll 1
        for (int c2 = 0; c2 < 64; c2 += 2) { HSTEP(c2, rb0, ra1, ru1, rd1); HSTEP(c2 + 1, rb0, ra0, ru0, rd0); }
        __syncthreads();
        EPILOG(63);
#undef HSTEP
#undef EPILOG
#undef LOADA
#undef WRITEA
#undef LOADB
#undef WRITEB
    }
    __syncthreads();
}

namespace fox {
constexpr int D = 128, NW = 8, QBLK = 32, KVBLK = 64, QB = NW * QBLK;
constexpr int SHM_V = KVBLK * D * 2, SHM_K = KVBLK * D * 2;
constexpr int OFF_WS = 2 * SHM_V + 2 * SHM_K, OFF_BIAS = OFF_WS + NW * 64 * 4, OFF_Q = OFF_BIAS + 2 * 64 * 4, LDS_NEED = OFF_Q + NW * 8192;
constexpr float SCALE = 0.08838834764831845f, INV_SCALE = 11.313708498984761f, THR = 8.f;
constexpr int W = SEQ;
#define KSWZ(row, colB) ((row) * 256 + ((colB) ^ (((row) & 7) << 4)))
#define SBAR() __builtin_amdgcn_sched_barrier(0)
__device__ __forceinline__ int v_st(int k, int c) { const int kk = (k & ~0xC) | ((k & 4) << 1) | ((k & 8) >> 1); return ((kk >> 3) * 4 + (c >> 5)) * 512 + ((kk & 7) * 32 + (c & 31)) * 2; }
__device__ __forceinline__ int v_rd_base(int lane) { return ((lane & 3) << 3) | (((lane >> 2) & 3) << 6) | (((lane >> 4) & 1) << 5) | (((lane >> 5) & 1) << 8); }
constexpr int v_rd_off(int d0, int ks, int half) { return d0 * 512 + ks * 4096 + half * 2048; }
__device__ __forceinline__ int crow(int r, int hi) { return (r & 3) + 8 * (r >> 2) + 4 * hi; }
__device__ __forceinline__ void mask_tile(f32x16& p0, f32x16& p1, int dq, unsigned Wm) {
    const float NEG = -__builtin_inff();
#pragma unroll
    for (int r = 0; r < 16; ++r) {
        const int c = (r & 3) + 8 * (r >> 2);
        if ((unsigned)(dq - c) >= Wm) p0[r] = NEG;
        if ((unsigned)(dq - c - 32) >= Wm) p1[r] = NEG;
    }
}
__device__ __forceinline__ void partialSM(f32x16& p0, f32x16& p1, float& m_reg, float& mn, float& alpha) {
    float pmax = p0[0]; for (int r = 1; r < 16; ++r) pmax = fmaxf(pmax, p0[r]); for (int r = 0; r < 16; ++r) pmax = fmaxf(pmax, p1[r]);
    { auto rr = __builtin_amdgcn_permlane32_swap(__float_as_uint(pmax), __float_as_uint(pmax), false, false);
      pmax = fmaxf(__uint_as_float(rr[0]), __uint_as_float(rr[1])); }
    constexpr float C2 = 1.4426950408889634f * SCALE;
    if (__builtin_expect(__all((pmax - m_reg) * SCALE <= THR), 1)) { mn = m_reg; alpha = 1.f; }
    else { mn = fmaxf(m_reg, pmax); alpha = __builtin_amdgcn_exp2f((m_reg - mn) * C2); m_reg = mn; }
    const float mnL = -mn * C2;
    for (int r = 0; r < 16; ++r) p0[r] = fmaf(p0[r], C2, mnL); for (int r = 0; r < 16; ++r) p1[r] = fmaf(p1[r], C2, mnL);
    for (int r = 0; r < 16; ++r) p0[r] = __builtin_amdgcn_exp2f(p0[r]);
}
__device__ __forceinline__ void finishSM(f32x16& p0, f32x16& p1, float alpha, float& l_reg, bf16x8& pa0, bf16x8& pa1, bf16x8& pa2, bf16x8& pa3) {
    for (int r = 0; r < 16; ++r) p1[r] = __builtin_amdgcn_exp2f(p1[r]);
    float ps = 0; for (int r = 0; r < 16; ++r) ps += p0[r]; for (int r = 0; r < 16; ++r) ps += p1[r];
    { auto rr = __builtin_amdgcn_permlane32_swap(__float_as_uint(ps), __float_as_uint(ps), false, false);
      ps = __uint_as_float(rr[0]) + __uint_as_float(rr[1]); }
    l_reg = l_reg * alpha + ps;
#define PK4(P, B_, OUT) do { unsigned a0 = cvtpk(P[B_+0], P[B_+1]), a1 = cvtpk(P[B_+2], P[B_+3]);                          \
        unsigned b0 = cvtpk(P[B_+4], P[B_+5]), b1 = cvtpk(P[B_+6], P[B_+7]);                                             \
        auto r0 = __builtin_amdgcn_permlane32_swap(a0, b0, false, false); auto r1 = __builtin_amdgcn_permlane32_swap(a1, b1, false, false); \
        u32x4 w = {r0[0], r1[0], r0[1], r1[1]}; OUT = *reinterpret_cast<bf16x8*>(&w); } while (0)
    PK4(p0, 0, pa0); PK4(p0, 8, pa1); PK4(p1, 0, pa2); PK4(p1, 8, pa3);
#undef PK4
}
template <int KB>
__device__ __forceinline__ void qkt(f32x16& p0, f32x16& p1, const char* K_lds, const char* bias_lds, int r32, int hi, const char* qf) {
    const char* bb = bias_lds + KB * 256 + hi * 16;
#pragma unroll
    for (int g = 0; g < 4; ++g) { const f32x4 b0 = *reinterpret_cast<const f32x4*>(bb + g * 32), b1 = *reinterpret_cast<const f32x4*>(bb + 128 + g * 32);
        p0[4 * g] = b0[0]; p0[4 * g + 1] = b0[1]; p0[4 * g + 2] = b0[2]; p0[4 * g + 3] = b0[3];
        p1[4 * g] = b1[0]; p1[4 * g + 1] = b1[1]; p1[4 * g + 2] = b1[2]; p1[4 * g + 3] = b1[3]; }
    const char* kb[4];
#pragma unroll
    for (int dd = 0; dd < 4; ++dd) kb[dd] = K_lds + KB * SHM_K + KSWZ(r32, (dd * 16 + hi * 8) * 2);
#pragma unroll
    for (int d0 = 0; d0 < 8; ++d0) { const char* a = kb[d0 & 3] + (d0 >> 2) * 128;
        bf16x8 b0 = *reinterpret_cast<const bf16x8*>(a);
        bf16x8 b1 = *reinterpret_cast<const bf16x8*>(a + 32 * 256);
        const bf16x8 q = *reinterpret_cast<const bf16x8*>(qf + d0 * 1024);
        p0 = __builtin_amdgcn_mfma_f32_32x32x16_bf16(b0, q, p0, 0, 0, 0);
        p1 = __builtin_amdgcn_mfma_f32_32x32x16_bf16(b1, q, p1, 0, 0, 0); }
}
template <int VB>
__device__ __forceinline__ void pv_tile(f32x16* o, int vb0, bf16x8 pa0, bf16x8 pa1, bf16x8 pa2, bf16x8 pa3) {
#define PV_D0(d0) do { constexpr int b_ = VB * SHM_V + v_rd_off(d0, 0, 0); \
        { s16x4 l0, l1, h0, h1; TRRD(l0, vb0, b_); TRRD(h0, vb0, b_ + 2048); TRRD(l1, vb0, b_ + 4096); TRRD(h1, vb0, b_ + 6144); \
        asm volatile("s_waitcnt lgkmcnt(0)" ::: "memory"); SBAR();   \
        o[d0] = __builtin_amdgcn_mfma_f32_32x32x16_bf16(pa0, join8(l0, h0), o[d0], 0, 0, 0);   \
        o[d0] = __builtin_amdgcn_mfma_f32_32x32x16_bf16(pa1, join8(l1, h1), o[d0], 0, 0, 0); }   \
        { s16x4 l2, l3, h2, h3; TRRD(l2, vb0, b_ + 8192); TRRD(h2, vb0, b_ + 10240); TRRD(l3, vb0, b_ + 12288); TRRD(h3, vb0, b_ + 14336); \
        asm volatile("s_waitcnt lgkmcnt(0)" ::: "memory"); SBAR();   \
        o[d0] = __builtin_amdgcn_mfma_f32_32x32x16_bf16(pa2, join8(l2, h2), o[d0], 0, 0, 0);   \
        o[d0] = __builtin_amdgcn_mfma_f32_32x32x16_bf16(pa3, join8(l3, h3), o[d0], 0, 0, 0); } } while (0)
    PV_D0(0); PV_D0(1); PV_D0(2); PV_D0(3);
#undef PV_D0
}
struct BlockRef { int bh, qb, jlo; };
__device__ __forceinline__ const bf16_t* ref_Q(unsigned char* ws, BlockRef r) { return (const bf16_t*)(ws + WS_PROJ) + (size_t)((r.bh >> 3) * SEQ + r.qb * QB) * LDP + FQ + (r.bh & 7) * HD; }
__device__ __forceinline__ const bf16_t* ref_K(unsigned char* ws, BlockRef r) { return (const bf16_t*)(ws + WS_PROJ) + (size_t)((r.bh >> 3) * SEQ) * LDP + FK + (r.bh & 7) * HD; }
__device__ __forceinline__ bf16_t* ref_O(unsigned char* ws, BlockRef r) { return (bf16_t*)(ws + WS_HBUF) + (size_t)((r.bh >> 3) * SEQ + r.qb * QB) * DM + 1024 + (r.bh & 7) * HD; }
__device__ __forceinline__ const float* ref_F(unsigned char* ws, BlockRef r) { return (const float*)(ws + WS_FCUM) + (size_t)r.bh * SEQ; }
struct Seam { bf16x8 qr[8]; bf16x8 st_v0, st_v1, st_k0, st_k1; };
#define ROW(p_, k0, rr) ((p_) + (unsigned)(((k0) + (rr)) * LDP + sc))
#define VMWN(n) asm volatile("s_waitcnt vmcnt(%0)" :: "i"(n) : "memory")
#define LD8(ptr) (*reinterpret_cast<const bf16x8*>(ptr))
#define SLOAD_H(Kp, Vp, Fp, k0, bf) do { const bf16_t* r0_ = ROW(Kp, k0, sr); const bf16_t* r1_ = ROW(Kp, k0, 32 + sr);             \
                         S.st_v0 = LD8(r0_ + (FV - FK)); S.st_v1 = LD8(r1_ + (FV - FK)); S.st_k0 = LD8(r0_); S.st_k1 = LD8(r1_); \
                         if (wid == 0) __builtin_amdgcn_global_load_lds((const unsigned*)((Fp) + (k0) + lane), (LAS unsigned*)(lds_las + OFF_BIAS + (bf) * 256), 4, 0, 0); } while (0)
#define SWRITE_HK(bf) do { *(bf16x8*)(K_lds + (bf) * SHM_K + kws) = S.st_k0; *(bf16x8*)(K_lds + (bf) * SHM_K + kws + 32 * 256) = S.st_k1; } while (0)
#define SWRITE_HV(bf) do { *(bf16x8*)(V_lds + (bf) * SHM_V + vst0) = S.st_v0; *(bf16x8*)(V_lds + (bf) * SHM_V + vst1) = S.st_v1; } while (0)
#define SWRITE_H(bf) do { SWRITE_HV(bf); SWRITE_HK(bf); } while (0)
__device__ __forceinline__ void prime(unsigned char* wsb, const BlockRef cur, char* lds, LAS unsigned char* lds_las, Seam& S, int wv) {
    const int wid = wv, lane = lane_id(), tid = wid * 64 + lane, r32 = lane & 31, hi = lane >> 5;
    const int sr = tid >> 4, sc = (tid & 15) * 8, kws = KSWZ(sr, sc * 2); char* K_lds = lds + 2 * SHM_V; char* bias_lds = lds + OFF_BIAS;
    { const bf16_t* q_ = ref_Q(wsb, cur); for (int d0 = 0; d0 < 8; ++d0) S.qr[d0] = LD8(q_ + (unsigned)((wid * QBLK + r32) * LDP + d0 * 16 + hi * 8)); }
    SLOAD_H(ref_K(wsb, cur), 0, ref_F(wsb, cur), cur.jlo * KVBLK, 0); VM0(); SWRITE_HK(0);
    for (int d0 = 0; d0 < 8; ++d0) *(bf16x8*)(lds + OFF_Q + wid * 8192 + d0 * 1024 + lane * 16) = S.qr[d0];
    __syncthreads();
}
__device__ __forceinline__ void block(unsigned char* wsb, const BlockRef cur, const BlockRef nxt, char* lds, LAS unsigned char* lds_las, Seam& S, int wv) {
    const int wid = wv, lane = lane_id(), tid = wid * 64 + lane, r32 = lane & 31, hi = lane >> 5;
    const int P0 = cur.qb * QB;
    const int j_hi = (P0 + QB - 1) / KVBLK + 1, j_lo = cur.jlo;
    const int NT = j_hi - j_lo;
    const int qlo = P0 + wid * QBLK, qm = qlo + r32 - 4 * hi;
    char* V_lds = lds; char* K_lds = lds + 2 * SHM_V; char* bias_lds = lds + OFF_BIAS; const char* qf = lds + OFF_Q + wid * 8192 + lane * 16;
    float* ws = (float*)(lds + OFF_WS) + wid * 64; float* li_l = ws, * al_l = ws + 32;
    float m_reg = -1e30f, l_reg = 0; f32x16 o[4] = {};
    const int sr = tid >> 4, sc = (tid & 15) * 8, vst0 = v_st(sr, sc), vst1 = v_st(32 + sr, sc), kws = KSWZ(sr, sc * 2);
    const int vb0 = (int)(uintptr_t)V_lds + v_rd_base(lane);
    const bf16_t* Kh = ref_K(wsb, cur); const float* Fh = ref_F(wsb, cur);
#define RESC(a) do { if (__any((a) < 1.f)) { if (hi == 0) al_l[r32] = (a); asm volatile("s_waitcnt lgkmcnt(0)" ::: "memory");              \
                     for (int d_ = 0; d_ < 4; ++d_) for (int r = 0; r < 16; ++r) o[d_][r] *= al_l[crow(r, hi)]; } } while (0)
#define KBASE(t) ((j_lo + (t)) * KVBLK)
#define MASKT(P0_, P1_, t) do { const int kb_ = KBASE(t); if (kb_ + KVBLK - 1 > qlo) mask_tile(P0_, P1_, qm - kb_, (unsigned)W); } while (0)
    constexpr int NQL = 8;
#define SEAM_K0() do { VMWN(NQL); SWRITE_HK(0); SBAR(); } while (0)
    f32x16 pA0, pA1, pB0, pB1; float mnA, mnB, alA, alB; bf16x8 pa0, pa1, pa2, pa3;
    SWRITE_HV(0); SBAR();
    if (NT > 1) { SLOAD_H(Kh, 0, Fh, KBASE(1), 1); }
    SBAR(); qkt<0>(pA0, pA1, K_lds, bias_lds, r32, hi, qf);
    MASKT(pA0, pA1, 0); partialSM(pA0, pA1, m_reg, mnA, alA);
    if (NT > 1) { VM0(); SWRITE_H(1); }
    __syncthreads();
#define HALF_STEP(PX0, PX1, mnX, alX, PY0, PY1, alY, t, KB, VB, SB) do {                                                      \
        SBAR(); qkt<KB>(PX0, PX1, K_lds, bias_lds, r32, hi, qf);                                             \
        finishSM(PY0, PY1, alY, l_reg, pa0, pa1, pa2, pa3); SBAR();                                                           \
        if ((t) + 1 < NT) { SLOAD_H(Kh, 0, Fh, KBASE((t) + 1), SB); SBAR(); }                                               \
        pv_tile<VB>(o, vb0, pa0, pa1, pa2, pa3); MASKT(PX0, PX1, (t)); partialSM(PX0, PX1, m_reg, mnX, alX);                                        \
        __syncthreads();                                                                                                      \
        if ((t) + 1 < NT) { VM0(); SWRITE_H(SB); }                                                                          \
        RESC(alX); __syncthreads(); } while (0)
    for (int t = 1; t + 1 < NT; t += 2) {
        HALF_STEP(pB0, pB1, mnB, alB, pA0, pA1, alA, t, 1, 0, 0);
        HALF_STEP(pA0, pA1, mnA, alA, pB0, pB1, alB, t + 1, 0, 1, 1);
    }
    const bool even = (NT & 1) == 0;
    if (even) { SBAR(); qkt<1>(pB0, pB1, K_lds, bias_lds, r32, hi, qf); SBAR(); }
    SLOAD_H(ref_K(wsb, nxt), 0, ref_F(wsb, nxt), nxt.jlo * KVBLK, 0); SBAR();
    { const bf16_t* q_ = ref_Q(wsb, nxt);
#pragma unroll
    for (int d0 = 0; d0 < 8; ++d0) S.qr[d0] = LD8(q_ + (unsigned)((wid * QBLK + r32) * LDP + d0 * 16 + hi * 8)); }
    SBAR();
    finishSM(pA0, pA1, alA, l_reg, pa0, pa1, pa2, pa3); SBAR();
    pv_tile<0>(o, vb0, pa0, pa1, pa2, pa3);
    if (even) { MASKT(pB0, pB1, NT - 1); partialSM(pB0, pB1, m_reg, mnB, alB); __syncthreads(); RESC(alB);
        finishSM(pB0, pB1, alB, l_reg, pa0, pa1, pa2, pa3); SBAR(); pv_tile<1>(o, vb0, pa0, pa1, pa2, pa3); }
    SBAR(); SEAM_K0();
    if (hi == 0) li_l[r32] = l_reg; asm volatile("s_waitcnt lgkmcnt(0)" ::: "memory");
    float rli[16];
#pragma unroll
    for (int r = 0; r < 16; ++r) rli[r] = __builtin_amdgcn_rcpf(li_l[crow(r, hi)]);
    bf16_t* Ow = ref_O(wsb, cur) + (size_t)(wid * QBLK) * DM;
#pragma unroll
    for (int r = 0; r < 16; ++r) { const int orow = crow(r, hi);
#pragma unroll
        for (int d0 = 0; d0 < 4; ++d0) { const float v = o[d0][r] * rli[r];
            const float vn = __shfl_xor(v, 1);
            if ((r32 & 1) == 0) *(unsigned*)(Ow + (unsigned)(orow * DM + d0 * 32 + r32)) = cvtpk(v, vn); } }
#pragma unroll
    for (int d0 = 0; d0 < 8; ++d0) *(bf16x8*)(lds + OFF_Q + wid * 8192 + d0 * 1024 + lane * 16) = S.qr[d0];
    __syncthreads();
#undef RESC
#undef KBASE
#undef MASKT
#undef SEAM_K0
#undef HALF_STEP
}
#undef ROW
#undef VMWN
#undef SLOAD_H
#undef SWRITE_HK
#undef SWRITE_HV
#undef SWRITE_H
#undef LD8
}

__device__ __forceinline__ int attn_pull(unsigned* qbase, int& qx, int x0, bool& dead) {
    if (dead) return -1;
    for (;;) {
        const int k = (int)__hip_atomic_fetch_add(qbase + 64 * qx, 1u, __ATOMIC_RELAXED, __HIP_MEMORY_SCOPE_AGENT);
        if (k < 128) return qx * 128 + k;
        qx = (qx + 1) & 7; if (qx == x0) { dead = true; return -1; }
    }
}
__device__ __forceinline__ int fox_jlo(const Params& p, int bh, int qb, int lane) {
    const float* Bv = (const float*)(p.ws + WS_FCUM) + (size_t)bh * SEQ;
    const unsigned* mx = (const unsigned*)(p.ws + WS_CTL) + CW_QKMAX + 2 * bh;
    const float q2 = __uint_as_float(__hip_atomic_load(mx, __ATOMIC_RELAXED, __HIP_MEMORY_SCOPE_AGENT)), k2 = __uint_as_float(__hip_atomic_load(mx + 1, __ATOMIC_RELAXED, __HIP_MEMORY_SCOPE_AGENT));
    const float thr = (40.f + 2.f * fox::SCALE * sqrtf(q2 * k2) * 1.01f) * fox::INV_SCALE;
    const float b1 = Bv[64 * lane + 63], b0 = Bv[qb * fox::QB];
    const unsigned long long m = __ballot(b1 < b0 - thr);
    return __builtin_popcountll(m);
}
__device__ __forceinline__ fox::BlockRef attn_ref(const Params& p, int item, int lane) { fox::BlockRef r; const int x = item >> 7, k = item & 127; r.bh = 8 * x + (k & 7); r.qb = 15 - (k >> 3);
    r.jlo = __builtin_amdgcn_readfirstlane(fox_jlo(p, r.bh, r.qb, lane)); return r; }
__device__ __forceinline__ void p4_attention(const Params& p, const Frame& F, char* lds_generic) {
    using namespace fox;
    unsigned* qbase = (unsigned*)(p.ws + WS_CTL) + CW_QUEUE;
    volatile LAS int* qslot = (volatile LAS int*)(F.lds + LDS_MISC + 64);
    const int x0 = (int)(xb_xcc_id() & 7u); int qx = x0; bool dead = false;
    if (F.tid == 0) { qslot[0] = attn_pull(qbase, qx, x0, dead); qslot[1] = attn_pull(qbase, qx, x0, dead); }
    __syncthreads();
    int L = qslot[0], Ln = qslot[1];
    if (L < 0) { __syncthreads(); return; }
    BlockRef cur = attn_ref(p, L, F.lane);
    Seam S;
    prime(p.ws, cur, lds_generic, F.lds, S, F.wave);
    for (int it = 0;; ++it) {
        const bool last = Ln < 0;
        const BlockRef nxt = last ? cur : attn_ref(p, Ln, F.lane);
        if (F.tid == 0) qslot[it & 1] = attn_pull(qbase, qx, x0, dead);
        block(p.ws, cur, nxt, lds_generic, F.lds, S, F.wave);
        if (last) break;
        cur = nxt; L = Ln; Ln = qslot[it & 1];
    }
    __syncthreads();
}

constexpr int L1_G1P = 0, L1_LNG = 8192, L1_LNB = 16384, L1_SC2P = 24576, L1_SH2 = 32768, L1_LG = 40960;
__device__ __forceinline__ void p6_ln1_router(const Params& p, const Frame& F) {
    const float* mod = (const float*)(p.ws + WS_MOD); const bf16_t* y1 = (const bf16_t*)(p.ws + WS_Y1); bf16_t* x1 = (bf16_t*)(p.ws + WS_X1); bf16_t* h2 = (bf16_t*)(p.ws + WS_H2);
    const bf16_t* rw = (const bf16_t*)(p.ws + WS_RTW); unsigned char* h2f8 = p.ws + WS_H2F8;
    unsigned* cnt = (unsigned*)(p.ws + WS_CTL) + CW_CNT;
    int* rt_e = (int*)(p.ws + WS_RT + RT_E); float* rt_w = (float*)(p.ws + WS_RT + RT_W); int* rt_pos = (int*)(p.ws + WS_RT + RT_POS); int* elist = (int*)(p.ws + WS_ELIST);
    LAS float* lg = (LAS float*)(F.lds + L1_LG + F.wave * 4096);
    const int fr = F.lane & 15, fq = F.lane >> 4;
    int bcur = -1;
    for (int g0 = F.bid; g0 < NTOK / 128; g0 += F.G) {
        const int b = (g0 * 128) / SEQ;
        if (b != bcur) { __syncthreads(); bcur = b; const float* mb = mod + (size_t)b * (6 * DM);
            for (unsigned i = (unsigned)F.tid; i < (unsigned)DM; i += 512u) { LAS float* L = (LAS float*)F.lds; const float* m2 = mb + 2 * DM; const float* m3 = mb + 3 * DM; const float* m4 = mb + 4 * DM;
                L[L1_G1P / 4 + i] = 1.f + m2[i]; L[L1_LNG / 4 + i] = p.ln1_g[i]; L[L1_LNB / 4 + i] = p.ln1_b[i]; L[L1_SC2P / 4 + i] = 1.f + m4[i]; L[L1_SH2 / 4 + i] = m3[i]; }
            __syncthreads(); }
        const int row0 = g0 * 128 + F.wave * 16;
#pragma unroll 1
        for (int pr = 0; pr < 8; ++pr) {
            f32x4 xa[2][8]; u32x4 ya[2][4];
#pragma unroll
            for (int r = 0; r < 2; ++r)
#pragma unroll
                for (int i = 0; i < 4; ++i) { const size_t o = (size_t)(row0 + 2 * pr + r) * DM + i * 512 + F.lane * 8;
                    xa[r][2 * i] = __builtin_nontemporal_load((const f32x4*)(p.x + o)); xa[r][2 * i + 1] = __builtin_nontemporal_load((const f32x4*)(p.x + o + 4)); ya[r][i] = *(const u32x4*)(y1 + o); }
#pragma unroll
            for (int r = 0; r < 2; ++r) {
                float v[32]; float s = 0.f;
#pragma unroll
                for (int i = 0; i < 4; ++i) { const int col = i * 512 + F.lane * 8; float yf[8]; unpack8(ya[r][i], yf);
                    const f32x4 ga = *(const LAS f32x4*)(F.lds + L1_G1P + col * 4), gb = *(const LAS f32x4*)(F.lds + L1_G1P + col * 4 + 16);
#pragma unroll
                    for (int e = 0; e < 4; ++e) { v[i * 8 + e] = ALPHA * xa[r][2 * i][e] + ga[e] * yf[e]; v[i * 8 + 4 + e] = ALPHA * xa[r][2 * i + 1][e] + gb[e] * yf[4 + e]; }
#pragma unroll
                    for (int e = 0; e < 8; ++e) s += v[i * 8 + e]; }
                const float mean = wave_sum(s) * (1.f / DM);
                float q = 0.f;
#pragma unroll
                for (int k = 0; k < 32; ++k) { const float d = v[k] - mean; q += d * d; }
                const float rstd = rsqrtf(wave_sum(q) * (1.f / DM) + LN_EPS);
#pragma unroll
                for (int i = 0; i < 4; ++i) { const int col = i * 512 + F.lane * 8; const size_t o = (size_t)(row0 + 2 * pr + r) * DM + col;
                    const f32x4 g0v = *(const LAS f32x4*)(F.lds + L1_LNG + col * 4), g1v = *(const LAS f32x4*)(F.lds + L1_LNG + col * 4 + 16), b0 = *(const LAS f32x4*)(F.lds + L1_LNB + col * 4), b1 = *(const LAS f32x4*)(F.lds + L1_LNB + col * 4 + 16);
                    const f32x4 c0 = *(const LAS f32x4*)(F.lds + L1_SC2P + col * 4), c1 = *(const LAS f32x4*)(F.lds + L1_SC2P + col * 4 + 16), s0 = *(const LAS f32x4*)(F.lds + L1_SH2 + col * 4), s1 = *(const LAS f32x4*)(F.lds + L1_SH2 + col * 4 + 16);
                    f32x4 o0, o1, h0, h1;
#pragma unroll
                    for (int e = 0; e < 4; ++e) { o0[e] = (v[i * 8 + e] - mean) * rstd * g0v[e] + b0[e]; o1[e] = (v[i * 8 + 4 + e] - mean) * rstd * g1v[e] + b1[e];
                        h0[e] = o0[e] * c0[e] + s0[e]; h1[e] = o1[e] * c1[e] + s1[e]; }
                    __builtin_nontemporal_store(pack8(o0, o1), (bf16x8*)(x1 + o));
                    *(bf16x8*)(h2 + o) = pack8(h0, h1); }
                __builtin_amdgcn_sched_barrier(0);
            }
        }
        VM0();
        f32x4 acc[3]; acc[0] = acc[1] = acc[2] = (f32x4){0.f, 0.f, 0.f, 0.f};
        const bf16_t* ar = h2 + (size_t)(row0 + fr) * DM + 8 * fq;
#pragma unroll 2
        for (int s_ = 0; s_ < 64; ++s_) {
            const bf16x8 a = *(const bf16x8*)(ar + 32 * s_);
            { float af[8]; unpack8(*reinterpret_cast<const u32x4*>(&a), af);
              *(u32x2*)(h2f8 + (unsigned)((row0 + fr) * DM + 32 * s_ + 8 * fq)) = (u32x2){pack_fp8x4(af[0], af[1], af[2], af[3]), pack_fp8x4(af[4], af[5], af[6], af[7])}; }
#pragma unroll
            for (int ct = 0; ct < 3; ++ct) { const bf16_t* bp = rw + (size_t)(16 * ct + fr) * DM + 32 * s_ + 8 * fq;
                acc[ct] = mfma16(a, *(const bf16x8*)bp, acc[ct]); acc[ct] = mfma16(a, *(const bf16x8*)(bp + 48 * DM), acc[ct]); }
        }
#pragma unroll
        for (int ct = 0; ct < 3; ++ct)
#pragma unroll
            for (int j = 0; j < 4; ++j) lg[(4 * fq + j) * 48 + 16 * ct + fr] = acc[ct][j];
        asm volatile("s_waitcnt lgkmcnt(0)" ::: "memory");
        if (F.lane < 16) {
            const int t = row0 + F.lane; const LAS float* l = lg + F.lane * 48;
            float gl[4];
#pragma unroll
            for (int g = 0; g < 4; ++g) gl[g] = l[g] + p.b_rg[g];
            float gm = gl[0]; int gi = 0;
#pragma unroll
            for (int g = 1; g < 4; ++g) if (gl[g] > gm) { gm = gl[g]; gi = g; }
            float gs = 0.f;
#pragma unroll
            for (int g = 0; g < 4; ++g) gs += __expf(gl[g] - gm);
            const float gw = 1.f / gs;
            float el[8];
#pragma unroll
            for (int e = 0; e < 8; ++e) el[e] = l[4 + 8 * gi + e] + p.b_re[8 * gi + e];
            float m0 = el[0]; int e0 = 0;
#pragma unroll
            for (int e = 1; e < 8; ++e) if (el[e] > m0) { m0 = el[e]; e0 = e; }
            float m1 = -__builtin_inff(); int e1 = 0;
#pragma unroll
            for (int e = 0; e < 8; ++e) if (e != e0 && el[e] > m1) { m1 = el[e]; e1 = e; }
            const float p1 = __expf(m1 - m0); const float w0 = gw / (1.f + p1), w1 = gw * p1 / (1.f + p1);
            const int x0 = 8 * gi + e0, x1i = 8 * gi + e1;
            const unsigned q0 = atomicAdd(cnt + x0, 1u), q1 = atomicAdd(cnt + x1i, 1u);
            rt_e[2 * t] = x0; rt_e[2 * t + 1] = x1i; rt_w[2 * t] = w0; rt_w[2 * t + 1] = w1; rt_pos[2 * t] = (int)q0; rt_pos[2 * t + 1] = (int)q1;
            elist[(unsigned)x0 * (unsigned)NTOK + q0] = t; elist[(unsigned)x1i * (unsigned)NTOK + q1] = t;
        }
    }
    __syncthreads();
}
__device__ __forceinline__ void slot_prefix(const Params& p, const Frame& F, LAS int* ps) {
    if (F.tid == 0) { const unsigned* cnt = (const unsigned*)(p.ws + WS_CTL) + CW_CNT; int run = 0;
        for (int e = 0; e < NEXP; ++e) { const int c = (int)__hip_atomic_load(cnt + e, __ATOMIC_RELAXED, __HIP_MEMORY_SCOPE_AGENT); ps[e] = run; ps[32 + e] = c; run += (c + 255) / 256 * 256; } ps[64] = run; }
}
constexpr int L2_G2P = 0, L2_LNG = 8192, L2_LNB = 16384, L2_PS = 24576;
__device__ __forceinline__ void p11_final(const Params& p, const Frame& F) {
    const float* mod = (const float*)(p.ws + WS_MOD); const bf16_t* x1 = (const bf16_t*)(p.ws + WS_X1); const unsigned char* yb = p.ws + WS_YB; const int* rt_e = (const int*)(p.ws + WS_RT + RT_E); const int* rt_pos = (const int*)(p.ws + WS_RT + RT_POS); const float* rt_w = (const float*)(p.ws + WS_RT + RT_W);
    LAS int* ps = (LAS int*)(F.lds + L2_PS);
    slot_prefix(p, F, ps);
    int bcur = -1;
    for (int g0 = F.bid; g0 < NTOK / 128; g0 += F.G) {
        const int b = (g0 * 128) / SEQ;
        if (b != bcur) { __syncthreads(); bcur = b; const float* mb = mod + (size_t)b * (6 * DM);
            for (unsigned i = (unsigned)F.tid; i < (unsigned)DM; i += 512u) { LAS float* L = (LAS float*)F.lds; const float* m5 = mb + 5 * DM; L[L2_G2P / 4 + i] = 1.f + m5[i]; L[L2_LNG / 4 + i] = p.ln2_g[i]; L[L2_LNB / 4 + i] = p.ln2_b[i]; }
            __syncthreads(); }
        const int row0 = g0 * 128 + F.wave * 16;
#pragma unroll 1
        for (int pr = 0; pr < 8; ++pr) {
            u32x4 xv[2][4]; u32x2 ya[2][4], yc[2][4]; float wa[2], wc[2];
#pragma unroll
            for (int r = 0; r < 2; ++r) { const int row = row0 + 2 * pr + r; const int sa = ps[rt_e[2 * row]] + rt_pos[2 * row], sb = ps[rt_e[2 * row + 1]] + rt_pos[2 * row + 1]; wa[r] = rt_w[2 * row] * Y8_INV; wc[r] = rt_w[2 * row + 1] * Y8_INV;
#pragma unroll
                for (int i = 0; i < 4; ++i) { const int col = i * 512 + F.lane * 8;
                    xv[r][i] = *(const u32x4*)(x1 + (size_t)row * DM + col); ya[r][i] = *(const u32x2*)(yb + (size_t)sa * DM + col); yc[r][i] = *(const u32x2*)(yb + (size_t)sb * DM + col); } }
#pragma unroll
            for (int r = 0; r < 2; ++r) { const int row = row0 + 2 * pr + r;
                float v[32]; float s = 0.f;
#pragma unroll
                for (int i = 0; i < 4; ++i) { const int col = i * 512 + F.lane * 8; float xf[8], yf[8], zf[8]; unpack8(xv[r][i], xf); unpack8_fp8(ya[r][i], yf); unpack8_fp8(yc[r][i], zf);
                    const f32x4 ga = *(const LAS f32x4*)(F.lds + L2_G2P + col * 4), gb = *(const LAS f32x4*)(F.lds + L2_G2P + col * 4 + 16);
#pragma unroll
                    for (int e = 0; e < 4; ++e) { v[i * 8 + e] = ALPHA * xf[e] + ga[e] * (wa[r] * yf[e] + wc[r] * zf[e]); v[i * 8 + 4 + e] = ALPHA * xf[4 + e] + gb[e] * (wa[r] * yf[4 + e] + wc[r] * zf[4 + e]); }
#pragma unroll
                    for (int e = 0; e < 8; ++e) s += v[i * 8 + e]; }
                const float mean = wave_sum(s) * (1.f / DM);
                float q = 0.f;
#pragma unroll
                for (int k = 0; k < 32; ++k) { const float d = v[k] - mean; q += d * d; }
                const float rstd = rsqrtf(wave_sum(q) * (1.f / DM) + LN_EPS);
#pragma unroll
                for (int i = 0; i < 4; ++i) { const int col = i * 512 + F.lane * 8;
                    const f32x4 g0v = *(const LAS f32x4*)(F.lds + L2_LNG + col * 4), g1v = *(const LAS f32x4*)(F.lds + L2_LNG + col * 4 + 16), b0 = *(const LAS f32x4*)(F.lds + L2_LNB + col * 4), b1 = *(const LAS f32x4*)(F.lds + L2_LNB + col * 4 + 16);
                    f32x4 o0, o1;
#pragma unroll
                    for (int e = 0; e < 4; ++e) { o0[e] = (v[i * 8 + e] - mean) * rstd * g0v[e] + b0[e]; o1[e] = (v[i * 8 + 4 + e] - mean) * rstd * g1v[e] + b1[e]; }
                    __builtin_nontemporal_store(o0, (f32x4*)(p.out + (size_t)row * DM + col)); __builtin_nontemporal_store(o1, (f32x4*)(p.out + (size_t)row * DM + col + 4)); }
                __builtin_amdgcn_sched_barrier(0);
            }
        }
    }
    __syncthreads();
}

typedef const __attribute__((address_space(4))) Params* kparams_t;
__device__ __forceinline__ Params load_params() {
#if defined(__HIP_DEVICE_COMPILE__)
    kparams_t pp = (kparams_t)__builtin_amdgcn_kernarg_segment_ptr(); asm volatile("" : "+s"(pp)); return *pp;
#else
    return Params{};
#endif
}
__device__ __forceinline__ Frame make_frame(unsigned char* lds_raw, int wv) {
    Frame F; F.lds = (LAS unsigned char*)lds_raw; F.lane = lane_id(); F.wave = wv; F.tid = wv * 64 + F.lane; F.G = gridDim.x; F.bid = blockIdx.x; return F;
}
constexpr int MOE_TL = 320, MOE_GI = 448;
template <bool TOK> __device__ __forceinline__ LAS int* moe_tables(const Params& p, const Frame& F, int& ntiles, int ntl) {
    LAS int* tl = (LAS int*)(F.lds + pg8::STAGE_BYTES); LAS int* ps = tl + MOE_TL;
    slot_prefix(p, F, ps);
    __syncthreads();
    ntiles = ps[64] / 256;
    for (int i = F.tid; i < ntiles; i += 512) { int e = 0;
#pragma unroll 1
        for (int x = 1; x < NEXP; ++x) if (ps[x] <= 256 * i) e = x;
        tl[i] = e; }
    __syncthreads();
    if constexpr (TOK) { const int* elist = (const int*)(p.ws + WS_ELIST);
        for (int u = 0; u < 24; ++u) { const int L = u * F.G + F.bid; if (L >= ntiles * ntl) break;
            if (F.tid < 256) { const int t = L / ntl, e = tl[t], pos = 256 * t - ps[e] + F.tid; tl[MOE_GI + u * 256 + F.tid] = pos < ps[32 + e] ? elist[(unsigned)e * (unsigned)NTOK + (unsigned)pos] : 0; } }
        __syncthreads(); }
    return tl;
}
template <unsigned MASK> __global__ void __launch_bounds__(512, 2) fwd(Params p_unused) {
    extern __shared__ __attribute__((aligned(16))) unsigned char lds_raw[];
    volatile LAS unsigned* misc = (volatile LAS unsigned*)((LAS unsigned char*)lds_raw + LDS_MISC);
    const int wv = __builtin_amdgcn_readfirstlane((int)threadIdx.x >> 6);
    __builtin_assume(wv >= 0 && wv < 8);
    if (wv == 0) misc[lane_id()] = 0u;
    __syncthreads();
    int lo, hi; unsigned* barw;
    { const Params p = load_params(); lo = p.ph_lo; hi = p.ph_hi; barw = (unsigned*)(p.ws + WS_CTL); }
    XcdBarrier bar; bar.bar = barw; bar.x = 0; bar.st = misc;
    bar.wv = wv;
    if (hi - lo > 1) bar = xcd_barrier_post(barw, misc, wv);
#define IN(k) (((MASK >> (k)) & 1u) && lo <= (k) && (k) < hi)
#define SEAM(k) do { if (IN(k) && IN((k) + 1)) xcd_barrier(bar); } while (0)
#ifndef PROBE_REP
#define PROBE_REP 0u
#endif
#define PHASE(k, ...) if (IN(k)) __VA_ARGS__ if (((PROBE_REP >> (k)) & 1u) && IN(k)) { xcd_barrier(bar); __VA_ARGS__ } SEAM(k);
    PHASE(0, { const Params p = load_params(); const Frame F = make_frame(lds_raw, wv); p0_prologue(p, F); })
    PHASE(1, { const Params p = load_params(); const Frame F = make_frame(lds_raw, wv); p1_hpass(p, F); })
    PHASE(2, { const Params p = load_params(); const Frame F = make_frame(lds_raw, wv); pg8::Gemm g{(const bf16_t*)(p.ws + WS_HBUF), (const bf16_t*)(p.ws + WS_WIN), NTOK, LDP, DM}; pg8::StaticOrder S; S.init(NTOK, LDP, F.G, F.bid);
        pg8::EpiBf16T<true> E{(bf16_t*)(p.ws + WS_PROJ), LDP}; pg8::gemm_phase<pg8::EpiBf16T<true>, pg8::StaticOrder, false>(F.lds, g, S, E, nullptr, F.wave); })
    PHASE(3, { const Params p = load_params(); const Frame F = make_frame(lds_raw, wv); p3_dnprep(p, F); })
    PHASE(4, { const Params p = load_params(); const Frame F = make_frame(lds_raw, wv); if (F.bid < 64) scan_unit(p, F, F.bid); else if (F.bid < 64 + CVT_WGS) moe_weight_tiles(p, F, F.bid - 64, CVT_WGS);
        p4_attention(p, F, (char*)lds_raw); })
    PHASE(6, { const Params p = load_params(); const Frame F = make_frame(lds_raw, wv); pg8::Gemm g{(const bf16_t*)(p.ws + WS_HBUF), (const bf16_t*)(p.ws + WS_WOUT), NTOK, DM, DM}; pg8::StaticOrder S; S.init(NTOK, DM, F.G, F.bid);
        pg8::EpiBf16 E{(bf16_t*)(p.ws + WS_Y1), DM}; pg8::gemm_phase<pg8::EpiBf16, pg8::StaticOrder, false>(F.lds, g, S, E, nullptr, F.wave); })
    PHASE(7, { const Params p = load_params(); const Frame F = make_frame(lds_raw, wv); p6_ln1_router(p, F); })
    PHASE(10, { const Params p = load_params(); const Frame F = make_frame(lds_raw, wv); int ntiles;
        LAS int* tl = moe_tables<true>(p, F, ntiles, 4);
        pg8::Gemm g{(const bf16_t*)(p.ws + WS_H2F8), (const bf16_t*)((const unsigned char*)p.out + OUT_W1), 0, 0, DM / 2};
        pg8::MoeOrder S{tl, ntiles, 4, F.G, F.bid};
        pg8::EpiSwiglu E{p.ws + WS_HID}; pg8::gemm_phase<pg8::EpiSwiglu, pg8::MoeOrder, true, true>(F.lds, g, S, E, tl + MOE_GI, F.wave); })
    PHASE(11, { const Params p = load_params(); const Frame F = make_frame(lds_raw, wv); int ntiles;
        LAS int* tl = moe_tables<false>(p, F, ntiles, 8);
        pg8::Gemm g{(const bf16_t*)(p.ws + WS_HID), (const bf16_t*)((const unsigned char*)p.out + OUT_W2), 0, 0, DEXP / 2};
        pg8::MoeOrder S{tl, ntiles, 8, F.G, F.bid};
        pg8::EpiY8 E{p.ws + WS_YB}; pg8::gemm_phase<pg8::EpiY8, pg8::MoeOrder, false, true>(F.lds, g, S, E, nullptr, F.wave); })
    PHASE(12, { const Params p = load_params(); const Frame F = make_frame(lds_raw, wv); p11_final(p, F); })
#undef IN
#undef SEAM
#undef PHASE
}

typedef void (*kern_t)(Params);
template <int K> struct PhaseTab { static void fill(kern_t* t) { t[K] = fwd<(1u << K)>; PhaseTab<K - 1>::fill(t); } };
template <> struct PhaseTab<-1> { static void fill(kern_t*) {} };
extern "C" void kernel_launch(void* const* d_in, const int* in_sizes, int n_in, void* d_out, int out_size, void* d_ws, size_t ws_size, hipStream_t stream) {
    static int grid = 0; static kern_t tab[NPHASE + 1];
    if (grid == 0) {
        if (n_in != 22 || out_size != NTOK * DM || ws_size < WS_END) { fprintf(stderr, "kernel_launch: unexpected shapes (n_in %d, out %d, ws %zu)\n", n_in, out_size, ws_size); grid = -1; return; }
        int dev = 0, cus = 0, per_cu = 0;
        if (hipGetDevice(&dev) != hipSuccess || hipDeviceGetAttribute(&cus, hipDeviceAttributeMultiprocessorCount, dev) != hipSuccess) { grid = -1; return; }
#if MK_ONE_LAUNCH
        tab[NPHASE] = fwd<0xffffu>;
        const int k0 = NPHASE, k1 = NPHASE + 1;
#else
        PhaseTab<NPHASE - 1>::fill(tab);
        const int k0 = 0, k1 = NPHASE;
#endif
        for (int k = k0; k < k1; ++k) {
            if (hipFuncSetAttribute((const void*)tab[k], hipFuncAttributeMaxDynamicSharedMemorySize, LDS_BYTES) != hipSuccess) { fprintf(stderr, "kernel_launch: hipFuncSetAttribute failed\n"); grid = -1; return; }
            if (hipOccupancyMaxActiveBlocksPerMultiprocessor(&per_cu, (const void*)tab[k], 512, LDS_BYTES) != hipSuccess || per_cu < 1) { fprintf(stderr, "kernel_launch: occupancy query says %d\n", per_cu); (void)hipGetLastError(); }
        }
        grid = cus;
        if (grid < 128) { fprintf(stderr, "kernel_launch: built for a 256-CU device (got %d CUs)\n", cus); grid = -1; return; }
    }
    if (grid < 0) return;
    (void)hipMemsetAsync((char*)d_ws + WS_CTL, 0, CTL_BYTES, stream);
    Params p{};
    p.x = (const float*)d_in[0]; p.c = (const float*)d_in[1]; p.w_ada = (const float*)d_in[2]; p.b_ada = (const float*)d_in[3]; p.w_in = (const float*)d_in[4]; p.conv_w = (const float*)d_in[5];
    p.a_log = (const float*)d_in[6]; p.dt_bias = (const float*)d_in[7]; p.norm_w = (const float*)d_in[8]; p.f_bias = (const float*)d_in[9]; p.w_out = (const float*)d_in[10];
    p.ln1_g = (const float*)d_in[11]; p.ln1_b = (const float*)d_in[12]; p.w_rg = (const float*)d_in[13]; p.b_rg = (const float*)d_in[14]; p.w_re = (const float*)d_in[15]; p.b_re = (const float*)d_in[16];
    p.w_gate = (const float*)d_in[17]; p.w_up = (const float*)d_in[18]; p.w_down = (const float*)d_in[19]; p.ln2_g = (const float*)d_in[20]; p.ln2_b = (const float*)d_in[21];
    p.out = (float*)d_out; p.ws = (unsigned char*)d_ws;
#if MK_ONE_LAUNCH
    p.ph_lo = 0; p.ph_hi = NPHASE;
    hipLaunchKernelGGL(tab[NPHASE], dim3(grid), dim3(512), LDS_BYTES, stream, p);
#else
    for (int k = 0; k < NPHASE; ++k) { p.ph_lo = k; p.ph_hi = k + 1; hipLaunchKernelGGL(tab[k], dim3(grid), dim3(512), LDS_BYTES, stream, p); }
#endif
}
```

```cpp
#include <hip/hip_runtime.h>
#include <cstdio>
#include <cstdint>

#ifndef MK_ONE_LAUNCH
#define MK_ONE_LAUNCH 1
#endif

#define LAS __attribute__((address_space(3)))
typedef unsigned short bf16_t;
typedef short bf16x8 __attribute__((ext_vector_type(8)));
typedef short s16x4 __attribute__((ext_vector_type(4)));
typedef float f32x4 __attribute__((ext_vector_type(4)));
typedef float f32x2 __attribute__((ext_vector_type(2)));
typedef float f32x16 __attribute__((ext_vector_type(16)));
typedef unsigned u32x4 __attribute__((ext_vector_type(4)));
typedef unsigned u32x2 __attribute__((ext_vector_type(2)));

constexpr int NB = 8, SEQ = 4096, DM = 2048, NTOK = NB * SEQ;
constexpr int NH = 8, HD = 128;
constexpr int LDP = 7168;
constexpr int PQ = 0, PK = 1024, PV = 2048, PZ = 3072, FQ = 4096, FK = 5120, FV = 6144;
constexpr int WIN_LD = 7192;
constexpr int NEXP = 32, DEXP = 512, PMAX = 2 * NTOK + NEXP * 256;
constexpr float LN_EPS = 1e-5f, NORM_EPS = 1e-6f;
constexpr float ALPHA = 1.189207115002721f;
constexpr float QSCALE = 0.08838834764831845f;
constexpr int NPHASE = 13;

constexpr size_t WS_CTL   = 0;
constexpr size_t CTL_BYTES = 65536;
constexpr int CW_CNT = 4096, CW_QUEUE = 5120, CW_NTILES = 6144, CW_TILE_E = 7168, CW_QKMAX = 8192;
constexpr size_t WS_MOD   = 65536;
constexpr size_t WS_SMALLW= WS_MOD + 393216;
constexpr size_t WS_RTW   = WS_SMALLW + 131072;
constexpr size_t WS_WOUT  = WS_RTW + 393216;
constexpr size_t WS_WIN   = WS_WOUT + 8388608;
constexpr size_t WS_SM    = WS_WIN + 29360128;
constexpr size_t WS_FCUM  = WS_SM + 4194304;
constexpr size_t WS_HBUF  = WS_FCUM + 1048576;
constexpr size_t WS_PROJ  = WS_HBUF + 134217728;
constexpr size_t WS_DN    = WS_PROJ + 469762048;
constexpr int DN_W = 0, DN_KT = 17408, DN_Q = 35840, DN_QK = 53248, DN_UT = 62464, DN_MISC = 78848, DN_CHUNK = 79104;
constexpr size_t WS_RT    = WS_DN + (size_t)4096 * DN_CHUNK;
constexpr size_t RT_E = 0, RT_W = 262144, RT_POS = 524288, RT_SLOT = 786432, RT_TOK = 1048576, RT_WB = 1048576 + 294912;
constexpr size_t WS_ELIST = WS_RT + 1048576 + 2 * 294912;
constexpr size_t WS_END   = WS_ELIST + (size_t)NEXP * NTOK * 4;
constexpr size_t WS_H2    = WS_PROJ;
constexpr size_t WS_X1    = WS_H2 + 134217728;
constexpr size_t WS_H2F8  = WS_X1 + 134217728;
constexpr size_t WS_HID   = WS_X1 + 268435456;
constexpr size_t WS_YB    = WS_HID + (size_t)PMAX * 512 * 2;
constexpr size_t WS_Y1    = WS_YB;
static_assert(WS_YB + (size_t)PMAX * 2048 * 2 <= WS_RT, "overlay");
static_assert(WS_END <= (size_t)1 << 30, "workspace");
constexpr size_t OUT_W1 = 0;
constexpr size_t OUT_W2 = 134217728;
constexpr float Y8_SCALE = 16.f, Y8_INV = 1.f / 16.f;
constexpr float W2_SCALE = 32.f, HID_SCALE = 8.f, Y2_INV = 1.f / (32.f * 8.f), W1_SCALE = 32.f, W1_INV = 1.f / 32.f;

constexpr int LDS_BYTES = 160 * 1024 - 512;
constexpr int LDS_MISC = LDS_BYTES - 256;

struct Params {
    const float* x; const float* c; const float* w_ada; const float* b_ada; const float* w_in; const float* conv_w; const float* a_log; const float* dt_bias;
    const float* norm_w; const float* f_bias; const float* w_out; const float* ln1_g; const float* ln1_b; const float* w_rg; const float* b_rg; const float* w_re;
    const float* b_re; const float* w_gate; const float* w_up; const float* w_down; const float* ln2_g; const float* ln2_b;
    float* out; unsigned char* ws; int ph_lo, ph_hi;
};

typedef __bf16 bf16v2 __attribute__((ext_vector_type(2)));
__device__ __forceinline__ unsigned cvtpk(float lo, float hi) { bf16v2 v; v[0] = (__bf16)lo; v[1] = (__bf16)hi; return __builtin_bit_cast(unsigned, v); }
__device__ __forceinline__ float bflo(unsigned w) { return __uint_as_float(w << 16); }
__device__ __forceinline__ float bfhi(unsigned w) { return __uint_as_float(w & 0xffff0000u); }
__device__ __forceinline__ float bf1(bf16_t h) { return __uint_as_float(((unsigned)h) << 16); }
__device__ __forceinline__ bf16_t f2bf(float f) { return (bf16_t)(cvtpk(f, 0.f) & 0xffffu); }
__device__ __forceinline__ float silu_f(float x) { return x * __builtin_amdgcn_rcpf(1.f + __expf(-x)); }
__device__ __forceinline__ f32x4 mfma16(bf16x8 a, bf16x8 b, f32x4 c) { return __builtin_amdgcn_mfma_f32_16x16x32_bf16(a, b, c, 0, 0, 0); }
__device__ __forceinline__ u32x2 pack4(f32x4 v) { u32x2 r; r.x = cvtpk(v[0], v[1]); r.y = cvtpk(v[2], v[3]); return r; }
__device__ __forceinline__ bf16x8 pack8(f32x4 a, f32x4 b) { u32x4 w = {cvtpk(a[0], a[1]), cvtpk(a[2], a[3]), cvtpk(b[0], b[1]), cvtpk(b[2], b[3])}; return *reinterpret_cast<bf16x8*>(&w); }
__device__ __forceinline__ void unpack8(u32x4 w, float* f) { f[0] = bflo(w.x); f[1] = bfhi(w.x); f[2] = bflo(w.y); f[3] = bfhi(w.y); f[4] = bflo(w.z); f[5] = bfhi(w.z); f[6] = bflo(w.w); f[7] = bfhi(w.w); }
typedef int i32x8 __attribute__((ext_vector_type(8)));
typedef int i32x4 __attribute__((ext_vector_type(4)));
typedef float f32x2_t __attribute__((ext_vector_type(2)));
__device__ __forceinline__ void unpack8_fp8(u32x2 w, float* f) { const f32x2_t a = __builtin_amdgcn_cvt_pk_f32_fp8((int)w.x, false), b = __builtin_amdgcn_cvt_pk_f32_fp8((int)w.x, true), c = __builtin_amdgcn_cvt_pk_f32_fp8((int)w.y, false), d = __builtin_amdgcn_cvt_pk_f32_fp8((int)w.y, true);
    f[0] = a[0]; f[1] = a[1]; f[2] = b[0]; f[3] = b[1]; f[4] = c[0]; f[5] = c[1]; f[6] = d[0]; f[7] = d[1]; }
__device__ __forceinline__ unsigned pack_fp8x4(float a, float b, float c, float d) { int w = __builtin_amdgcn_cvt_pk_fp8_f32(a, b, 0, false); w = __builtin_amdgcn_cvt_pk_fp8_f32(c, d, w, true); return (unsigned)w; }
__device__ __forceinline__ float wave_sum(float v) {
#pragma unroll
    for (int o = 32; o >= 1; o >>= 1) v += __shfl_xor(v, o);
    return v;
}
#define TRRD(dst, addr, off) asm volatile("ds_read_b64_tr_b16 %0, %1 offset:%2" : "=&v"(dst) : "v"(addr), "i"(off) : "memory")
#define LGKM0() do { asm volatile("s_waitcnt lgkmcnt(0)" ::: "memory"); __builtin_amdgcn_sched_barrier(0); } while (0)
#define VM0() asm volatile("s_waitcnt vmcnt(0)" ::: "memory")
#define LBAR() do { asm volatile("s_waitcnt lgkmcnt(0)" ::: "memory"); __builtin_amdgcn_s_barrier(); asm volatile("" ::: "memory"); } while (0)
__device__ __forceinline__ bf16x8 join8(s16x4 l, s16x4 h) { return (bf16x8){l[0], l[1], l[2], l[3], h[0], h[1], h[2], h[3]}; }

__device__ __forceinline__ int lane_id() { int l; asm volatile("v_mbcnt_lo_u32_b32 %0, -1, 0\n\tv_mbcnt_hi_u32_b32 %0, -1, %0" : "=v"(l)); __builtin_assume(l >= 0 && l < 64); return l; }
#define TID(wv) ((wv) * 64 + lane_id())
#define XB_TMO      128
#define XB_XCNT(j)  (256  + 64 * (j))
#define XB_XSUB(j)  (1280 + 64 * (j))
#define XB_XGEN(j)  (2304 + 64 * (j))
#define XB_TOP      3328
#define XB_TOPGEN   3392
#define XCD_BAR_WORDS 3456
#define XB_SPIN_CAP (1u << 18)
__device__ __forceinline__ unsigned xb_ld(unsigned* p)              { return __hip_atomic_load(p, __ATOMIC_RELAXED, __HIP_MEMORY_SCOPE_AGENT); }
__device__ __forceinline__ unsigned xb_add(unsigned* p, unsigned v) { return __hip_atomic_fetch_add(p, v, __ATOMIC_RELAXED, __HIP_MEMORY_SCOPE_AGENT); }
__device__ __forceinline__ unsigned xb_xcc_id() { return (unsigned)__builtin_amdgcn_s_getreg((3 << 11) | 20) & 0xFu; }
#define XB_SPIN(cond, bar) do { unsigned _sp = 0; while (cond) { __builtin_amdgcn_s_sleep(1); \
    if ((++_sp & 255u) == 0u) { if (xb_ld(&(bar)[XB_TMO])) break; if (_sp > XB_SPIN_CAP) { atomicAdd(&(bar)[XB_TMO], 1u); break; } } } } while (0)
struct XcdBarrier { unsigned* bar; unsigned x; volatile LAS unsigned* st; int wv; };
__device__ __forceinline__ XcdBarrier xcd_barrier_post(unsigned* bar, volatile LAS unsigned* st, int wv) {
    XcdBarrier b; b.bar = bar; b.x = xb_xcc_id(); b.st = st; b.wv = wv;
    if (TID(wv) == 0) (void)xb_add(&bar[XB_XCNT(b.x)], 1u);
    return b;
}
__device__ __forceinline__ void xcd_barrier_complete(unsigned* bar, unsigned x, unsigned& nloc, unsigned& nx) {
    const unsigned G = gridDim.x * gridDim.y * gridDim.z;
    unsigned sum, cnt, mine, sp = 0u;
    for (;;) {
        sum = 0u; cnt = 0u; mine = 0u;
#pragma unroll
        for (unsigned j = 0; j < 16; ++j) { const unsigned c = xb_ld(&bar[XB_XCNT(j)]); sum += c; cnt += (c > 0u) ? 1u : 0u; mine = (j == x) ? c : mine; }
        if (sum == G) break;
        __builtin_amdgcn_s_sleep(1);
        if ((++sp & 255u) == 0u) { if (xb_ld(&bar[XB_TMO])) break; if (sp > XB_SPIN_CAP) { atomicAdd(&bar[XB_TMO], 1u); break; } }
    }
    nloc = mine > 0u ? mine : 1u; nx = cnt > 0u ? cnt : 1u;
}
__device__ __forceinline__ void xcd_barrier(const XcdBarrier& b) {
    asm volatile("s_waitcnt vmcnt(0)" ::: "memory");
    __syncthreads();
    if (TID(b.wv) == 0) {
        unsigned* bar = b.bar;
        __builtin_amdgcn_s_waitcnt(0);
        unsigned nloc = b.st[0], nx = b.st[1];
        if (nloc == 0u) { xcd_barrier_complete(bar, b.x, nloc, nx); b.st[0] = nloc; b.st[1] = nx; }
        const unsigned old = xb_add(&bar[XB_XSUB(b.x)], 1u);
        const unsigned gen = old / nloc;
        if (old + 1u == (gen + 1u) * nloc) {
            __builtin_amdgcn_fence(__ATOMIC_RELEASE, "agent");
            asm volatile("s_waitcnt vmcnt(0)" ::: "memory");
            const unsigned og = xb_add(&bar[XB_TOP], 1u);
            const unsigned tg = og / nx;
            if (og + 1u == (tg + 1u) * nx) xb_add(&bar[XB_TOPGEN], 1u);
            else XB_SPIN(xb_ld(&bar[XB_TOPGEN]) == tg, bar);
            __builtin_amdgcn_fence(__ATOMIC_ACQUIRE, "agent");
            xb_add(&bar[XB_XGEN(b.x)], 1u);
            asm volatile("s_waitcnt vmcnt(0)" ::: "memory");
        } else {
            XB_SPIN(xb_ld(&bar[XB_XGEN(b.x)]) == gen, bar);
            __builtin_amdgcn_fence(__ATOMIC_ACQUIRE, "agent");
            asm volatile("s_waitcnt vmcnt(0)" ::: "memory");
        }
    }
    __syncthreads();
}

namespace pg8 {
constexpr int BM = 256, BK = 64, HALF = 128, HTB = HALF * BK * 2, STAGE_BYTES = 8 * HTB, NXCD = 8, WGM = 8;
__host__ __device__ __forceinline__ int lds_byte(int r, int c) { const int st = (r >> 4) * 2 + (c >> 5), rr = r & 15, cc = c & 31, ob = rr * 64 + cc * 2; return st * 1024 + (ob ^ (((ob >> 9) & 1) << 5)); }
__host__ __device__ __forceinline__ void stage_rc(int b, int& R, int& C) { const int st = b / 1024, sb = b % 1024, swz = sb ^ (((sb >> 9) & 1) << 5); R = (st >> 1) * 16 + swz / 64; C = (st & 1) * 32 + (swz % 64) / 2; }
__host__ __device__ __forceinline__ int perm32(int rho) { const int n = rho >> 4, i = rho & 15; return 8 * (i >> 2) + 4 * n + (i & 3); }
struct Unit { int pm, pn; };
struct Gemm { const bf16_t* A; const bf16_t* Bt; int M, N, K; };
struct StaticOrder {
    int nM, nN, nwg, G, c;
    __device__ void init(int M, int N, int G_, int c_) { nM = M / BM; nN = N / BM; nwg = nM * nN; G = G_; c = c_; }
    __device__ bool next(int i, Unit& u) const {
        const long L = (long)i * G + c; if (L >= nwg) return false;
        int wgid = (int)L; { const int q = nwg / NXCD, r = nwg % NXCD, xcd = wgid % NXCD, off = wgid / NXCD; wgid = (xcd < r ? xcd * (q + 1) : r * (q + 1) + (xcd - r) * q) + off; }
        const int nig = WGM * nN, gid = wgid / nig, fm = gid * WGM, gsz = (nM - fm) < WGM ? (nM - fm) : WGM;
        u.pm = fm + ((wgid % nig) % gsz); u.pn = (wgid % nig) / gsz; return true;
    }
};
struct MoeOrder {
    const LAS int* tile_e; int ntiles, ntl, G, c;
    __device__ bool next(int i, Unit& u) const {
        const long L = (long)i * G + c; if (L >= (long)ntiles * ntl) return false;
        const int t = (int)(L / ntl), j = (int)(L % ntl); u.pm = t; u.pn = tile_e[t] * ntl + j; return true;
    }
};
template <bool NT> struct EpiBf16T {
    static constexpr bool PERM = true; static constexpr int NST = 16;
    bf16_t* O; int ldc;
    __device__ __forceinline__ void operator()(const f32x4 (&acc)[2][2][4][2], const Unit& u, int wr, int wc, int fr, int fq) const {
        const int row0 = u.pm * BM + wr * 64 + fr, col0 = u.pn * BM + wc * 32 + 8 * fq;
#pragma unroll
        for (int ai = 0; ai < 2; ++ai)
#pragma unroll
            for (int m = 0; m < 4; ++m) { bf16_t* rowp = O + (size_t)(row0 + ai * HALF + m * 16) * ldc + col0;
#pragma unroll
                for (int bj = 0; bj < 2; ++bj) { const f32x4 v0 = acc[ai][bj][m][0], v1 = acc[ai][bj][m][1];
                    u32x4 w; w.x = cvtpk(v0[0], v0[1]); w.y = cvtpk(v0[2], v0[3]); w.z = cvtpk(v1[0], v1[1]); w.w = cvtpk(v1[2], v1[3]);
                    if constexpr (NT) __builtin_nontemporal_store(w, (u32x4*)(rowp + bj * HALF)); else *(u32x4*)(rowp + bj * HALF) = w; } }
    }
};
typedef EpiBf16T<false> EpiBf16;
struct EpiSwiglu {
    static constexpr bool PERM = true; static constexpr int NST = 8;
    unsigned char* O;
    __device__ __forceinline__ void operator()(const f32x4 (&acc)[2][2][4][2], const Unit& u, int wr, int wc, int fr, int fq) const {
        const int row0 = u.pm * BM + wr * 64 + fr, col0 = (u.pn & 3) * 128 + wc * 32 + 8 * fq;
#pragma unroll
        for (int ai = 0; ai < 2; ++ai)
#pragma unroll
            for (int m = 0; m < 4; ++m) { unsigned char* rowp = O + (size_t)(row0 + ai * HALF + m * 16) * DEXP + col0;
                float h[8];
#pragma unroll
                for (int n = 0; n < 2; ++n)
#pragma unroll
                    for (int j = 0; j < 4; ++j) { const float g = acc[ai][0][m][n][j] * W1_INV, up = acc[ai][1][m][n][j] * (W1_INV * HID_SCALE); h[n * 4 + j] = g * __builtin_amdgcn_rcpf(1.f + __expf(-g)) * up; }
                *(u32x2*)rowp = (u32x2){pack_fp8x4(h[0], h[1], h[2], h[3]), pack_fp8x4(h[4], h[5], h[6], h[7])}; }
    }
};
struct EpiY8 {
    static constexpr bool PERM = true, BJ8 = true; static constexpr int NST = 8;
    unsigned char* O;
    __device__ __forceinline__ void operator()(const f32x4 (&acc)[2][2][4][2], const Unit& u, int wr, int wc, int fr, int fq) const {
        const int row0 = u.pm * BM + wr * 64 + fr, col0 = (u.pn & 7) * BM + wc * 64 + 16 * fq;
#pragma unroll
        for (int ai = 0; ai < 2; ++ai)
#pragma unroll
            for (int m = 0; m < 4; ++m) { unsigned char* rowp = O + (size_t)(row0 + ai * HALF + m * 16) * DM + col0;
                u32x4 w;
#pragma unroll
                for (int bj = 0; bj < 2; ++bj)
#pragma unroll
                    for (int n = 0; n < 2; ++n) { f32x4 v = acc[ai][bj][m][n] * (Y2_INV * Y8_SCALE);
#pragma unroll
                        for (int e = 0; e < 4; ++e) v[e] = __builtin_amdgcn_fmed3f(v[e], -448.f, 448.f);
                        w[bj * 2 + n] = pack_fp8x4(v[0], v[1], v[2], v[3]); }
                *(u32x4*)rowp = w; }
    }
};

template <class E, class = void> struct EpiBj8 { static constexpr bool value = false; };
template <class E> struct EpiBj8<E, decltype((void)E::BJ8)> { static constexpr bool value = E::BJ8; };
template <class Epi, class Sched, bool GATHER, bool FP8 = false>
__device__ __forceinline__ void gemm_phase(LAS unsigned char* lds, const Gemm g, const Sched& S, const Epi& E, const LAS int* gidx, int wv) {
    const int wid = wv, lane = lane_id(), tid = wid * 64 + lane, wr = wid >> 2, wc = wid & 3, fr = lane & 15, fq = lane >> 4;
    const int K = g.K, nt = K / BK;
    unsigned voffA[2], voffB[2]; int RA[2], CA[2];
#pragma unroll
    for (int i = 0; i < 2; ++i) { int R, C; stage_rc(tid * 16 + i * 8192, R, C); const int Rb = EpiBj8<Epi>::value ? (64 * (R >> 5) + 16 * ((R & 15) >> 2) + 4 * ((R >> 4) & 1) + (R & 3)) : Epi::PERM ? ((R & ~31) + perm32(R & 31)) : R;
        voffA[i] = (unsigned)(R * K + C) * 2u; voffB[i] = (unsigned)(Rb * K + C) * 2u; RA[i] = R; CA[i] = C; }
    const size_t kstep = (size_t)(BK * 2);
    const size_t hstep = (size_t)HALF * K * 2;
    const size_t tstep = 2 * hstep;
    const size_t bstep = EpiBj8<Epi>::value ? (size_t)8 * K * 2 : hstep;
    const unsigned ldsw = (unsigned)wid * 1024u;
    const int aoff = lds_byte(wr * 64 + fr, fq * 8), boff = lds_byte(wc * 32 + fr, fq * 8);
    const int c8 = 32 * (fq >> 1) + 16 * (fq & 1);
    const int aoff8[2] = {lds_byte(wr * 64 + fr, c8), lds_byte(wr * 64 + fr, c8 + 8)}, boff8[2] = {lds_byte(wc * 32 + fr, c8), lds_byte(wc * 32 + fr, c8 + 8)};
#define PG8_SA(b, h) (((b) * 2 + (h)) * HTB)
#define PG8_SB(b, h) ((4 + (b) * 2 + (h)) * HTB)
#define PG8_STAGE(bufoff, gbase, voff) do { _Pragma("unroll") for (int _i = 0; _i < 2; ++_i) \
        __builtin_amdgcn_global_load_lds((const unsigned*)((const char*)(gbase) + (voff)[_i]), (LAS unsigned*)(lds + (bufoff) + ldsw + _i * 8192), 16, 0, 0); } while (0)
#define PG8_STAGE_A(bufoff, kbase, ubase, h, gv) do { if constexpr (GATHER) { PG8_STAGE(bufoff, kbase, gv[h]); } else { PG8_STAGE(bufoff, (ubase) + (h) * hstep, voffA); } } while (0)
#define PG8_LDA(dst, b, h) do { if constexpr (FP8) { _Pragma("unroll") for (int m = 0; m < 4; ++m) { const i32x4 lo_ = *(const LAS i32x4*)(lds + PG8_SA(b, h) + aoff8[0] + m * 2048), hi_ = *(const LAS i32x4*)(lds + PG8_SA(b, h) + aoff8[1] + m * 2048); dst##8[m] = __builtin_shufflevector(lo_, hi_, 0, 1, 2, 3, 4, 5, 6, 7); } } \
        else { _Pragma("unroll") for (int m = 0; m < 4; ++m) _Pragma("unroll") for (int k = 0; k < 2; ++k) dst[m][k] = *(const LAS bf16x8*)(lds + PG8_SA(b, h) + aoff + m * 2048 + k * 1024); } } while (0)
#define PG8_LDB(dst, b, h) do { if constexpr (FP8) { _Pragma("unroll") for (int n = 0; n < 2; ++n) { const i32x4 lo_ = *(const LAS i32x4*)(lds + PG8_SB(b, h) + boff8[0] + n * 2048), hi_ = *(const LAS i32x4*)(lds + PG8_SB(b, h) + boff8[1] + n * 2048); dst##8[n] = __builtin_shufflevector(lo_, hi_, 0, 1, 2, 3, 4, 5, 6, 7); } } \
        else { _Pragma("unroll") for (int n = 0; n < 2; ++n) _Pragma("unroll") for (int k = 0; k < 2; ++k) dst[n][k] = *(const LAS bf16x8*)(lds + PG8_SB(b, h) + boff + n * 2048 + k * 1024); } } while (0)
#define PG8_MMA(ai, bj, At, Bt) do { __builtin_amdgcn_s_setprio(1); \
        if constexpr (FP8) { _Pragma("unroll") for (int m = 0; m < 4; ++m) _Pragma("unroll") for (int n = 0; n < 2; ++n) \
            asm volatile("s_nop 1\n\tv_mfma_f32_16x16x128_f8f6f4 %0, %1, %2, %0" : "+v"(acc[ai][bj][m][n]) : "v"(Bt##8[n]), "v"(At##8[m])); }     \
        else { _Pragma("unroll") for (int m = 0; m < 4; ++m) _Pragma("unroll") for (int n = 0; n < 2; ++n) _Pragma("unroll") for (int k = 0; k < 2; ++k) \
            acc[ai][bj][m][n] = __builtin_amdgcn_mfma_f32_16x16x32_bf16(Bt[n][k], At[m][k], acc[ai][bj][m][n], 0, 0, 0); } \
        __builtin_amdgcn_s_setprio(0); } while (0)
#define PG8_WAIT_V(n) asm volatile("s_waitcnt vmcnt(" #n ")" ::: "memory")
#define PG8_WAIT_L(n) asm volatile("s_waitcnt lgkmcnt(" #n ")" ::: "memory")
#define PG8_BAR __builtin_amdgcn_s_barrier()
#define PG8_SCHED __builtin_amdgcn_sched_barrier(0)
    Unit cur, nxt; int ui = 0;
    if (!S.next(0, cur)) return;
    f32x4 acc[2][2][4][2];
#pragma unroll
    for (int a = 0; a < 2; ++a)
#pragma unroll
        for (int b = 0; b < 2; ++b)
#pragma unroll
            for (int m = 0; m < 4; ++m)
#pragma unroll
                for (int n = 0; n < 2; ++n) acc[a][b][m][n] = (f32x4){0.f, 0.f, 0.f, 0.f};
    bf16x8 At[4][2], B0[2][2], B1[2][2]; i32x8 At8[4], B08[2], B18[2];
    unsigned gc[2][2], gn[2][2];
#define PG8_GLOAD(dst, pm_) do { _Pragma("unroll") for (int h_ = 0; h_ < 2; ++h_) _Pragma("unroll") for (int i_ = 0; i_ < 2; ++i_) \
        dst[h_][i_] = ((unsigned)gidx[(pm_) * BM + h_ * HALF + RA[i_]] * (unsigned)K + (unsigned)CA[i_]) * 2u; } while (0)
    if constexpr (GATHER) { PG8_GLOAD(gc, 0); } else { gc[0][0] = gc[0][1] = gc[1][0] = gc[1][1] = 0u; }
    gn[0][0] = gc[0][0]; gn[0][1] = gc[0][1]; gn[1][0] = gc[1][0]; gn[1][1] = gc[1][1];
    const char* cA = (const char*)g.A + (GATHER ? (size_t)0 : (size_t)cur.pm * tstep); const char* cB = (const char*)g.Bt + (size_t)cur.pn * tstep;
    PG8_STAGE(PG8_SB(0, 0), cB, voffB); PG8_STAGE_A(PG8_SA(0, 0), cA, cA, 0, gc); PG8_STAGE(PG8_SB(0, 1), cB + bstep, voffB); PG8_STAGE_A(PG8_SA(0, 1), cA, cA, 1, gc);
    if (wr == 1) PG8_BAR;
    PG8_WAIT_V(4); PG8_BAR;
    PG8_STAGE(PG8_SB(1, 0), cB + kstep, voffB); PG8_STAGE_A(PG8_SA(1, 0), cA + kstep, cA + kstep, 0, gc); PG8_STAGE(PG8_SB(1, 1), cB + bstep + kstep, voffB);
    PG8_WAIT_V(6); PG8_BAR;
    PG8_STAGE_A(PG8_SA(1, 1), cA + kstep, cA + kstep, 1, gc);
    for (;;) {
        const bool has_next = S.next(ui + 1, nxt);
        const char* nA = has_next ? (const char*)g.A + (GATHER ? (size_t)0 : (size_t)nxt.pm * tstep) : cA; const char* nB = has_next ? (const char*)g.Bt + (size_t)nxt.pn * tstep : cB;
        if constexpr (GATHER) { if (has_next) { PG8_GLOAD(gn, ui + 1); } }
        for (int t = 0; t < nt; t += 2) {
            const bool last = (t == nt - 2);
            const char* a1 = cA + (size_t)(t + 1) * kstep;
            const char* a2 = last ? nA : cA + (size_t)(t + 2) * kstep; const char* b2 = last ? nB : cB + (size_t)(t + 2) * kstep;
            const char* a3 = a2 + kstep; const char* b3 = b2 + kstep;
            unsigned g2[2][2];
            if constexpr (GATHER) {
#pragma unroll
                for (int h_ = 0; h_ < 2; ++h_)
#pragma unroll
                    for (int i_ = 0; i_ < 2; ++i_) g2[h_][i_] = last ? gn[h_][i_] : gc[h_][i_];
            }
            PG8_LDB(B0, 0, 0); PG8_SCHED; PG8_LDA(At, 0, 0);
            PG8_WAIT_L(8); PG8_BAR; PG8_WAIT_L(0); PG8_MMA(0, 0, At, B0); PG8_BAR; PG8_SCHED;
            PG8_LDB(B1, 0, 1); PG8_STAGE(PG8_SB(0, 0), b2, voffB);
            PG8_BAR; PG8_WAIT_L(0); PG8_MMA(0, 1, At, B1); PG8_BAR;
            PG8_LDA(At, 0, 1); PG8_STAGE_A(PG8_SA(0, 0), a2, a2, 0, g2);
            PG8_BAR; PG8_WAIT_L(0); PG8_MMA(1, 0, At, B0); PG8_BAR; PG8_SCHED;
            PG8_STAGE(PG8_SB(0, 1), b2 + bstep, voffB);
            if (t == 0 && ui > 0) asm volatile("s_waitcnt vmcnt(%0)" :: "i"(6 + Epi::NST) : "memory"); else PG8_WAIT_V(6);
            PG8_BAR; PG8_MMA(1, 1, At, B1); PG8_BAR;
            PG8_LDB(B0, 1, 0); PG8_SCHED; PG8_LDA(At, 1, 0); PG8_STAGE_A(PG8_SA(0, 1), a2, a2, 1, g2);
            PG8_WAIT_L(8); PG8_BAR; PG8_WAIT_L(0); PG8_MMA(0, 0, At, B0); PG8_BAR; PG8_SCHED;
            PG8_LDB(B1, 1, 1); PG8_STAGE(PG8_SB(1, 0), b3, voffB);
            PG8_BAR; PG8_WAIT_L(0); PG8_MMA(0, 1, At, B1); PG8_BAR;
            PG8_LDA(At, 1, 1); PG8_STAGE_A(PG8_SA(1, 0), a3, a3, 0, g2);
            PG8_BAR; PG8_WAIT_L(0); PG8_MMA(1, 0, At, B0); PG8_BAR; PG8_SCHED;
            PG8_STAGE(PG8_SB(1, 1), b3 + bstep, voffB);
            PG8_WAIT_V(6); PG8_BAR; PG8_MMA(1, 1, At, B1); PG8_BAR;
            PG8_STAGE_A(PG8_SA(1, 1), a3, a3, 1, g2);
        }
        if constexpr (FP8) { asm volatile("s_nop 15\n\ts_nop 15" ::: "memory"); }
        E(acc, cur, wr, wc, fr, fq);
        if (!has_next) break;
#pragma unroll
        for (int a = 0; a < 2; ++a)
#pragma unroll
            for (int b = 0; b < 2; ++b)
#pragma unroll
                for (int m = 0; m < 4; ++m)
#pragma unroll
                    for (int n = 0; n < 2; ++n) acc[a][b][m][n] = (f32x4){0.f, 0.f, 0.f, 0.f};
        cur = nxt; cA = nA; cB = nB; ++ui;
        gc[0][0] = gn[0][0]; gc[0][1] = gn[0][1]; gc[1][0] = gn[1][0]; gc[1][1] = gn[1][1];
    }
    PG8_WAIT_V(0);
    if (wr == 0) PG8_BAR;
    PG8_BAR;
#undef PG8_SA
#undef PG8_SB
#undef PG8_STAGE
#undef PG8_STAGE_A
#undef PG8_LDA
#undef PG8_LDB
#undef PG8_MMA
#undef PG8_WAIT_V
#undef PG8_WAIT_L
#undef PG8_BAR
#undef PG8_SCHED
#undef PG8_GLOAD
}
}

struct Frame { LAS unsigned char* lds; int tid, lane, wave, G, bid; };

__device__ __forceinline__ void p0_mod_unit(const Params& p, const Frame& F, int u) {
    LAS float* st = (LAS float*)F.lds;
    LAS float* red = (LAS float*)(F.lds + 67584);
    for (int idx = F.tid; idx < NB * DM; idx += 512) { const int b = idx >> 11, k = idx & 2047; st[(k + (k >> 6)) * 8 + b] = silu_f(p.c[idx]); }
    __syncthreads();
    if (F.tid < 384) {
        const int cgp = F.tid % 12, kg = F.tid / 12;
        f32x4 acc[8];
#pragma unroll
        for (int b = 0; b < 8; ++b) acc[b] = (f32x4){0.f, 0.f, 0.f, 0.f};
        const char* wbase = (const char*)(p.w_ada + 48 * u); const unsigned woff = (unsigned)((kg * 64) * (6 * DM) + 4 * cgp) * 4u;
#define MOD_LOAD8(dst, j) do { _Pragma("unroll") for (int q = 0; q < 8; ++q) dst[q] = __builtin_nontemporal_load((const f32x4*)(wbase + (woff + (unsigned)((j) * 8 + q) * (unsigned)(6 * DM * 4)))); } while (0)
#define MOD_USE8(src, j) do { _Pragma("unroll") for (int q = 0; q < 8; ++q) { const int kk = (j) * 8 + q; const f32x4 w = src[q]; \
            const f32x4 s0 = *(const LAS f32x4*)(st + (kg * 65 + kk) * 8), s1 = *(const LAS f32x4*)(st + (kg * 65 + kk) * 8 + 4); \
            acc[0] += w * s0[0]; acc[1] += w * s0[1]; acc[2] += w * s0[2]; acc[3] += w * s0[3]; acc[4] += w * s1[0]; acc[5] += w * s1[1]; acc[6] += w * s1[2]; acc[7] += w * s1[3]; } } while (0)
        f32x4 wa[8], wb[8];
        MOD_LOAD8(wa, 0); __builtin_amdgcn_sched_barrier(0);
#pragma unroll 1
        for (int j = 0; j < 8; j += 2) {
            MOD_LOAD8(wb, j + 1); __builtin_amdgcn_sched_barrier(0);
            MOD_USE8(wa, j); __builtin_amdgcn_sched_barrier(0);
            { const int jn = j + 2 < 8 ? j + 2 : 7; MOD_LOAD8(wa, jn); } __builtin_amdgcn_sched_barrier(0);
            MOD_USE8(wb, j + 1); __builtin_amdgcn_sched_barrier(0);
        }
#undef MOD_LOAD8
#undef MOD_USE8
#pragma unroll
        for (int b = 0; b < 8; ++b) *(LAS f32x4*)(red + (kg * 8 + b) * 48 + 4 * cgp) = acc[b];
    }
    __syncthreads();
    if (F.tid < 384) {
        const int b = F.tid / 48, col = F.tid % 48; float s = p.b_ada[48 * u + col];
#pragma unroll
        for (int kg = 0; kg < 32; ++kg) s += red[(kg * 8 + b) * 48 + col];
        ((float*)(p.ws + WS_MOD))[b * (6 * DM) + 48 * u + col] = s;
    }
    __syncthreads();
}
struct CvtJob { const float* src; bf16_t* dst; int ld_src, ld_dst, qrows; float f8scale; };
constexpr int CVT_NT = 4;
#ifndef CVT_WGS
#define CVT_WGS 96
#endif
template <class JobFn>
__device__ __forceinline__ void cvt_stream(const Frame& F, int first, int stride, int total, JobFn job) {
    int v = first; if (v >= total) return;
    const int kr = F.tid >> 5, nc = (F.tid & 31) * 4, n = F.tid >> 2, kc = (F.tid & 3) * 16;
    CvtJob cur = job(v); f32x4 r[CVT_NT][4];
#define CVT_LOAD(jb) do { _Pragma("unroll") for (int q = 0; q < CVT_NT; ++q) _Pragma("unroll") for (int i = 0; i < 4; ++i) r[q][i] = __builtin_nontemporal_load((const f32x4*)((jb).src + (size_t)(kr + 16 * i) * (jb).ld_src + 128 * q + nc)); } while (0)
    CVT_LOAD(cur);
    int buf = 0;
    for (;;) {
        LAS unsigned char* t = F.lds + buf * (CVT_NT * 16384);
#pragma unroll
        for (int q = 0; q < CVT_NT; ++q)
#pragma unroll
            for (int i = 0; i < 4; ++i) *(LAS u32x2*)(t + q * 16384 + (kr + 16 * i) * 256 + nc * 2) = pack4(r[q][i]);
        const int vn = v + stride; const bool more = vn < total; CvtJob nx = cur;
        if (more) { nx = job(vn); CVT_LOAD(nx); }
        asm volatile("s_waitcnt lgkmcnt(0)" ::: "memory"); __builtin_amdgcn_s_barrier(); asm volatile("" ::: "memory");
#pragma unroll
        for (int q = 0; q < CVT_NT; ++q) { unsigned w[8];
#pragma unroll
          for (int e = 0; e < 8; ++e) { const unsigned lo = *(const LAS bf16_t*)(t + q * 16384 + (kc + 2 * e) * 256 + n * 2), hi = *(const LAS bf16_t*)(t + q * 16384 + (kc + 2 * e + 1) * 256 + n * 2); w[e] = lo | (hi << 16); }
          if (cur.f8scale != 0.f) { const float sc = cur.f8scale; unsigned f[4];
#pragma unroll
              for (int e = 0; e < 4; ++e) f[e] = pack_fp8x4(bflo(w[2 * e]) * sc, bfhi(w[2 * e]) * sc, bflo(w[2 * e + 1]) * sc, bfhi(w[2 * e + 1]) * sc);
              *(u32x4*)((unsigned char*)cur.dst + (size_t)(q * cur.qrows + n) * cur.ld_dst + kc) = (u32x4){f[0], f[1], f[2], f[3]}; }
          else { u32x4* d = (u32x4*)(cur.dst + (size_t)(q * cur.qrows + n) * cur.ld_dst + kc); d[0] = (u32x4){w[0], w[1], w[2], w[3]}; d[1] = (u32x4){w[4], w[5], w[6], w[7]}; } }
        if (!more) break;
        v = vn; buf ^= 1; cur = nx;
    }
#undef CVT_LOAD
    __syncthreads();
}
constexpr int P0_MOD = 256, P0_WIN = 1792, P0_WOUT = 512, P0_GU = 8192, P0_DOWN = 4096, P0_SMALL = 16, P0_RT = 24;
__device__ __forceinline__ void p0_prologue(const Params& p, const Frame& F) {
    bf16_t* wout_t = (bf16_t*)(p.ws + WS_WOUT); bf16_t* win_t = (bf16_t*)(p.ws + WS_WIN);
    for (int v = F.bid; v < P0_MOD; v += F.G) p0_mod_unit(p, F, v);
    cvt_stream(F, F.bid, F.G, (P0_WIN + P0_WOUT) / CVT_NT, [&](int g) -> CvtJob {
        int idx = g * CVT_NT;
        if (idx < P0_WIN) { const int kt = idx / 56, nt = idx % 56, n0 = 128 * nt, oc = n0 + (n0 >= 4096 ? 16 : 0);
            return CvtJob{p.w_in + (size_t)kt * 64 * WIN_LD + oc, win_t + (size_t)n0 * DM + kt * 64, WIN_LD, DM, 128, 0.f}; }
        idx -= P0_WIN; const int kt = idx / 16, nt = idx % 16;
        return CvtJob{p.w_out + (size_t)kt * 64 * DM + 128 * nt, wout_t + (size_t)(128 * nt) * DM + kt * 64, DM, DM, 128, 0.f}; });
    for (int v = F.bid; v < P0_SMALL + P0_RT; v += F.G) {
        int idx = v;
        if (idx < P0_SMALL) { bf16_t* sw = (bf16_t*)(p.ws + WS_SMALLW);
            for (int j = 0; j < 8; ++j) { const int i = idx * 4096 + j * 512 + F.tid, s = i >> 11, k = i & 2047;
                const float val = s < 24 ? p.w_in[(size_t)k * WIN_LD + (s < 16 ? 4096 + s : 7184 + s - 16)] : 0.f; sw[i] = f2bf(val); }
            continue; } idx -= P0_SMALL;
        { bf16_t* rw = (bf16_t*)(p.ws + WS_RTW);
            for (int j = 0; j < 8; ++j) { const int i = idx * 4096 + j * 512 + F.tid, n = i >> 11, k = i & 2047;
                const float val = n < 4 ? p.w_rg[k * 4 + n] : (n < 36 ? p.w_re[(size_t)((n - 4) >> 3) * DM * 8 + k * 8 + ((n - 4) & 7)] : 0.f);
                const bf16_t hi = f2bf(val); rw[i] = hi; rw[48 * DM + i] = f2bf(val - bf1(hi)); } }
    }
}
__device__ __forceinline__ void moe_weight_tiles(const Params& p, const Frame& F, int first, int stride) {
    bf16_t* w1 = (bf16_t*)((unsigned char*)p.out + OUT_W1); bf16_t* w2 = (bf16_t*)((unsigned char*)p.out + OUT_W2);
    cvt_stream(F, first, stride, (P0_GU + P0_DOWN) / CVT_NT, [&](int g) -> CvtJob {
        int idx = g * CVT_NT;
        if (idx < P0_GU) { const int e = idx >> 8, r = idx & 255, which = r >> 7, r2 = r & 127, kt = r2 >> 2;
            return CvtJob{(which ? p.w_up : p.w_gate) + (size_t)e * DM * DEXP + (size_t)kt * 64 * DEXP, (bf16_t*)((unsigned char*)w1 + (size_t)(e * 1024 + which * 128) * DM + kt * 64), DEXP, DM, 256, W1_SCALE}; }
        idx -= P0_GU; const int e = idx >> 7, r = idx & 127, kt = r >> 4, nt = r & 15;
        return CvtJob{p.w_down + (size_t)e * DEXP * DM + (size_t)kt * 64 * DM + 128 * nt, (bf16_t*)((unsigned char*)w2 + (size_t)(e * 2048 + 128 * nt) * DEXP + kt * 64), DM, DEXP, 128, W2_SCALE}; });
}

constexpr int H1_SW = 16384, H1_SWLD = 4112;
__device__ __forceinline__ void p1_hpass(const Params& p, const Frame& F) {
    const float* mod = (const float*)(p.ws + WS_MOD); bf16_t* hb = (bf16_t*)(p.ws + WS_HBUF); const bf16_t* sw = (const bf16_t*)(p.ws + WS_SMALLW); float* sm = (float*)(p.ws + WS_SM);
    const int fr = F.lane & 15, fq = F.lane >> 4;
    for (int i = F.tid; i < 32 * 256; i += 512) { const int r = i >> 8, ch = i & 255; *(LAS u32x4*)(F.lds + H1_SW + r * H1_SWLD + ch * 16) = *(const u32x4*)(sw + (size_t)r * DM + ch * 8); }
    int bcur = -1;
    for (int wt0 = F.bid * 8; wt0 < NTOK / 16; wt0 += F.G * 8) {
        const int wt = wt0 + F.wave, row0 = wt * 16, b = (wt0 * 16) / SEQ;
        if (b != bcur) { __syncthreads(); bcur = b;
            for (int i = F.tid; i < DM; i += 512) { ((LAS float*)F.lds)[i] = 1.f + mod[(size_t)b * (6 * DM) + DM + i]; ((LAS float*)F.lds)[DM + i] = mod[(size_t)b * (6 * DM) + i]; }
            __syncthreads(); }
        const float* xr = p.x + (size_t)(row0 + fr) * DM + 8 * fq; bf16_t* hr = hb + (size_t)(row0 + fr) * DM + 8 * fq;
        f32x4 a0 = {0.f, 0.f, 0.f, 0.f}, a1 = {0.f, 0.f, 0.f, 0.f};
        f32x4 xa[8][2], xn[8][2];
#define H1_LOAD(dst, blk_) do { _Pragma("unroll") for (int j = 0; j < 8; ++j) { dst[j][0] = __builtin_nontemporal_load((const f32x4*)(xr + 32 * (8 * (blk_) + j))); dst[j][1] = __builtin_nontemporal_load((const f32x4*)(xr + 32 * (8 * (blk_) + j) + 4)); } } while (0)
#define H1_COMP(src, blk_) do { _Pragma("unroll") for (int j = 0; j < 8; ++j) { const int s = 8 * (blk_) + j; \
                const f32x4 c0 = *(const LAS f32x4*)(F.lds + (32 * s + 8 * fq) * 4), c1 = *(const LAS f32x4*)(F.lds + (32 * s + 8 * fq) * 4 + 16); \
                const f32x4 h0 = *(const LAS f32x4*)(F.lds + 8192 + (32 * s + 8 * fq) * 4), h1 = *(const LAS f32x4*)(F.lds + 8192 + (32 * s + 8 * fq) * 4 + 16); \
                const bf16x8 af = pack8(src[j][0] * c0 + h0, src[j][1] * c1 + h1); \
                *(bf16x8*)(hr + 32 * s) = af; \
                const bf16x8 b0 = *(const LAS bf16x8*)(F.lds + H1_SW + fr * H1_SWLD + (32 * s + 8 * fq) * 2), b1 = *(const LAS bf16x8*)(F.lds + H1_SW + (16 + fr) * H1_SWLD + (32 * s + 8 * fq) * 2); \
                a0 = mfma16(af, b0, a0); a1 = mfma16(af, b1, a1); } } while (0)
        H1_LOAD(xa, 0);
#pragma unroll 1
        for (int bp = 0; bp < 4; ++bp) {
            H1_LOAD(xn, 2 * bp + 1); H1_COMP(xa, 2 * bp);
            if (bp < 3) H1_LOAD(xa, 2 * bp + 2);
            H1_COMP(xn, 2 * bp + 1);
        }
#undef H1_LOAD
#undef H1_COMP
#pragma unroll
        for (int j = 0; j < 4; ++j) { float* o = sm + (size_t)(row0 + 4 * fq + j) * 32; o[fr] = a0[j]; o[16 + fr] = a1[j]; }
    }
    __syncthreads();
}

constexpr int D1_KN = 0, D1_QN = 17408, D1_VN = 34816, D1_AOFF = 52224, D1_TM = 61440, D1_TB = 70656, D1_TG = 79872, D1_ADIAG = 89088, D1_GATES = 93440;
constexpr int D1_CW = 94464;
struct D1Pre { u32x4 x[3][5]; float gb, ga; };
__device__ __forceinline__ void d1_prefetch(const Params& p, const Frame& F, int u, D1Pre& P) {
    const int bh = u >> 6, c = u & 63, b = bh >> 3, h = bh & 7, row0 = b * SEQ + c * 64;
    const bf16_t* proj = (const bf16_t*)(p.ws + WS_PROJ); const float* sm = (const float*)(p.ws + WS_SM);
    const int cg = F.tid & 15, t0 = 2 * (F.tid >> 4);
#pragma unroll
    for (int part = 0; part < 3; ++part)
#pragma unroll
        for (int j = 0; j < 5; ++j) { const int tt = c * 64 + t0 - 3 + j; const int tc = tt >= 0 ? t0 - 3 + j : 0;
            P.x[part][j] = *(const u32x4*)(proj + (size_t)(row0 + tc) * LDP + part * 1024 + h * HD + 8 * cg); }
    const float* r = sm + (size_t)(row0 + F.lane) * 32; P.gb = r[h]; P.ga = r[8 + h];
}
__device__ __forceinline__ void d1_chunk(const Params& p, const Frame& F, int u, D1Pre& P, int unext) {
    LAS unsigned char* lds = F.lds;
    const int tid = F.tid, lane = F.lane, wave = F.wave, fr = lane & 15, fq = lane >> 4;
    const int bh = u >> 6, c = u & 63, h = bh & 7;
    unsigned char* outc = p.ws + WS_DN + (size_t)u * DN_CHUNK;
    LAS float* Gs = (LAS float*)(lds + D1_GATES); LAS float* Bs = Gs + 64; LAS float* EGs = Gs + 128;
    if (wave == 0) {
        const float bl = P.gb, al = P.ga;
        const float beta = __builtin_amdgcn_rcpf(1.f + __expf(-bl));
        const float xs = al + p.dt_bias[h];
        const float sp = xs > 20.f ? xs : log1pf(__expf(xs));
        float G = -__expf(p.a_log[h]) * sp;
#pragma unroll
        for (int o = 1; o < 64; o <<= 1) { const float v = __shfl_up(G, o); if (lane >= o) G += v; }
        Gs[lane] = G; Bs[lane] = beta; EGs[lane] = __expf(G);
    }
    {
        const int cg = tid & 15, rp = tid >> 4, t0 = 2 * rp;
#pragma unroll
        for (int part = 0; part < 3; ++part) {
            float cw[4][8];
#pragma unroll
            for (int tp = 0; tp < 4; ++tp) { const f32x4 w0 = *(const LAS f32x4*)(lds + D1_CW + ((part * 4 + tp) * 128 + 8 * cg) * 4), w1 = *(const LAS f32x4*)(lds + D1_CW + ((part * 4 + tp) * 128 + 8 * cg + 4) * 4);
                cw[tp][0] = w0[0]; cw[tp][1] = w0[1]; cw[tp][2] = w0[2]; cw[tp][3] = w0[3]; cw[tp][4] = w1[0]; cw[tp][5] = w1[1]; cw[tp][6] = w1[2]; cw[tp][7] = w1[3]; }
            float o0[8], o1[8];
#pragma unroll
            for (int e = 0; e < 8; ++e) { o0[e] = 0.f; o1[e] = 0.f; }
#pragma unroll
            for (int j = 0; j < 5; ++j) { u32x4 xr = P.x[part][j];
                if (j < 3) { const bool valid = c * 64 + t0 - 3 + j >= 0; xr.x = valid ? xr.x : 0u; xr.y = valid ? xr.y : 0u; xr.z = valid ? xr.z : 0u; xr.w = valid ? xr.w : 0u; }
                float xf[8]; unpack8(xr, xf);
#pragma unroll
                for (int e = 0; e < 8; ++e) { const float xv = xf[e]; if (j < 4) o0[e] += cw[j][e] * xv; if (j >= 1) o1[e] += cw[j - 1][e] * xv; } }
            float s0 = 0.f, s1 = 0.f;
#pragma unroll
            for (int e = 0; e < 8; ++e) { o0[e] = silu_f(o0[e]); o1[e] = silu_f(o1[e]); s0 += o0[e] * o0[e]; s1 += o1[e] * o1[e]; }
            if (part < 2) {
#pragma unroll
                for (int o = 1; o < 16; o <<= 1) { s0 += __shfl_xor(s0, o); s1 += __shfl_xor(s1, o); }
                const float r0 = rsqrtf(s0 + NORM_EPS), r1 = rsqrtf(s1 + NORM_EPS);
#pragma unroll
                for (int e = 0; e < 8; ++e) { o0[e] *= r0; o1[e] *= r1; }
            }
            const int img = part == 0 ? D1_QN : (part == 1 ? D1_KN : D1_VN);
            *(LAS bf16x8*)(lds + img + t0 * 272 + cg * 16) = pack8((f32x4){o0[0], o0[1], o0[2], o0[3]}, (f32x4){o0[4], o0[5], o0[6], o0[7]});
            *(LAS bf16x8*)(lds + img + (t0 + 1) * 272 + cg * 16) = pack8((f32x4){o1[0], o1[1], o1[2], o1[3]}, (f32x4){o1[4], o1[5], o1[6], o1[7]});
            __builtin_amdgcn_sched_barrier(0);
        }
    }
    d1_prefetch(p, F, unext, P);
    __syncthreads();
#define D1_TILE_JOB(job_) do { const int job = (job_), kind = job >> 4, ti = (job >> 2) & 3, tj = job & 3; \
        const int icol = 16 * ti + fr, j0 = 16 * tj + 4 * fq; \
        if (tj > ti) { if (kind == 1) *(u32x2*)(outc + DN_QK + icol * 144 + j0 * 2) = (u32x2){0u, 0u}; break; } \
        f32x4 acc = {0.f, 0.f, 0.f, 0.f}; \
        const int ybase = kind ? D1_QN : D1_KN; \
        _Pragma("unroll") for (int s = 0; s < 4; ++s) { \
            const bf16x8 a = *(const LAS bf16x8*)(lds + D1_KN + (16 * tj + fr) * 272 + (32 * s + 8 * fq) * 2); \
            const bf16x8 bb = *(const LAS bf16x8*)(lds + ybase + (16 * ti + fr) * 272 + (32 * s + 8 * fq) * 2); \
            acc = mfma16(a, bb, acc); } \
        const float Gi = Gs[icol]; const f32x4 Gj = *(const LAS f32x4*)(Gs + j0); \
        f32x4 v; \
        if (kind == 0) { const float bi = Bs[icol]; \
            _Pragma("unroll") for (int e = 0; e < 4; ++e) v[e] = (j0 + e < icol) ? bi * acc[e] * __expf(Gi - Gj[e]) : 0.f; \
            if (tj < ti) *(LAS u32x2*)(lds + D1_AOFF + icol * 144 + j0 * 2) = pack4(v); \
            else *(LAS f32x4*)(lds + D1_ADIAG + ti * 1040 + fr * 64 + fq * 16) = v; \
        } else { \
            _Pragma("unroll") for (int e = 0; e < 4; ++e) v[e] = (j0 + e <= icol) ? acc[e] * __expf(Gi - Gj[e]) * QSCALE : 0.f; \
            *(u32x2*)(outc + DN_QK + icol * 144 + j0 * 2) = pack4(v); \
        } } while (0)
#pragma unroll 1
    for (int jj = 0; jj < 2; ++jj) D1_TILE_JOB(wave + 8 * jj);
    __syncthreads();
    if (wave == 0) {
        { const int blk = lane >> 4, jc = lane & 15; float t[16];
#pragma unroll
          for (int i = 0; i < 16; ++i) { float a4[4] = {(jc == i) ? 1.f : 0.f, 0.f, 0.f, 0.f};
#pragma unroll
              for (int m4 = 0; m4 < (i + 3) / 4; ++m4) { const f32x4 ar = *(const LAS f32x4*)(lds + D1_ADIAG + blk * 1040 + i * 64 + m4 * 16);
#pragma unroll
                  for (int e = 0; e < 4; ++e) if (4 * m4 + e < i) a4[e] -= ar[e] * t[4 * m4 + e]; }
              t[i] = (a4[0] + a4[1]) + (a4[2] + a4[3]); if ((i & 3) == 3) __builtin_amdgcn_sched_barrier(0); }
          const int j = 16 * blk + jc; const float bj = Bs[j], bgj = bj * EGs[j];
#pragma unroll
          for (int i = 0; i < 16; ++i) { const int off = (16 * blk + i) * 144 + j * 2;
              *(LAS bf16_t*)(lds + D1_TM + off) = f2bf(t[i]); *(LAS bf16_t*)(lds + D1_TB + off) = f2bf(t[i] * bj); *(LAS bf16_t*)(lds + D1_TG + off) = f2bf(t[i] * bgj); } }
        LGKM0();
        const int tmaddr = (int)(uintptr_t)(lds + D1_TM);
#pragma unroll
        for (int bb = 1; bb < 4; ++bb) {
            constexpr int NS_MAX = 2;
            bf16x8 a[NS_MAX]; s16x4 l[3][NS_MAX], hh[3][NS_MAX];
            const int ns = bb == 3 ? 2 : 1;
#pragma unroll
            for (int s_ = 0; s_ < NS_MAX; ++s_) if (s_ < ns) a[s_] = *(const LAS bf16x8*)(lds + D1_AOFF + (16 * bb + fr) * 144 + (32 * s_ + 8 * fq) * 2);
#pragma unroll
            for (int cc = 0; cc < 3; ++cc) if (cc < bb)
#pragma unroll
                for (int s_ = 0; s_ < NS_MAX; ++s_) if (s_ < ns) { const int ad = tmaddr + (32 * s_ + 8 * fq + (fr >> 2)) * 144 + (16 * cc + 4 * (fr & 3)) * 2; TRRD(l[cc][s_], ad, 0); TRRD(hh[cc][s_], ad, 576); }
            const u32x2 t2 = *(const LAS u32x2*)(lds + D1_TM + (16 * bb + fr) * 144 + (16 * bb + 4 * fq) * 2);
            LGKM0();
            f32x4 X[3];
#pragma unroll
            for (int cc = 0; cc < 3; ++cc) if (cc < bb) { X[cc] = (f32x4){0.f, 0.f, 0.f, 0.f};
#pragma unroll
                for (int s_ = 0; s_ < NS_MAX; ++s_) if (s_ < ns) X[cc] = mfma16(a[s_], join8(l[cc][s_], hh[cc][s_]), X[cc]); }
#pragma unroll
            for (int cc = 0; cc < 3; ++cc) if (cc < bb) {
                u32x4 aw = {t2.x, t2.y, 0u, 0u}, bw = {cvtpk(X[cc][0], X[cc][1]), cvtpk(X[cc][2], X[cc][3]), 0u, 0u};
                const f32x4 Tn = mfma16(*reinterpret_cast<bf16x8*>(&aw), *reinterpret_cast<bf16x8*>(&bw), (f32x4){0.f, 0.f, 0.f, 0.f});
                const int j = 16 * cc + fr; const float bj = Bs[j], bgj = bj * EGs[j];
#pragma unroll
                for (int e = 0; e < 4; ++e) { const int off = (16 * bb + 4 * fq + e) * 144 + j * 2; const float tv = -Tn[e];
                    *(LAS bf16_t*)(lds + D1_TM + off) = f2bf(tv); *(LAS bf16_t*)(lds + D1_TB + off) = f2bf(tv * bj); *(LAS bf16_t*)(lds + D1_TG + off) = f2bf(tv * bgj); }
            }
            LGKM0();
        }
    } else {
        const int t7 = tid - 64; const float Glast = Gs[63];
        for (int i = t7; i < 1024; i += 448) { const int r = i >> 4, ch = i & 15; float f[8]; unpack8(*(const LAS u32x4*)(lds + D1_QN + r * 272 + ch * 16), f); const float sc = EGs[r] * QSCALE;
            *(bf16x8*)(outc + DN_Q + r * 272 + ch * 16) = pack8((f32x4){f[0] * sc, f[1] * sc, f[2] * sc, f[3] * sc}, (f32x4){f[4] * sc, f[5] * sc, f[6] * sc, f[7] * sc}); }
        for (int i = t7; i < 1024; i += 448) { const int dk = i & 127, ich = i >> 7; float f[8];
#pragma unroll
            for (int e = 0; e < 8; ++e) f[e] = bf1(*(const LAS bf16_t*)(lds + D1_KN + (8 * ich + e) * 272 + dk * 2)) * __expf(Glast - Gs[8 * ich + e]);
            *(bf16x8*)(outc + DN_KT + dk * 144 + ich * 16) = pack8((f32x4){f[0], f[1], f[2], f[3]}, (f32x4){f[4], f[5], f[6], f[7]}); }
        if (t7 == 0) *(float*)(outc + DN_MISC) = __expf(Glast);
#pragma unroll 1
        for (int jq = 16 + wave - 1; jq < 32; jq += 7) D1_TILE_JOB(jq);
    }
#undef D1_TILE_JOB
    __syncthreads();
    { const int vnaddr = (int)(uintptr_t)(lds + D1_VN), knaddr = (int)(uintptr_t)(lds + D1_KN);
#pragma unroll
      for (int jp = 0; jp < 2; ++jp) {
        bf16x8 a[2][2]; s16x4 l[2][2], hh[2][2];
#pragma unroll
        for (int q = 0; q < 2; ++q)
#pragma unroll
            for (int s_ = 0; s_ < 2; ++s_) { const int it = 2 * jp + q;
                a[q][s_] = *(const LAS bf16x8*)(lds + D1_TB + (16 * it + fr) * 144 + (32 * s_ + 8 * fq) * 2);
                const int ad = vnaddr + (32 * s_ + 8 * fq + (fr >> 2)) * 272 + (16 * wave + 4 * (fr & 3)) * 2;
                TRRD(l[q][s_], ad, 0); TRRD(hh[q][s_], ad, 1088); }
        LGKM0();
#pragma unroll
        for (int q = 0; q < 2; ++q) { const int it = 2 * jp + q; f32x4 acc = {0.f, 0.f, 0.f, 0.f};
            acc = mfma16(a[q][0], join8(l[q][0], hh[q][0]), acc); acc = mfma16(a[q][1], join8(l[q][1], hh[q][1]), acc);
            *(u32x2*)(outc + DN_UT + (16 * wave + fr) * 128 + (16 * it + 4 * fq) * 2) = pack4(acc); }
      }
#pragma unroll
      for (int jp = 0; jp < 2; ++jp) {
        const int it = wave & 3;
        bf16x8 bb[2]; s16x4 l[2][2], hh[2][2];
#pragma unroll
        for (int s_ = 0; s_ < 2; ++s_) bb[s_] = *(const LAS bf16x8*)(lds + D1_TG + (16 * it + fr) * 144 + (32 * s_ + 8 * fq) * 2);
#pragma unroll
        for (int q = 0; q < 2; ++q)
#pragma unroll
            for (int s_ = 0; s_ < 2; ++s_) { const int dkt = 4 * jp + 2 * q + (wave >> 2);
                const int ad = knaddr + (32 * s_ + 8 * fq + (fr >> 2)) * 272 + (16 * dkt + 4 * (fr & 3)) * 2;
                TRRD(l[q][s_], ad, 0); TRRD(hh[q][s_], ad, 1088); }
        LGKM0();
#pragma unroll
        for (int q = 0; q < 2; ++q) { const int dkt = 4 * jp + 2 * q + (wave >> 2); f32x4 acc = {0.f, 0.f, 0.f, 0.f};
            acc = mfma16(join8(l[q][0], hh[q][0]), bb[0], acc); acc = mfma16(join8(l[q][1], hh[q][1]), bb[1], acc);
            *(u32x2*)(outc + DN_W + (16 * it + fr) * 272 + (16 * dkt + 4 * fq) * 2) = pack4(-acc); }
      } }
    __syncthreads();
}
__device__ __forceinline__ void fcum_unit(const Params& p, const Frame& F, int bh) {
    const float* sm = (const float*)(p.ws + WS_SM); float* fc = (float*)(p.ws + WS_FCUM) + (size_t)bh * SEQ;
    const int b = bh >> 3, h = bh & 7; const float fb = p.f_bias[h];
    LAS float* red = (LAS float*)F.lds;
    float v[8], s = 0.f;
#pragma unroll
    for (int e = 0; e < 8; ++e) { const float z = sm[(size_t)(b * SEQ + F.tid * 8 + e) * 32 + 16 + h] + fb; const float ls = fminf(z, 0.f) - log1pf(__expf(-fabsf(z))); s += ls; v[e] = s; }
    float inc = s;
#pragma unroll
    for (int o = 1; o < 64; o <<= 1) { const float t = __shfl_up(inc, o); if (F.lane >= o) inc += t; }
    if (F.lane == 63) red[F.wave] = inc;
    __syncthreads();
    float base = inc - s;
    for (int w = 0; w < F.wave; ++w) base += red[w];
#pragma unroll
    for (int e = 0; e < 8; ++e) fc[F.tid * 8 + e] = -(base + v[e]) * 11.313708498984761f;
    __syncthreads();
}
__device__ __forceinline__ int d1_unit(int bid, int i) { const int h = bid & 7, j = (bid >> 3) + 32 * i, b = j >> 6, c = j & 63; return ((b * 8 + h) << 6) + c; }
__device__ __forceinline__ void p3_dnprep(const Params& p, const Frame& F) {
    if (F.G == 256) {
        const int h = F.bid & 7;
        for (int i = F.tid; i < 3 * 4 * 128; i += 512) { const int part = i / 512, tp = (i >> 7) & 3, ch = i & 127; ((LAS float*)(F.lds + D1_CW))[i] = p.conv_w[tp * 3072 + part * 1024 + h * HD + ch]; }
        for (int i = F.tid; i < 2304; i += 512) *(LAS u32x4*)(F.lds + D1_AOFF + i * 16) = (u32x4){0u, 0u, 0u, 0u};
        D1Pre P; d1_prefetch(p, F, d1_unit(F.bid, 0), P);
        __syncthreads();
#pragma unroll 1
        for (int i = 0; i < 16; ++i) d1_chunk(p, F, d1_unit(F.bid, i), P, d1_unit(F.bid, i < 15 ? i + 1 : i));
    } else {
        for (int u = F.bid; u < 4096; u += F.G) { const int h = (u >> 6) & 7;
            __syncthreads();
            for (int i = F.tid; i < 3 * 4 * 128; i += 512) { const int part = i / 512, tp = (i >> 7) & 3, ch = i & 127; ((LAS float*)(F.lds + D1_CW))[i] = p.conv_w[tp * 3072 + part * 1024 + h * HD + ch]; }
            for (int i = F.tid; i < 2304; i += 512) *(LAS u32x4*)(F.lds + D1_AOFF + i * 16) = (u32x4){0u, 0u, 0u, 0u};
            D1Pre P; d1_prefetch(p, F, u, P);
            __syncthreads();
            d1_chunk(p, F, u, P, u); }
    }
    if (F.bid < 64) fcum_unit(p, F, F.bid);
    for (int u = F.bid; u < 256; u += F.G) { const int bh = u >> 2, seg = u & 3, b = bh >> 3, h = bh & 7;
        const bf16_t* proj = (const bf16_t*)(p.ws + WS_PROJ); float q2m = 0.f, k2m = 0.f;
        for (int r = F.tid >> 4; r < 1024; r += 32) { const bf16_t* rowp = proj + (size_t)(b * SEQ + seg * 1024 + r) * LDP + h * HD + 8 * (F.tid & 15);
            float qf[8], kf[8]; unpack8(*(const u32x4*)(rowp + FQ), qf); unpack8(*(const u32x4*)(rowp + FK), kf);
            float q2 = 0.f, k2 = 0.f;
#pragma unroll
            for (int e = 0; e < 8; ++e) { q2 += qf[e] * qf[e]; k2 += kf[e] * kf[e]; }
#pragma unroll
            for (int m = 1; m < 16; m <<= 1) { q2 += __shfl_xor(q2, m); k2 += __shfl_xor(k2, m); }
            q2m = fmaxf(q2m, q2); k2m = fmaxf(k2m, k2); }
#pragma unroll
        for (int m = 16; m < 64; m <<= 1) { q2m = fmaxf(q2m, __shfl_xor(q2m, m)); k2m = fmaxf(k2m, __shfl_xor(k2m, m)); }
        if (F.lane == 0) { unsigned* mx = (unsigned*)(p.ws + WS_CTL) + CW_QKMAX + 2 * bh; atomicMax(mx, __float_as_uint(q2m)); atomicMax(mx + 1, __float_as_uint(k2m)); } }
}

constexpr int SC_W = 0, SC_KT = 17408, SC_Q = 35840, SC_QK = 53248, SC_ST = 62464, SC_VT = 97280, SC_OB = 115712, SC_END = 133120, SC_UT = 133120, SC_DC = SC_UT + 16384, SC_NW = SC_DC + 64;
__device__ __forceinline__ void scan_unit(const Params& p, const Frame& F, int bh) {
    LAS unsigned char* lds = F.lds;
    const int tid = F.tid, lane = F.lane, wave = F.wave, fr = lane & 15, fq = lane >> 4;
    const int b = bh >> 3, h = bh & 7;
    const unsigned char* dn = p.ws + WS_DN + (size_t)bh * 64 * DN_CHUNK;
    const bf16_t* proj = (const bf16_t*)(p.ws + WS_PROJ); bf16_t* cat = (bf16_t*)(p.ws + WS_HBUF);
    if (wave < 4) {
        LAS unsigned char* ST = lds + SC_ST + wave * 8704; LAS unsigned char* VT = lds + SC_VT + wave * 4608;
        f32x4 S[8][2];
#pragma unroll
        for (int a = 0; a < 8; ++a) { S[a][0] = (f32x4){0.f, 0.f, 0.f, 0.f}; S[a][1] = (f32x4){0.f, 0.f, 0.f, 0.f}; }
#define LDF(base, pitch, rt, s) (*(const LAS bf16x8*)(lds + (base) + (16 * (rt) + fr) * (pitch) + (32 * (s) + 8 * fq) * 2))
#define SCHED() __builtin_amdgcn_sched_barrier(0)
#define SSTEP(c) do { \
            _Pragma("unroll") for (int dkt = 0; dkt < 8; ++dkt) _Pragma("unroll") for (int dvt = 0; dvt < 2; ++dvt) *(LAS u32x2*)(ST + (16 * dvt + fr) * 272 + (16 * dkt + 4 * fq) * 2) = pack4(S[dkt][dvt]); \
            LBAR();                                                                                 \
            bf16x8 bs[2][4], fa[8], fb[8]; \
            _Pragma("unroll") for (int dvt = 0; dvt < 2; ++dvt) _Pragma("unroll") for (int s = 0; s < 4; ++s) bs[dvt][s] = *(const LAS bf16x8*)(ST + (16 * dvt + fr) * 272 + (32 * s + 8 * fq) * 2); \
            _Pragma("unroll") for (int i = 0; i < 8; ++i) fa[i] = LDF(SC_W, 272, i >> 2, i & 3); \
            SCHED(); \
            f32x4 va[2][2], vb[2][2]; \
            const float DC = *(const LAS float*)(lds + SC_DC); \
            _Pragma("unroll") for (int it = 0; it < 2; ++it) _Pragma("unroll") for (int dvt = 0; dvt < 2; ++dvt) { \
                const u32x2 ua = *(const LAS u32x2*)(lds + SC_UT + (32 * wave + 16 * dvt + fr) * 128 + (16 * it + 4 * fq) * 2), ub = *(const LAS u32x2*)(lds + SC_UT + (32 * wave + 16 * dvt + fr) * 128 + (16 * (2 + it) + 4 * fq) * 2); \
                va[it][dvt] = (f32x4){bflo(ua.x), bfhi(ua.x), bflo(ua.y), bfhi(ua.y)}; vb[it][dvt] = (f32x4){bflo(ub.x), bfhi(ub.x), bflo(ub.y), bfhi(ub.y)}; } \
            _Pragma("unroll") for (int i = 0; i < 8; ++i) fb[i] = LDF(SC_W, 272, 2 + (i >> 2), i & 3); \
            SCHED(); \
            _Pragma("unroll") for (int i = 0; i < 8; ++i) { va[i >> 2][0] = mfma16(fa[i], bs[0][i & 3], va[i >> 2][0]); va[i >> 2][1] = mfma16(fa[i], bs[1][i & 3], va[i >> 2][1]); } \
            SCHED(); \
            _Pragma("unroll") for (int i = 0; i < 8; ++i) fa[i] = LDF(SC_KT, 144, i >> 1, i & 1); \
            _Pragma("unroll") for (int it = 0; it < 2; ++it) _Pragma("unroll") for (int dvt = 0; dvt < 2; ++dvt) *(LAS u32x2*)(VT + (16 * dvt + fr) * 144 + (16 * it + 4 * fq) * 2) = pack4(va[it][dvt]); \
            SCHED(); \
            _Pragma("unroll") for (int i = 0; i < 8; ++i) { vb[i >> 2][0] = mfma16(fb[i], bs[0][i & 3], vb[i >> 2][0]); vb[i >> 2][1] = mfma16(fb[i], bs[1][i & 3], vb[i >> 2][1]); } \
            _Pragma("unroll") for (int it = 0; it < 2; ++it) _Pragma("unroll") for (int dvt = 0; dvt < 2; ++dvt) *(LAS u32x2*)(VT + (16 * dvt + fr) * 144 + (16 * (2 + it) + 4 * fq) * 2) = pack4(vb[it][dvt]); \
            bf16x8 bv[2][2]; \
            _Pragma("unroll") for (int dvt = 0; dvt < 2; ++dvt) _Pragma("unroll") for (int s = 0; s < 2; ++s) bv[dvt][s] = *(const LAS bf16x8*)(VT + (16 * dvt + fr) * 144 + (32 * s + 8 * fq) * 2); \
            _Pragma("unroll") for (int i = 0; i < 8; ++i) fb[i] = LDF(SC_KT, 144, 4 + (i >> 1), i & 1); \
            SCHED(); \
            _Pragma("unroll") for (int dkt = 0; dkt < 8; ++dkt) { S[dkt][0] *= DC; S[dkt][1] *= DC; } \
            _Pragma("unroll") for (int i = 0; i < 8; ++i) { S[i >> 1][0] = mfma16(fa[i], bv[0][i & 1], S[i >> 1][0]); S[i >> 1][1] = mfma16(fa[i], bv[1][i & 1], S[i >> 1][1]); } \
            _Pragma("unroll") for (int i = 0; i < 8; ++i) { S[4 + (i >> 1)][0] = mfma16(fb[i], bv[0][i & 1], S[4 + (i >> 1)][0]); S[4 + (i >> 1)][1] = mfma16(fb[i], bv[1][i & 1], S[4 + (i >> 1)][1]); } \
            LBAR();                                                                                 \
              \
            bf16x8 bq[2][4];                                                                       \
            _Pragma("unroll") for (int dvt = 0; dvt < 2; ++dvt) _Pragma("unroll") for (int s = 0; s < 4; ++s) bq[dvt][s] = *(const LAS bf16x8*)(ST + (16 * dvt + fr) * 272 + (32 * s + 8 * fq) * 2); \
            _Pragma("unroll") for (int i = 0; i < 4; ++i) fa[i] = LDF(SC_Q, 272, 0, i); \
            fa[4] = LDF(SC_QK, 144, 0, 0); fa[5] = LDF(SC_QK, 144, 0, 1); \
            _Pragma("unroll") for (int i = 0; i < 4; ++i) fb[i] = LDF(SC_Q, 272, 1, i); \
            fb[4] = LDF(SC_QK, 144, 1, 0); fb[5] = LDF(SC_QK, 144, 1, 1); \
            SCHED(); \
            _Pragma("unroll") for (int it = 0; it < 4; ++it) { \
                f32x4 o0 = {0.f, 0.f, 0.f, 0.f}, o1 = {0.f, 0.f, 0.f, 0.f}; \
                if ((it & 1) == 0) { \
                    _Pragma("unroll") for (int i = 0; i < 4; ++i) { o0 = mfma16(fa[i], bq[0][i], o0); o1 = mfma16(fa[i], bq[1][i], o1); } \
                    _Pragma("unroll") for (int i = 0; i < 2; ++i) { o0 = mfma16(fa[4 + i], bv[0][i], o0); o1 = mfma16(fa[4 + i], bv[1][i], o1); } \
                    SCHED(); \
                    if (it + 2 < 4) { _Pragma("unroll") for (int i = 0; i < 4; ++i) fa[i] = LDF(SC_Q, 272, it + 2, i); fa[4] = LDF(SC_QK, 144, it + 2, 0); fa[5] = LDF(SC_QK, 144, it + 2, 1); } \
                } else { \
                    _Pragma("unroll") for (int i = 0; i < 4; ++i) { o0 = mfma16(fb[i], bq[0][i], o0); o1 = mfma16(fb[i], bq[1][i], o1); } \
                    _Pragma("unroll") for (int i = 0; i < 2; ++i) { o0 = mfma16(fb[4 + i], bv[0][i], o0); o1 = mfma16(fb[4 + i], bv[1][i], o1); } \
                    SCHED(); \
                    if (it + 2 < 4) { _Pragma("unroll") for (int i = 0; i < 4; ++i) fb[i] = LDF(SC_Q, 272, it + 2, i); fb[4] = LDF(SC_QK, 144, it + 2, 0); fb[5] = LDF(SC_QK, 144, it + 2, 1); } \
                } \
                _Pragma("unroll") for (int e = 0; e < 4; ++e) { const int i_ = 16 * it + 4 * fq + e; \
                    *(LAS bf16_t*)(lds + SC_OB + i_ * 272 + (32 * wave + fr) * 2) = f2bf(o0[e]); *(LAS bf16_t*)(lds + SC_OB + i_ * 272 + (32 * wave + 16 + fr) * 2) = f2bf(o1[e]); } \
                SCHED(); \
            } } while (0)
#pragma unroll 1
        for (int c2 = 0; c2 < 64; ++c2) { SSTEP(c2); }
#undef SSTEP
#undef LDF
#undef SCHED
        __syncthreads();
    } else {
        const int ht = tid - 256;
        u32x4 ra0[9], ra1[9], rb0[7], ru0[4], ru1[4]; float rd0, rd1;
#define LOADA(ra, ru, rd, cc) do { const int cc_ = (cc) < 64 ? (cc) : 63; const unsigned char* s_ = dn + (size_t)cc_ * DN_CHUNK; \
        _Pragma("unroll") for (int i = 0; i < 9; ++i) ra[i] = *(const u32x4*)(s_ + DN_W + (size_t)(ht + 256 * i) * 16); \
        _Pragma("unroll") for (int i = 0; i < 4; ++i) ru[i] = *(const u32x4*)(s_ + DN_UT + (size_t)(ht + 256 * i) * 16); rd = *(const float*)(s_ + DN_MISC); } while (0)
#define WRITEA(ra, ru, rd) do { _Pragma("unroll") for (int i = 0; i < 9; ++i) if (i < 8 || ht < 192) *(LAS u32x4*)(lds + SC_W + (ht + 256 * i) * 16) = ra[i]; \
        _Pragma("unroll") for (int i = 0; i < 4; ++i) *(LAS u32x4*)(lds + SC_UT + (ht + 256 * i) * 16) = ru[i]; if (ht == 0) *(LAS float*)(lds + SC_DC) = rd; } while (0)
#define LOADB(rb, cc) do { const int cc_ = (cc) < 64 ? (cc) : 63; const unsigned char* s_ = dn + (size_t)cc_ * DN_CHUNK + DN_Q; _Pragma("unroll") for (int i = 0; i < 7; ++i) rb[i] = *(const u32x4*)(s_ + (size_t)(ht + 256 * i) * 16); } while (0)
#define WRITEB(rb) do { _Pragma("unroll") for (int i = 0; i < 7; ++i) if (i < 6 || ht < 128) *(LAS u32x4*)(lds + SC_Q + (ht + 256 * i) * 16) = rb[i]; } while (0)
        LOADA(ra0, ru0, rd0, 0); WRITEA(ra0, ru0, rd0); LOADA(ra1, ru1, rd1, 1); LOADA(ra0, ru0, rd0, 2); LOADB(rb0, 0);
        const int ei = ht >> 2, ecg = ht & 3;
        const bf16_t* zbase = proj + (size_t)(b * SEQ + ei) * LDP + PZ + h * HD + 32 * ecg;
        if (ht < 32) *(LAS f32x4*)(lds + SC_NW + ht * 16) = *(const f32x4*)(p.norm_w + 4 * ht);
        u32x4 zr0[4];
#pragma unroll
        for (int k = 0; k < 4; ++k) zr0[k] = *(const u32x4*)(zbase + 8 * k);
#define EPILOG(ce) do { \
                const int row = b * SEQ + (ce) * 64 + ei; \
                float ss = 0.f; \
                _Pragma("unroll") for (int k = 0; k < 4; ++k) { float o[8]; unpack8(*(const LAS u32x4*)(lds + SC_OB + ei * 272 + (32 * ecg + 8 * k) * 2), o); \
                    _Pragma("unroll") for (int e = 0; e < 8; ++e) ss += o[e] * o[e]; } \
                ss += __shfl_xor(ss, 1); ss += __shfl_xor(ss, 2); \
                const float rs = rsqrtf(ss * (1.f / 128.f) + NORM_EPS); \
                bf16_t* op = cat + (size_t)row * DM + h * HD + 32 * ecg; \
                _Pragma("unroll") for (int k = 0; k < 4; ++k) { float z[8], o[8]; unpack8(zr0[k], z); unpack8(*(const LAS u32x4*)(lds + SC_OB + ei * 272 + (32 * ecg + 8 * k) * 2), o); float r[8]; \
                    const f32x4 nw0 = *(const LAS f32x4*)(lds + SC_NW + (32 * ecg + 8 * k) * 4), nw1 = *(const LAS f32x4*)(lds + SC_NW + (32 * ecg + 8 * k + 4) * 4); \
                    _Pragma("unroll") for (int e = 0; e < 8; ++e) r[e] = o[e] * rs * (e < 4 ? nw0[e] : nw1[e - 4]) * silu_f(z[e]); \
                    *(bf16x8*)(op + 8 * k) = pack8((f32x4){r[0], r[1], r[2], r[3]}, (f32x4){r[4], r[5], r[6], r[7]}); } } while (0)
#define HSTEP(c, RBX, RAY, RUY, RDY) do { \
            LBAR();                                                                                 \
            WRITEB(RBX); LOADB(RBX, (c) + 1); \
            { const int ce = (c) > 0 ? (c) - 1 : 0; EPILOG(ce); } \
            { _Pragma("unroll") for (int k = 0; k < 4; ++k) zr0[k] = *(const u32x4*)(zbase + (size_t)(c) * 64 * LDP + 8 * k); }     \
            LBAR();                                                                                 \
            WRITEA(RAY, RUY, RDY); LOADA(RAY, RUY, RDY, (c) + 3); \
            } while (0)
#pragma unroll 1
        for (int c2 = 0; c2 < 64; c2 += 2) { HSTEP(c2, rb0, ra1, ru1, rd1); HSTEP(c2 + 1, rb0, ra0, ru0, rd0); }
        __syncthreads();
        EPILOG(63);
#undef HSTEP
#undef EPILOG
#undef LOADA
#undef WRITEA
#undef LOADB
#undef WRITEB
    }
    __syncthreads();
}

namespace fox {
constexpr int D = 128, NW = 8, QBLK = 32, KVBLK = 64, QB = NW * QBLK;
constexpr int SHM_V = KVBLK * D * 2, SHM_K = KVBLK * D * 2;
constexpr int OFF_WS = 2 * SHM_V + 2 * SHM_K, OFF_BIAS = OFF_WS + NW * 64 * 4, OFF_Q = OFF_BIAS + 2 * 64 * 4, LDS_NEED = OFF_Q + NW * 8192;
constexpr float SCALE = 0.08838834764831845f, INV_SCALE = 11.313708498984761f, THR = 8.f;
constexpr int W = SEQ;
#define KSWZ(row, colB) ((row) * 256 + ((colB) ^ (((row) & 7) << 4)))
#define SBAR() __builtin_amdgcn_sched_barrier(0)
__device__ __forceinline__ int v_st(int k, int c) { const int kk = (k & ~0xC) | ((k & 4) << 1) | ((k & 8) >> 1); return ((kk >> 3) * 4 + (c >> 5)) * 512 + ((kk & 7) * 32 + (c & 31)) * 2; }
__device__ __forceinline__ int v_rd_base(int lane) { return ((lane & 3) << 3) | (((lane >> 2) & 3) << 6) | (((lane >> 4) & 1) << 5) | (((lane >> 5) & 1) << 8); }
constexpr int v_rd_off(int d0, int ks, int half) { return d0 * 512 + ks * 4096 + half * 2048; }
__device__ __forceinline__ int crow(int r, int hi) { return (r & 3) + 8 * (r >> 2) + 4 * hi; }
__device__ __forceinline__ void mask_tile(f32x16& p0, f32x16& p1, int dq, unsigned Wm) {
    const float NEG = -__builtin_inff();
#pragma unroll
    for (int r = 0; r < 16; ++r) {
        const int c = (r & 3) + 8 * (r >> 2);
        if ((unsigned)(dq - c) >= Wm) p0[r] = NEG;
        if ((unsigned)(dq - c - 32) >= Wm) p1[r] = NEG;
    }
}
__device__ __forceinline__ void partialSM(f32x16& p0, f32x16& p1, float& m_reg, float& mn, float& alpha) {
    float pmax = p0[0]; for (int r = 1; r < 16; ++r) pmax = fmaxf(pmax, p0[r]); for (int r = 0; r < 16; ++r) pmax = fmaxf(pmax, p1[r]);
    { auto rr = __builtin_amdgcn_permlane32_swap(__float_as_uint(pmax), __float_as_uint(pmax), false, false);
      pmax = fmaxf(__uint_as_float(rr[0]), __uint_as_float(rr[1])); }
    constexpr float C2 = 1.4426950408889634f * SCALE;
    if (__builtin_expect(__all((pmax - m_reg) * SCALE <= THR), 1)) { mn = m_reg; alpha = 1.f; }
    else { mn = fmaxf(m_reg, pmax); alpha = __builtin_amdgcn_exp2f((m_reg - mn) * C2); m_reg = mn; }
    const float mnL = -mn * C2;
    for (int r = 0; r < 16; ++r) p0[r] = fmaf(p0[r], C2, mnL); for (int r = 0; r < 16; ++r) p1[r] = fmaf(p1[r], C2, mnL);
    for (int r = 0; r < 16; ++r) p0[r] = __builtin_amdgcn_exp2f(p0[r]);
}
__device__ __forceinline__ void finishSM(f32x16& p0, f32x16& p1, float alpha, float& l_reg, bf16x8& pa0, bf16x8& pa1, bf16x8& pa2, bf16x8& pa3) {
    for (int r = 0; r < 16; ++r) p1[r] = __builtin_amdgcn_exp2f(p1[r]);
    float ps = 0; for (int r = 0; r < 16; ++r) ps += p0[r]; for (int r = 0; r < 16; ++r) ps += p1[r];
    { auto rr = __builtin_amdgcn_permlane32_swap(__float_as_uint(ps), __float_as_uint(ps), false, false);
      ps = __uint_as_float(rr[0]) + __uint_as_float(rr[1]); }
    l_reg = l_reg * alpha + ps;
#define PK4(P, B_, OUT) do { unsigned a0 = cvtpk(P[B_+0], P[B_+1]), a1 = cvtpk(P[B_+2], P[B_+3]);                          \
        unsigned b0 = cvtpk(P[B_+4], P[B_+5]), b1 = cvtpk(P[B_+6], P[B_+7]);                                             \
        auto r0 = __builtin_amdgcn_permlane32_swap(a0, b0, false, false); auto r1 = __builtin_amdgcn_permlane32_swap(a1, b1, false, false); \
        u32x4 w = {r0[0], r1[0], r0[1], r1[1]}; OUT = *reinterpret_cast<bf16x8*>(&w); } while (0)
    PK4(p0, 0, pa0); PK4(p0, 8, pa1); PK4(p1, 0, pa2); PK4(p1, 8, pa3);
#undef PK4
}
template <int KB>
__device__ __forceinline__ void qkt(f32x16& p0, f32x16& p1, const char* K_lds, const char* bias_lds, int r32, int hi, const char* qf) {
    const char* bb = bias_lds + KB * 256 + hi * 16;
#pragma unroll
    for (int g = 0; g < 4; ++g) { const f32x4 b0 = *reinterpret_cast<const f32x4*>(bb + g * 32), b1 = *reinterpret_cast<const f32x4*>(bb + 128 + g * 32);
        p0[4 * g] = b0[0]; p0[4 * g + 1] = b0[1]; p0[4 * g + 2] = b0[2]; p0[4 * g + 3] = b0[3];
        p1[4 * g] = b1[0]; p1[4 * g + 1] = b1[1]; p1[4 * g + 2] = b1[2]; p1[4 * g + 3] = b1[3]; }
    const char* kb[4];
#pragma unroll
    for (int dd = 0; dd < 4; ++dd) kb[dd] = K_lds + KB * SHM_K + KSWZ(r32, (dd * 16 + hi * 8) * 2);
#pragma unroll
    for (int d0 = 0; d0 < 8; ++d0) { const char* a = kb[d0 & 3] + (d0 >> 2) * 128;
        bf16x8 b0 = *reinterpret_cast<const bf16x8*>(a);
        bf16x8 b1 = *reinterpret_cast<const bf16x8*>(a + 32 * 256);
        const bf16x8 q = *reinterpret_cast<const bf16x8*>(qf + d0 * 1024);
        p0 = __builtin_amdgcn_mfma_f32_32x32x16_bf16(b0, q, p0, 0, 0, 0);
        p1 = __builtin_amdgcn_mfma_f32_32x32x16_bf16(b1, q, p1, 0, 0, 0); }
}
template <int VB>
__device__ __forceinline__ void pv_tile(f32x16* o, int vb0, bf16x8 pa0, bf16x8 pa1, bf16x8 pa2, bf16x8 pa3) {
#define PV_D0(d0) do { constexpr int b_ = VB * SHM_V + v_rd_off(d0, 0, 0); \
        { s16x4 l0, l1, h0, h1; TRRD(l0, vb0, b_); TRRD(h0, vb0, b_ + 2048); TRRD(l1, vb0, b_ + 4096); TRRD(h1, vb0, b_ + 6144); \
        asm volatile("s_waitcnt lgkmcnt(0)" ::: "memory"); SBAR();   \
        o[d0] = __builtin_amdgcn_mfma_f32_32x32x16_bf16(pa0, join8(l0, h0), o[d0], 0, 0, 0);   \
        o[d0] = __builtin_amdgcn_mfma_f32_32x32x16_bf16(pa1, join8(l1, h1), o[d0], 0, 0, 0); }   \
        { s16x4 l2, l3, h2, h3; TRRD(l2, vb0, b_ + 8192); TRRD(h2, vb0, b_ + 10240); TRRD(l3, vb0, b_ + 12288); TRRD(h3, vb0, b_ + 14336); \
        asm volatile("s_waitcnt lgkmcnt(0)" ::: "memory"); SBAR();   \
        o[d0] = __builtin_amdgcn_mfma_f32_32x32x16_bf16(pa2, join8(l2, h2), o[d0], 0, 0, 0);   \
        o[d0] = __builtin_amdgcn_mfma_f32_32x32x16_bf16(pa3, join8(l3, h3), o[d0], 0, 0, 0); } } while (0)
    PV_D0(0); PV_D0(1); PV_D0(2); PV_D0(3);
#undef PV_D0
}
struct BlockRef { int bh, qb, jlo; };
__device__ __forceinline__ const bf16_t* ref_Q(unsigned char* ws, BlockRef r) { return (const bf16_t*)(ws + WS_PROJ) + (size_t)((r.bh >> 3) * SEQ + r.qb * QB) * LDP + FQ + (r.bh & 7) * HD; }
__device__ __forceinline__ const bf16_t* ref_K(unsigned char* ws, BlockRef r) { return (const bf16_t*)(ws + WS_PROJ) + (size_t)((r.bh >> 3) * SEQ) * LDP + FK + (r.bh & 7) * HD; }
__device__ __forceinline__ bf16_t* ref_O(unsigned char* ws, BlockRef r) { return (bf16_t*)(ws + WS_HBUF) + (size_t)((r.bh >> 3) * SEQ + r.qb * QB) * DM + 1024 + (r.bh & 7) * HD; }
__device__ __forceinline__ const float* ref_F(unsigned char* ws, BlockRef r) { return (const float*)(ws + WS_FCUM) + (size_t)r.bh * SEQ; }
struct Seam { bf16x8 qr[8]; bf16x8 st_v0, st_v1, st_k0, st_k1; };
#define ROW(p_, k0, rr) ((p_) + (unsigned)(((k0) + (rr)) * LDP + sc))
#define VMWN(n) asm volatile("s_waitcnt vmcnt(%0)" :: "i"(n) : "memory")
#define LD8(ptr) (*reinterpret_cast<const bf16x8*>(ptr))
#define SLOAD_H(Kp, Vp, Fp, k0, bf) do { const bf16_t* r0_ = ROW(Kp, k0, sr); const bf16_t* r1_ = ROW(Kp, k0, 32 + sr);             \
                         S.st_v0 = LD8(r0_ + (FV - FK)); S.st_v1 = LD8(r1_ + (FV - FK)); S.st_k0 = LD8(r0_); S.st_k1 = LD8(r1_); \
                         if (wid == 0) __builtin_amdgcn_global_load_lds((const unsigned*)((Fp) + (k0) + lane), (LAS unsigned*)(lds_las + OFF_BIAS + (bf) * 256), 4, 0, 0); } while (0)
#define SWRITE_HK(bf) do { *(bf16x8*)(K_lds + (bf) * SHM_K + kws) = S.st_k0; *(bf16x8*)(K_lds + (bf) * SHM_K + kws + 32 * 256) = S.st_k1; } while (0)
#define SWRITE_HV(bf) do { *(bf16x8*)(V_lds + (bf) * SHM_V + vst0) = S.st_v0; *(bf16x8*)(V_lds + (bf) * SHM_V + vst1) = S.st_v1; } while (0)
#define SWRITE_H(bf) do { SWRITE_HV(bf); SWRITE_HK(bf); } while (0)
__device__ __forceinline__ void prime(unsigned char* wsb, const BlockRef cur, char* lds, LAS unsigned char* lds_las, Seam& S, int wv) {
    const int wid = wv, lane = lane_id(), tid = wid * 64 + lane, r32 = lane & 31, hi = lane >> 5;
    const int sr = tid >> 4, sc = (tid & 15) * 8, kws = KSWZ(sr, sc * 2); char* K_lds = lds + 2 * SHM_V; char* bias_lds = lds + OFF_BIAS;
    { const bf16_t* q_ = ref_Q(wsb, cur); for (int d0 = 0; d0 < 8; ++d0) S.qr[d0] = LD8(q_ + (unsigned)((wid * QBLK + r32) * LDP + d0 * 16 + hi * 8)); }
    SLOAD_H(ref_K(wsb, cur), 0, ref_F(wsb, cur), cur.jlo * KVBLK, 0); VM0(); SWRITE_HK(0);
    for (int d0 = 0; d0 < 8; ++d0) *(bf16x8*)(lds + OFF_Q + wid * 8192 + d0 * 1024 + lane * 16) = S.qr[d0];
    __syncthreads();
}
__device__ __forceinline__ void block(unsigned char* wsb, const BlockRef cur, const BlockRef nxt, char* lds, LAS unsigned char* lds_las, Seam& S, int wv) {
    const int wid = wv, lane = lane_id(), tid = wid * 64 + lane, r32 = lane & 31, hi = lane >> 5;
    const int P0 = cur.qb * QB;
    const int j_hi = (P0 + QB - 1) / KVBLK + 1, j_lo = cur.jlo;
    const int NT = j_hi - j_lo;
    const int qlo = P0 + wid * QBLK, qm = qlo + r32 - 4 * hi;
    char* V_lds = lds; char* K_lds = lds + 2 * SHM_V; char* bias_lds = lds + OFF_BIAS; const char* qf = lds + OFF_Q + wid * 8192 + lane * 16;
    float* ws = (float*)(lds + OFF_WS) + wid * 64; float* li_l = ws, * al_l = ws + 32;
    float m_reg = -1e30f, l_reg = 0; f32x16 o[4] = {};
    const int sr = tid >> 4, sc = (tid & 15) * 8, vst0 = v_st(sr, sc), vst1 = v_st(32 + sr, sc), kws = KSWZ(sr, sc * 2);
    const int vb0 = (int)(uintptr_t)V_lds + v_rd_base(lane);
    const bf16_t* Kh = ref_K(wsb, cur); const float* Fh = ref_F(wsb, cur);
#define RESC(a) do { if (__any((a) < 1.f)) { if (hi == 0) al_l[r32] = (a); asm volatile("s_waitcnt lgkmcnt(0)" ::: "memory");              \
                     for (int d_ = 0; d_ < 4; ++d_) for (int r = 0; r < 16; ++r) o[d_][r] *= al_l[crow(r, hi)]; } } while (0)
#define KBASE(t) ((j_lo + (t)) * KVBLK)
#define MASKT(P0_, P1_, t) do { const int kb_ = KBASE(t); if (kb_ + KVBLK - 1 > qlo) mask_tile(P0_, P1_, qm - kb_, (unsigned)W); } while (0)
    constexpr int NQL = 8;
#define SEAM_K0() do { VMWN(NQL); SWRITE_HK(0); SBAR(); } while (0)
    f32x16 pA0, pA1, pB0, pB1; float mnA, mnB, alA, alB; bf16x8 pa0, pa1, pa2, pa3;
    SWRITE_HV(0); SBAR();
    if (NT > 1) { SLOAD_H(Kh, 0, Fh, KBASE(1), 1); }
    SBAR(); qkt<0>(pA0, pA1, K_lds, bias_lds, r32, hi, qf);
    MASKT(pA0, pA1, 0); partialSM(pA0, pA1, m_reg, mnA, alA);
    if (NT > 1) { VM0(); SWRITE_H(1); }
    __syncthreads();
#define HALF_STEP(PX0, PX1, mnX, alX, PY0, PY1, alY, t, KB, VB, SB) do {                                                      \
        SBAR(); qkt<KB>(PX0, PX1, K_lds, bias_lds, r32, hi, qf);                                             \
        finishSM(PY0, PY1, alY, l_reg, pa0, pa1, pa2, pa3); SBAR();                                                           \
        if ((t) + 1 < NT) { SLOAD_H(Kh, 0, Fh, KBASE((t) + 1), SB); SBAR(); }                                               \
        pv_tile<VB>(o, vb0, pa0, pa1, pa2, pa3); MASKT(PX0, PX1, (t)); partialSM(PX0, PX1, m_reg, mnX, alX);                                        \
        __syncthreads();                                                                                                      \
        if ((t) + 1 < NT) { VM0(); SWRITE_H(SB); }                                                                          \
        RESC(alX); __syncthreads(); } while (0)
    for (int t = 1; t + 1 < NT; t += 2) {
        HALF_STEP(pB0, pB1, mnB, alB, pA0, pA1, alA, t, 1, 0, 0);
        HALF_STEP(pA0, pA1, mnA, alA, pB0, pB1, alB, t + 1, 0, 1, 1);
    }
    const bool even = (NT & 1) == 0;
    if (even) { SBAR(); qkt<1>(pB0, pB1, K_lds, bias_lds, r32, hi, qf); SBAR(); }
    SLOAD_H(ref_K(wsb, nxt), 0, ref_F(wsb, nxt), nxt.jlo * KVBLK, 0); SBAR();
    { const bf16_t* q_ = ref_Q(wsb, nxt);
#pragma unroll
    for (int d0 = 0; d0 < 8; ++d0) S.qr[d0] = LD8(q_ + (unsigned)((wid * QBLK + r32) * LDP + d0 * 16 + hi * 8)); }
    SBAR();
    finishSM(pA0, pA1, alA, l_reg, pa0, pa1, pa2, pa3); SBAR();
    pv_tile<0>(o, vb0, pa0, pa1, pa2, pa3);
    if (even) { MASKT(pB0, pB1, NT - 1); partialSM(pB0, pB1, m_reg, mnB, alB); __syncthreads(); RESC(alB);
        finishSM(pB0, pB1, alB, l_reg, pa0, pa1, pa2, pa3); SBAR(); pv_tile<1>(o, vb0, pa0, pa1, pa2, pa3); }
    SBAR(); SEAM_K0();
    if (hi == 0) li_l[r32] = l_reg; asm volatile("s_waitcnt lgkmcnt(0)" ::: "memory");
    float rli[16];
#pragma unroll
    for (int r = 0; r < 16; ++r) rli[r] = __builtin_amdgcn_rcpf(li_l[crow(r, hi)]);
    bf16_t* Ow = ref_O(wsb, cur) + (size_t)(wid * QBLK) * DM;
#pragma unroll
    for (int r = 0; r < 16; ++r) { const int orow = crow(r, hi);
#pragma unroll
        for (int d0 = 0; d0 < 4; ++d0) { const float v = o[d0][r] * rli[r];
            const float vn = __shfl_xor(v, 1);
            if ((r32 & 1) == 0) *(unsigned*)(Ow + (unsigned)(orow * DM + d0 * 32 + r32)) = cvtpk(v, vn); } }
#pragma unroll
    for (int d0 = 0; d0 < 8; ++d0) *(bf16x8*)(lds + OFF_Q + wid * 8192 + d0 * 1024 + lane * 16) = S.qr[d0];
    __syncthreads();
#undef RESC
#undef KBASE
#undef MASKT
#undef SEAM_K0
#undef HALF_STEP
}
#undef ROW
#undef VMWN
#undef SLOAD_H
#undef SWRITE_HK
#undef SWRITE_HV
#undef SWRITE_H
#undef LD8
}

__device__ __forceinline__ int attn_pull(unsigned* qbase, int& qx, int x0, bool& dead) {
    if (dead) return -1;
    for (;;) {
        const int k = (int)__hip_atomic_fetch_add(qbase + 64 * qx, 1u, __ATOMIC_RELAXED, __HIP_MEMORY_SCOPE_AGENT);
        if (k < 128) return qx * 128 + k;
        qx = (qx + 1) & 7; if (qx == x0) { dead = true; return -1; }
    }
}
__device__ __forceinline__ int fox_jlo(const Params& p, int bh, int qb, int lane) {
    const float* Bv = (const float*)(p.ws + WS_FCUM) + (size_t)bh * SEQ;
    const unsigned* mx = (const unsigned*)(p.ws + WS_CTL) + CW_QKMAX + 2 * bh;
    const float q2 = __uint_as_float(__hip_atomic_load(mx, __ATOMIC_RELAXED, __HIP_MEMORY_SCOPE_AGENT)), k2 = __uint_as_float(__hip_atomic_load(mx + 1, __ATOMIC_RELAXED, __HIP_MEMORY_SCOPE_AGENT));
    const float thr = (40.f + 2.f * fox::SCALE * sqrtf(q2 * k2) * 1.01f) * fox::INV_SCALE;
    const float b1 = Bv[64 * lane + 63], b0 = Bv[qb * fox::QB];
    const unsigned long long m = __ballot(b1 < b0 - thr);
    return __builtin_popcountll(m);
}
__device__ __forceinline__ fox::BlockRef attn_ref(const Params& p, int item, int lane) { fox::BlockRef r; const int x = item >> 7, k = item & 127; r.bh = 8 * x + (k & 7); r.qb = 15 - (k >> 3);
    r.jlo = __builtin_amdgcn_readfirstlane(fox_jlo(p, r.bh, r.qb, lane)); return r; }
__device__ __forceinline__ void p4_attention(const Params& p, const Frame& F, char* lds_generic) {
    using namespace fox;
    unsigned* qbase = (unsigned*)(p.ws + WS_CTL) + CW_QUEUE;
    volatile LAS int* qslot = (volatile LAS int*)(F.lds + LDS_MISC + 64);
    const int x0 = (int)(xb_xcc_id() & 7u); int qx = x0; bool dead = false;
    if (F.tid == 0) { qslot[0] = attn_pull(qbase, qx, x0, dead); qslot[1] = attn_pull(qbase, qx, x0, dead); }
    __syncthreads();
    int L = qslot[0], Ln = qslot[1];
    if (L < 0) { __syncthreads(); return; }
    BlockRef cur = attn_ref(p, L, F.lane);
    Seam S;
    prime(p.ws, cur, lds_generic, F.lds, S, F.wave);
    for (int it = 0;; ++it) {
        const bool last = Ln < 0;
        const BlockRef nxt = last ? cur : attn_ref(p, Ln, F.lane);
        if (F.tid == 0) qslot[it & 1] = attn_pull(qbase, qx, x0, dead);
        block(p.ws, cur, nxt, lds_generic, F.lds, S, F.wave);
        if (last) break;
        cur = nxt; L = Ln; Ln = qslot[it & 1];
    }
    __syncthreads();
}

constexpr int L1_G1P = 0, L1_LNG = 8192, L1_LNB = 16384, L1_SC2P = 24576, L1_SH2 = 32768, L1_LG = 40960;
__device__ __forceinline__ void p6_ln1_router(const Params& p, const Frame& F) {
    const float* mod = (const float*)(p.ws + WS_MOD); const bf16_t* y1 = (const bf16_t*)(p.ws + WS_Y1); bf16_t* x1 = (bf16_t*)(p.ws + WS_X1); bf16_t* h2 = (bf16_t*)(p.ws + WS_H2);
    const bf16_t* rw = (const bf16_t*)(p.ws + WS_RTW); unsigned char* h2f8 = p.ws + WS_H2F8;
    unsigned* cnt = (unsigned*)(p.ws + WS_CTL) + CW_CNT;
    int* rt_e = (int*)(p.ws + WS_RT + RT_E); float* rt_w = (float*)(p.ws + WS_RT + RT_W); int* rt_pos = (int*)(p.ws + WS_RT + RT_POS); int* elist = (int*)(p.ws + WS_ELIST);
    LAS float* lg = (LAS float*)(F.lds + L1_LG + F.wave * 4096);
    const int fr = F.lane & 15, fq = F.lane >> 4;
    int bcur = -1;
    for (int g0 = F.bid; g0 < NTOK / 128; g0 += F.G) {
        const int b = (g0 * 128) / SEQ;
        if (b != bcur) { __syncthreads(); bcur = b; const float* mb = mod + (size_t)b * (6 * DM);
            for (unsigned i = (unsigned)F.tid; i < (unsigned)DM; i += 512u) { LAS float* L = (LAS float*)F.lds; const float* m2 = mb + 2 * DM; const float* m3 = mb + 3 * DM; const float* m4 = mb + 4 * DM;
                L[L1_G1P / 4 + i] = 1.f + m2[i]; L[L1_LNG / 4 + i] = p.ln1_g[i]; L[L1_LNB / 4 + i] = p.ln1_b[i]; L[L1_SC2P / 4 + i] = 1.f + m4[i]; L[L1_SH2 / 4 + i] = m3[i]; }
            __syncthreads(); }
        const int row0 = g0 * 128 + F.wave * 16;
#pragma unroll 1
        for (int pr = 0; pr < 8; ++pr) {
            f32x4 xa[2][8]; u32x4 ya[2][4];
#pragma unroll
            for (int r = 0; r < 2; ++r)
#pragma unroll
                for (int i = 0; i < 4; ++i) { const size_t o = (size_t)(row0 + 2 * pr + r) * DM + i * 512 + F.lane * 8;
                    xa[r][2 * i] = __builtin_nontemporal_load((const f32x4*)(p.x + o)); xa[r][2 * i + 1] = __builtin_nontemporal_load((const f32x4*)(p.x + o + 4)); ya[r][i] = *(const u32x4*)(y1 + o); }
#pragma unroll
            for (int r = 0; r < 2; ++r) {
                float v[32]; float s = 0.f;
#pragma unroll
                for (int i = 0; i < 4; ++i) { const int col = i * 512 + F.lane * 8; float yf[8]; unpack8(ya[r][i], yf);
                    const f32x4 ga = *(const LAS f32x4*)(F.lds + L1_G1P + col * 4), gb = *(const LAS f32x4*)(F.lds + L1_G1P + col * 4 + 16);
#pragma unroll
                    for (int e = 0; e < 4; ++e) { v[i * 8 + e] = ALPHA * xa[r][2 * i][e] + ga[e] * yf[e]; v[i * 8 + 4 + e] = ALPHA * xa[r][2 * i + 1][e] + gb[e] * yf[4 + e]; }
#pragma unroll
                    for (int e = 0; e < 8; ++e) s += v[i * 8 + e]; }
                const float mean = wave_sum(s) * (1.f / DM);
                float q = 0.f;
#pragma unroll
                for (int k = 0; k < 32; ++k) { const float d = v[k] - mean; q += d * d; }
                const float rstd = rsqrtf(wave_sum(q) * (1.f / DM) + LN_EPS);
#pragma unroll
                for (int i = 0; i < 4; ++i) { const int col = i * 512 + F.lane * 8; const size_t o = (size_t)(row0 + 2 * pr + r) * DM + col;
                    const f32x4 g0v = *(const LAS f32x4*)(F.lds + L1_LNG + col * 4), g1v = *(const LAS f32x4*)(F.lds + L1_LNG + col * 4 + 16), b0 = *(const LAS f32x4*)(F.lds + L1_LNB + col * 4), b1 = *(const LAS f32x4*)(F.lds + L1_LNB + col * 4 + 16);
                    const f32x4 c0 = *(const LAS f32x4*)(F.lds + L1_SC2P + col * 4), c1 = *(const LAS f32x4*)(F.lds + L1_SC2P + col * 4 + 16), s0 = *(const LAS f32x4*)(F.lds + L1_SH2 + col * 4), s1 = *(const LAS f32x4*)(F.lds + L1_SH2 + col * 4 + 16);
                    f32x4 o0, o1, h0, h1;
#pragma unroll
                    for (int e = 0; e < 4; ++e) { o0[e] = (v[i * 8 + e] - mean) * rstd * g0v[e] + b0[e]; o1[e] = (v[i * 8 + 4 + e] - mean) * rstd * g1v[e] + b1[e];
                        h0[e] = o0[e] * c0[e] + s0[e]; h1[e] = o1[e] * c1[e] + s1[e]; }
                    __builtin_nontemporal_store(pack8(o0, o1), (bf16x8*)(x1 + o));
                    *(bf16x8*)(h2 + o) = pack8(h0, h1); }
                __builtin_amdgcn_sched_barrier(0);
            }
        }
        VM0();
        f32x4 acc[3]; acc[0] = acc[1] = acc[2] = (f32x4){0.f, 0.f, 0.f, 0.f};
        const bf16_t* ar = h2 + (size_t)(row0 + fr) * DM + 8 * fq;
#pragma unroll 2
        for (int s_ = 0; s_ < 64; ++s_) {
            const bf16x8 a = *(const bf16x8*)(ar + 32 * s_);
            { float af[8]; unpack8(*reinterpret_cast<const u32x4*>(&a), af);
              *(u32x2*)(h2f8 + (unsigned)((row0 + fr) * DM + 32 * s_ + 8 * fq)) = (u32x2){pack_fp8x4(af[0], af[1], af[2], af[3]), pack_fp8x4(af[4], af[5], af[6], af[7])}; }
#pragma unroll
            for (int ct = 0; ct < 3; ++ct) { const bf16_t* bp = rw + (size_t)(16 * ct + fr) * DM + 32 * s_ + 8 * fq;
                acc[ct] = mfma16(a, *(const bf16x8*)bp, acc[ct]); acc[ct] = mfma16(a, *(const bf16x8*)(bp + 48 * DM), acc[ct]); }
        }
#pragma unroll
        for (int ct = 0; ct < 3; ++ct)
#pragma unroll
            for (int j = 0; j < 4; ++j) lg[(4 * fq + j) * 48 + 16 * ct + fr] = acc[ct][j];
        asm volatile("s_waitcnt lgkmcnt(0)" ::: "memory");
        if (F.lane < 16) {
            const int t = row0 + F.lane; const LAS float* l = lg + F.lane * 48;
            float gl[4];
#pragma unroll
            for (int g = 0; g < 4; ++g) gl[g] = l[g] + p.b_rg[g];
            float gm = gl[0]; int gi = 0;
#pragma unroll
            for (int g = 1; g < 4; ++g) if (gl[g] > gm) { gm = gl[g]; gi = g; }
            float gs = 0.f;
#pragma unroll
            for (int g = 0; g < 4; ++g) gs += __expf(gl[g] - gm);
            const float gw = 1.f / gs;
            float el[8];
#pragma unroll
            for (int e = 0; e < 8; ++e) el[e] = l[4 + 8 * gi + e] + p.b_re[8 * gi + e];
            float m0 = el[0]; int e0 = 0;
#pragma unroll
            for (int e = 1; e < 8; ++e) if (el[e] > m0) { m0 = el[e]; e0 = e; }
            float m1 = -__builtin_inff(); int e1 = 0;
#pragma unroll
            for (int e = 0; e < 8; ++e) if (e != e0 && el[e] > m1) { m1 = el[e]; e1 = e; }
            const float p1 = __expf(m1 - m0); const float w0 = gw / (1.f + p1), w1 = gw * p1 / (1.f + p1);
            const int x0 = 8 * gi + e0, x1i = 8 * gi + e1;
            const unsigned q0 = atomicAdd(cnt + x0, 1u), q1 = atomicAdd(cnt + x1i, 1u);
            rt_e[2 * t] = x0; rt_e[2 * t + 1] = x1i; rt_w[2 * t] = w0; rt_w[2 * t + 1] = w1; rt_pos[2 * t] = (int)q0; rt_pos[2 * t + 1] = (int)q1;
            elist[(unsigned)x0 * (unsigned)NTOK + q0] = t; elist[(unsigned)x1i * (unsigned)NTOK + q1] = t;
        }
    }
    __syncthreads();
}
__device__ __forceinline__ void slot_prefix(const Params& p, const Frame& F, LAS int* ps) {
    if (F.tid == 0) { const unsigned* cnt = (const unsigned*)(p.ws + WS_CTL) + CW_CNT; int run = 0;
        for (int e = 0; e < NEXP; ++e) { const int c = (int)__hip_atomic_load(cnt + e, __ATOMIC_RELAXED, __HIP_MEMORY_SCOPE_AGENT); ps[e] = run; ps[32 + e] = c; run += (c + 255) / 256 * 256; } ps[64] = run; }
}
constexpr int L2_G2P = 0, L2_LNG = 8192, L2_LNB = 16384, L2_PS = 24576;
__device__ __forceinline__ void p11_final(const Params& p, const Frame& F) {
    const float* mod = (const float*)(p.ws + WS_MOD); const bf16_t* x1 = (const bf16_t*)(p.ws + WS_X1); const unsigned char* yb = p.ws + WS_YB; const int* rt_e = (const int*)(p.ws + WS_RT + RT_E); const int* rt_pos = (const int*)(p.ws + WS_RT + RT_POS); const float* rt_w = (const float*)(p.ws + WS_RT + RT_W);
    LAS int* ps = (LAS int*)(F.lds + L2_PS);
    slot_prefix(p, F, ps);
    int bcur = -1;
    for (int g0 = F.bid; g0 < NTOK / 128; g0 += F.G) {
        const int b = (g0 * 128) / SEQ;
        if (b != bcur) { __syncthreads(); bcur = b; const float* mb = mod + (size_t)b * (6 * DM);
            for (unsigned i = (unsigned)F.tid; i < (unsigned)DM; i += 512u) { LAS float* L = (LAS float*)F.lds; const float* m5 = mb + 5 * DM; L[L2_G2P / 4 + i] = 1.f + m5[i]; L[L2_LNG / 4 + i] = p.ln2_g[i]; L[L2_LNB / 4 + i] = p.ln2_b[i]; }
            __syncthreads(); }
        const int row0 = g0 * 128 + F.wave * 16;
#pragma unroll 1
        for (int pr = 0; pr < 8; ++pr) {
            u32x4 xv[2][4]; u32x2 ya[2][4], yc[2][4]; float wa[2], wc[2];
#pragma unroll
            for (int r = 0; r < 2; ++r) { const int row = row0 + 2 * pr + r; const int sa = ps[rt_e[2 * row]] + rt_pos[2 * row], sb = ps[rt_e[2 * row + 1]] + rt_pos[2 * row + 1]; wa[r] = rt_w[2 * row] * Y8_INV; wc[r] = rt_w[2 * row + 1] * Y8_INV;
#pragma unroll
                for (int i = 0; i < 4; ++i) { const int col = i * 512 + F.lane * 8;
                    xv[r][i] = *(const u32x4*)(x1 + (size_t)row * DM + col); ya[r][i] = *(const u32x2*)(yb + (size_t)sa * DM + col); yc[r][i] = *(const u32x2*)(yb + (size_t)sb * DM + col); } }
#pragma unroll
            for (int r = 0; r < 2; ++r) { const int row = row0 + 2 * pr + r;
                float v[32]; float s = 0.f;
#pragma unroll
                for (int i = 0; i < 4; ++i) { const int col = i * 512 + F.lane * 8; float xf[8], yf[8], zf[8]; unpack8(xv[r][i], xf); unpack8_fp8(ya[r][i], yf); unpack8_fp8(yc[r][i], zf);
                    const f32x4 ga = *(const LAS f32x4*)(F.lds + L2_G2P + col * 4), gb = *(const LAS f32x4*)(F.lds + L2_G2P + col * 4 + 16);
#pragma unroll
                    for (int e = 0; e < 4; ++e) { v[i * 8 + e] = ALPHA * xf[e] + ga[e] * (wa[r] * yf[e] + wc[r] * zf[e]); v[i * 8 + 4 + e] = ALPHA * xf[4 + e] + gb[e] * (wa[r] * yf[4 + e] + wc[r] * zf[4 + e]); }
#pragma unroll
                    for (int e = 0; e < 8; ++e) s += v[i * 8 + e]; }
                const float mean = wave_sum(s) * (1.f / DM);
                float q = 0.f;
#pragma unroll
                for (int k = 0; k < 32; ++k) { const float d = v[k] - mean; q += d * d; }
                const float rstd = rsqrtf(wave_sum(q) * (1.f / DM) + LN_EPS);
#pragma unroll
                for (int i = 0; i < 4; ++i) { const int col = i * 512 + F.lane * 8;
                    const f32x4 g0v = *(const LAS f32x4*)(F.lds + L2_LNG + col * 4), g1v = *(const LAS f32x4*)(F.lds + L2_LNG + col * 4 + 16), b0 = *(const LAS f32x4*)(F.lds + L2_LNB + col * 4), b1 = *(const LAS f32x4*)(F.lds + L2_LNB + col * 4 + 16);
                    f32x4 o0, o1;
#pragma unroll
                    for (int e = 0; e < 4; ++e) { o0[e] = (v[i * 8 + e] - mean) * rstd * g0v[e] + b0[e]; o1[e] = (v[i * 8 + 4 + e] - mean) * rstd * g1v[e] + b1[e]; }
                    __builtin_nontemporal_store(o0, (f32x4*)(p.out + (size_t)row * DM + col)); __builtin_nontemporal_store(o1, (f32x4*)(p.out + (size_t)row * DM + col + 4)); }
                __builtin_amdgcn_sched_barrier(0);
            }
        }
    }
    __syncthreads();
}

typedef const __attribute__((address_space(4))) Params* kparams_t;
__device__ __forceinline__ Params load_params() {
#if defined(__HIP_DEVICE_COMPILE__)
    kparams_t pp = (kparams_t)__builtin_amdgcn_kernarg_segment_ptr(); asm volatile("" : "+s"(pp)); return *pp;
#else
    return Params{};
#endif
}
__device__ __forceinline__ Frame make_frame(unsigned char* lds_raw, int wv) {
    Frame F; F.lds = (LAS unsigned char*)lds_raw; F.lane = lane_id(); F.wave = wv; F.tid = wv * 64 + F.lane; F.G = gridDim.x; F.bid = blockIdx.x; return F;
}
constexpr int MOE_TL = 320, MOE_GI = 448;
template <bool TOK> __device__ __forceinline__ LAS int* moe_tables(const Params& p, const Frame& F, int& ntiles, int ntl) {
    LAS int* tl = (LAS int*)(F.lds + pg8::STAGE_BYTES); LAS int* ps = tl + MOE_TL;
    slot_prefix(p, F, ps);
    __syncthreads();
    ntiles = ps[64] / 256;
    for (int i = F.tid; i < ntiles; i += 512) { int e = 0;
#pragma unroll 1
        for (int x = 1; x < NEXP; ++x) if (ps[x] <= 256 * i) e = x;
        tl[i] = e; }
    __syncthreads();
    if constexpr (TOK) { const int* elist = (const int*)(p.ws + WS_ELIST);
        for (int u = 0; u < 24; ++u) { const int L = u * F.G + F.bid; if (L >= ntiles * ntl) break;
            if (F.tid < 256) { const int t = L / ntl, e = tl[t], pos = 256 * t - ps[e] + F.tid; tl[MOE_GI + u * 256 + F.tid] = pos < ps[32 + e] ? elist[(unsigned)e * (unsigned)NTOK + (unsigned)pos] : 0; } }
        __syncthreads(); }
    return tl;
}
template <unsigned MASK> __global__ void __launch_bounds__(512, 2) fwd(Params p_unused) {
    extern __shared__ __attribute__((aligned(16))) unsigned char lds_raw[];
    volatile LAS unsigned* misc = (volatile LAS unsigned*)((LAS unsigned char*)lds_raw + LDS_MISC);
    const int wv = __builtin_amdgcn_readfirstlane((int)threadIdx.x >> 6);
    __builtin_assume(wv >= 0 && wv < 8);
    if (wv == 0) misc[lane_id()] = 0u;
    __syncthreads();
    int lo, hi; unsigned* barw;
    { const Params p = load_params(); lo = p.ph_lo; hi = p.ph_hi; barw = (unsigned*)(p.ws + WS_CTL); }
    XcdBarrier bar; bar.bar = barw; bar.x = 0; bar.st = misc;
    bar.wv = wv;
    if (hi - lo > 1) bar = xcd_barrier_post(barw, misc, wv);
#define IN(k) (((MASK >> (k)) & 1u) && lo <= (k) && (k) < hi)
#define SEAM(k) do { if (IN(k) && IN((k) + 1)) xcd_barrier(bar); } while (0)
#ifndef PROBE_REP
#define PROBE_REP 0u
#endif
#define PHASE(k, ...) if (IN(k)) __VA_ARGS__ if (((PROBE_REP >> (k)) & 1u) && IN(k)) { xcd_barrier(bar); __VA_ARGS__ } SEAM(k);
    PHASE(0, { const Params p = load_params(); const Frame F = make_frame(lds_raw, wv); p0_prologue(p, F); })
    PHASE(1, { const Params p = load_params(); const Frame F = make_frame(lds_raw, wv); p1_hpass(p, F); })
    PHASE(2, { const Params p = load_params(); const Frame F = make_frame(lds_raw, wv); pg8::Gemm g{(const bf16_t*)(p.ws + WS_HBUF), (const bf16_t*)(p.ws + WS_WIN), NTOK, LDP, DM}; pg8::StaticOrder S; S.init(NTOK, LDP, F.G, F.bid);
        pg8::EpiBf16T<true> E{(bf16_t*)(p.ws + WS_PROJ), LDP}; pg8::gemm_phase<pg8::EpiBf16T<true>, pg8::StaticOrder, false>(F.lds, g, S, E, nullptr, F.wave); })
    PHASE(3, { const Params p = load_params(); const Frame F = make_frame(lds_raw, wv); p3_dnprep(p, F); })
    PHASE(4, { const Params p = load_params(); const Frame F = make_frame(lds_raw, wv); if (F.bid < 64) scan_unit(p, F, F.bid); else if (F.bid < 64 + CVT_WGS) moe_weight_tiles(p, F, F.bid - 64, CVT_WGS);
        p4_attention(p, F, (char*)lds_raw); })
    PHASE(6, { const Params p = load_params(); const Frame F = make_frame(lds_raw, wv); pg8::Gemm g{(const bf16_t*)(p.ws + WS_HBUF), (const bf16_t*)(p.ws + WS_WOUT), NTOK, DM, DM}; pg8::StaticOrder S; S.init(NTOK, DM, F.G, F.bid);
        pg8::EpiBf16 E{(bf16_t*)(p.ws + WS_Y1), DM}; pg8::gemm_phase<pg8::EpiBf16, pg8::StaticOrder, false>(F.lds, g, S, E, nullptr, F.wave); })
    PHASE(7, { const Params p = load_params(); const Frame F = make_frame(lds_raw, wv); p6_ln1_router(p, F); })
    PHASE(10, { const Params p = load_params(); const Frame F = make_frame(lds_raw, wv); int ntiles;
        LAS int* tl = moe_tables<true>(p, F, ntiles, 4);
        pg8::Gemm g{(const bf16_t*)(p.ws + WS_H2F8), (const bf16_t*)((const unsigned char*)p.out + OUT_W1), 0, 0, DM / 2};
        pg8::MoeOrder S{tl, ntiles, 4, F.G, F.bid};
        pg8::EpiSwiglu E{p.ws + WS_HID}; pg8::gemm_phase<pg8::EpiSwiglu, pg8::MoeOrder, true, true>(F.lds, g, S, E, tl + MOE_GI, F.wave); })
    PHASE(11, { const Params p = load_params(); const Frame F = make_frame(lds_raw, wv); int ntiles;
        LAS int* tl = moe_tables<false>(p, F, ntiles, 8);
        pg8::Gemm g{(const bf16_t*)(p.ws + WS_HID), (const bf16_t*)((const unsigned char*)p.out + OUT_W2), 0, 0, DEXP / 2};
        pg8::MoeOrder S{tl, ntiles, 8, F.G, F.bid};
        pg8::EpiY8 E{p.ws + WS_YB}; pg8::gemm_phase<pg8::EpiY8, pg8::MoeOrder, false, true>(F.lds, g, S, E, nullptr, F.wave); })
    PHASE(12, { const Params p = load_params(); const Frame F = make_frame(lds_raw, wv); p11_final(p, F); })
#undef IN
#undef SEAM
#undef PHASE
}

typedef void (*kern_t)(Params);
template <int K> struct PhaseTab { static void fill(kern_t* t) { t[K] = fwd<(1u << K)>; PhaseTab<K - 1>::fill(t); } };
template <> struct PhaseTab<-1> { static void fill(kern_t*) {} };
extern "C" void kernel_launch(void* const* d_in, const int* in_sizes, int n_in, void* d_out, int out_size, void* d_ws, size_t ws_size, hipStream_t stream) {
    static int grid = 0; static kern_t tab[NPHASE + 1];
    if (grid == 0) {
        if (n_in != 22 || out_size != NTOK * DM || ws_size < WS_END) { fprintf(stderr, "kernel_launch: unexpected shapes (n_in %d, out %d, ws %zu)\n", n_in, out_size, ws_size); grid = -1; return; }
        int dev = 0, cus = 0, per_cu = 0;
        if (hipGetDevice(&dev) != hipSuccess || hipDeviceGetAttribute(&cus, hipDeviceAttributeMultiprocessorCount, dev) != hipSuccess) { grid = -1; return; }
#if MK_ONE_LAUNCH
        tab[NPHASE] = fwd<0xffffu>;
        const int k0 = NPHASE, k1 = NPHASE + 1;
#else
        PhaseTab<NPHASE - 1>::fill(tab);
        const int k0 = 0, k1 = NPHASE;
#endif
        for (int k = k0; k < k1; ++k) {
            if (hipFuncSetAttribute((const void*)tab[k], hipFuncAttributeMaxDynamicSharedMemorySize, LDS_BYTES) != hipSuccess) { fprintf(stderr, "kernel_launch: hipFuncSetAttribute failed\n"); grid = -1; return; }
            if (hipOccupancyMaxActiveBlocksPerMultiprocessor(&per_cu, (const void*)tab[k], 512, LDS_BYTES) != hipSuccess || per_cu < 1) { fprintf(stderr, "kernel_launch: occupancy query says %d\n", per_cu); (void)hipGetLastError(); }
        }
        grid = cus;
        if (grid < 128) { fprintf(stderr, "kernel_launch: built for a 256-CU device (got %d CUs)\n", cus); grid = -1; return; }
    }
    if (grid < 0) return;
    (void)hipMemsetAsync((char*)d_ws + WS_CTL, 0, CTL_BYTES, stream);
    Params p{};
    p.x = (const float*)d_in[0]; p.c = (const float*)d_in[1]; p.w_ada = (const float*)d_in[2]; p.b_ada = (const float*)d_in[3]; p.w_in = (const float*)d_in[4]; p.conv_w = (const float*)d_in[5];
    p.a_log = (const float*)d_in[6]; p.dt_bias = (const float*)d_in[7]; p.norm_w = (const float*)d_in[8]; p.f_bias = (const float*)d_in[9]; p.w_out = (const float*)d_in[10];
    p.ln1_g = (const float*)d_in[11]; p.ln1_b = (const float*)d_in[12]; p.w_rg = (const float*)d_in[13]; p.b_rg = (const float*)d_in[14]; p.w_re = (const float*)d_in[15]; p.b_re = (const float*)d_in[16];
    p.w_gate = (const float*)d_in[17]; p.w_up = (const float*)d_in[18]; p.w_down = (const float*)d_in[19]; p.ln2_g = (const float*)d_in[20]; p.ln2_b = (const float*)d_in[21];
    p.out = (float*)d_out; p.ws = (unsigned char*)d_ws;
#if MK_ONE_LAUNCH
    p.ph_lo = 0; p.ph_hi = NPHASE;
    hipLaunchKernelGGL(tab[NPHASE], dim3(grid), dim3(512), LDS_BYTES, stream, p);
#else
    for (int k = 0; k < NPHASE; ++k) { p.ph_lo = k; p.ph_hi = k + 1; hipLaunchKernelGGL(tab[k], dim3(grid), dim3(512), LDS_BYTES, stream, p); }
#endif
}
```

```cpp
#include <hip/hip_runtime.h>
#include <cstdio>
#include <cstdint>

#ifndef MK_ONE_LAUNCH
#define MK_ONE_LAUNCH 1
#endif

#define LAS __attribute__((address_space(3)))
typedef unsigned short bf16_t;
typedef short bf16x8 __attribute__((ext_vector_type(8)));
typedef short s16x4 __attribute__((ext_vector_type(4)));
typedef float f32x4 __attribute__((ext_vector_type(4)));
typedef float f32x2 __attribute__((ext_vector_type(2)));
typedef float f32x16 __attribute__((ext_vector_type(16)));
typedef unsigned u32x4 __attribute__((ext_vector_type(4)));
typedef unsigned u32x2 __attribute__((ext_vector_type(2)));

constexpr int NB = 8, SEQ = 4096, DM = 2048, NTOK = NB * SEQ;
constexpr int NH = 8, HD = 128;
constexpr int LDP = 7168;
constexpr int PQ = 0, PK = 1024, PV = 2048, PZ = 3072, FQ = 4096, FK = 5120, FV = 6144;
constexpr int WIN_LD = 7192;
constexpr int NEXP = 32, DEXP = 512, PMAX = 2 * NTOK + NEXP * 256;
constexpr float LN_EPS = 1e-5f, NORM_EPS = 1e-6f;
constexpr float ALPHA = 1.189207115002721f;
constexpr float QSCALE = 0.08838834764831845f;
constexpr int NPHASE = 13;

constexpr size_t WS_CTL   = 0;
constexpr size_t CTL_BYTES = 65536;
constexpr int CW_CNT = 4096, CW_QUEUE = 5120, CW_NTILES = 6144, CW_TILE_E = 7168, CW_QKMAX = 8192;
constexpr size_t WS_MOD   = 65536;
constexpr size_t WS_SMALLW= WS_MOD + 393216;
constexpr size_t WS_RTW   = WS_SMALLW + 131072;
constexpr size_t WS_WOUT  = WS_RTW + 393216;
constexpr size_t WS_WIN   = WS_WOUT + 8388608;
constexpr size_t WS_SM    = WS_WIN + 29360128;
constexpr size_t WS_FCUM  = WS_SM + 4194304;
constexpr size_t WS_HBUF  = WS_FCUM + 1048576;
constexpr size_t WS_PROJ  = WS_HBUF + 134217728;
constexpr size_t WS_DN    = WS_PROJ + 469762048;
constexpr int DN_W = 0, DN_KT = 17408, DN_Q = 35840, DN_QK = 53248, DN_UT = 62464, DN_MISC = 78848, DN_CHUNK = 79104;
constexpr size_t WS_RT    = WS_DN + (size_t)4096 * DN_CHUNK;
constexpr size_t RT_E = 0, RT_W = 262144, RT_POS = 524288, RT_SLOT = 786432, RT_TOK = 1048576, RT_WB = 1048576 + 294912;
constexpr size_t WS_ELIST = WS_RT + 1048576 + 2 * 294912;
constexpr size_t WS_END   = WS_ELIST + (size_t)NEXP * NTOK * 4;
constexpr size_t WS_H2    = WS_PROJ;
constexpr size_t WS_X1    = WS_H2 + 134217728;
constexpr size_t WS_H2F8  = WS_X1 + 134217728;
constexpr size_t WS_HID   = WS_X1 + 268435456;
constexpr size_t WS_YB    = WS_HID + (size_t)PMAX * 512 * 2;
constexpr size_t WS_Y1    = WS_YB;
static_assert(WS_YB + (size_t)PMAX * 2048 * 2 <= WS_RT, "overlay");
static_assert(WS_END <= (size_t)1 << 30, "workspace");
constexpr size_t OUT_W1 = 0;
constexpr size_t OUT_W2 = 134217728;
constexpr float Y8_SCALE = 16.f, Y8_INV = 1.f / 16.f;
constexpr float W2_SCALE = 32.f, HID_SCALE = 8.f, Y2_INV = 1.f / (32.f * 8.f), W1_SCALE = 32.f, W1_INV = 1.f / 32.f;

constexpr int LDS_BYTES = 160 * 1024 - 512;
constexpr int LDS_MISC = LDS_BYTES - 256;

struct Params {
    const float* x; const float* c; const float* w_ada; const float* b_ada; const float* w_in; const float* conv_w; const float* a_log; const float* dt_bias;
    const float* norm_w; const float* f_bias; const float* w_out; const float* ln1_g; const float* ln1_b; const float* w_rg; const float* b_rg; const float* w_re;
    const float* b_re; const float* w_gate; const float* w_up; const float* w_down; const float* ln2_g; const float* ln2_b;
    float* out; unsigned char* ws; int ph_lo, ph_hi;
};

typedef __bf16 bf16v2 __attribute__((ext_vector_type(2)));
__device__ __forceinline__ unsigned cvtpk(float lo, float hi) { bf16v2 v; v[0] = (__bf16)lo; v[1] = (__bf16)hi; return __builtin_bit_cast(unsigned, v); }
__device__ __forceinline__ float bflo(unsigned w) { return __uint_as_float(w << 16); }
__device__ __forceinline__ float bfhi(unsigned w) { return __uint_as_float(w & 0xffff0000u); }
__device__ __forceinline__ float bf1(bf16_t h) { return __uint_as_float(((unsigned)h) << 16); }
__device__ __forceinline__ bf16_t f2bf(float f) { return (bf16_t)(cvtpk(f, 0.f) & 0xffffu); }
__device__ __forceinline__ float silu_f(float x) { return x * __builtin_amdgcn_rcpf(1.f + __expf(-x)); }
__device__ __forceinline__ f32x4 mfma16(bf16x8 a, bf16x8 b, f32x4 c) { return __builtin_amdgcn_mfma_f32_16x16x32_bf16(a, b, c, 0, 0, 0); }
__device__ __forceinline__ u32x2 pack4(f32x4 v) { u32x2 r; r.x = cvtpk(v[0], v[1]); r.y = cvtpk(v[2], v[3]); return r; }
__device__ __forceinline__ bf16x8 pack8(f32x4 a, f32x4 b) { u32x4 w = {cvtpk(a[0], a[1]), cvtpk(a[2], a[3]), cvtpk(b[0], b[1]), cvtpk(b[2], b[3])}; return *reinterpret_cast<bf16x8*>(&w); }
__device__ __forceinline__ void unpack8(u32x4 w, float* f) { f[0] = bflo(w.x); f[1] = bfhi(w.x); f[2] = bflo(w.y); f[3] = bfhi(w.y); f[4] = bflo(w.z); f[5] = bfhi(w.z); f[6] = bflo(w.w); f[7] = bfhi(w.w); }
typedef int i32x8 __attribute__((ext_vector_type(8)));
typedef int i32x4 __attribute__((ext_vector_type(4)));
typedef float f32x2_t __attribute__((ext_vector_type(2)));
__device__ __forceinline__ void unpack8_fp8(u32x2 w, float* f) { const f32x2_t a = __builtin_amdgcn_cvt_pk_f32_fp8((int)w.x, false), b = __builtin_amdgcn_cvt_pk_f32_fp8((int)w.x, true), c = __builtin_amdgcn_cvt_pk_f32_fp8((int)w.y, false), d = __builtin_amdgcn_cvt_pk_f32_fp8((int)w.y, true);
    f[0] = a[0]; f[1] = a[1]; f[2] = b[0]; f[3] = b[1]; f[4] = c[0]; f[5] = c[1]; f[6] = d[0]; f[7] = d[1]; }
__device__ __forceinline__ unsigned pack_fp8x4(float a, float b, float c, float d) { int w = __builtin_amdgcn_cvt_pk_fp8_f32(a, b, 0, false); w = __builtin_amdgcn_cvt_pk_fp8_f32(c, d, w, true); return (unsigned)w; }
__device__ __forceinline__ float wave_sum(float v) {
#pragma unroll
    for (int o = 32; o >= 1; o >>= 1) v += __shfl_xor(v, o);
    return v;
}
#define TRRD(dst, addr, off) asm volatile("ds_read_b64_tr_b16 %0, %1 offset:%2" : "=&v"(dst) : "v"(addr), "i"(off) : "memory")
#define LGKM0() do { asm volatile("s_waitcnt lgkmcnt(0)" ::: "memory"); __builtin_amdgcn_sched_barrier(0); } while (0)
#define VM0() asm volatile("s_waitcnt vmcnt(0)" ::: "memory")
#define LBAR() do { asm volatile("s_waitcnt lgkmcnt(0)" ::: "memory"); __builtin_amdgcn_s_barrier(); asm volatile("" ::: "memory"); } while (0)
__device__ __forceinline__ bf16x8 join8(s16x4 l, s16x4 h) { return (bf16x8){l[0], l[1], l[2], l[3], h[0], h[1], h[2], h[3]}; }

__device__ __forceinline__ int lane_id() { int l; asm volatile("v_mbcnt_lo_u32_b32 %0, -1, 0\n\tv_mbcnt_hi_u32_b32 %0, -1, %0" : "=v"(l)); __builtin_assume(l >= 0 && l < 64); return l; }
#define TID(wv) ((wv) * 64 + lane_id())
#define XB_TMO      128
#define XB_XCNT(j)  (256  + 64 * (j))
#define XB_XSUB(j)  (1280 + 64 * (j))
#define XB_XGEN(j)  (2304 + 64 * (j))
#define XB_TOP      3328
#define XB_TOPGEN   3392
#define XCD_BAR_WORDS 3456
#define XB_SPIN_CAP (1u << 18)
__device__ __forceinline__ unsigned xb_ld(unsigned* p)              { return __hip_atomic_load(p, __ATOMIC_RELAXED, __HIP_MEMORY_SCOPE_AGENT); }
__device__ __forceinline__ unsigned xb_add(unsigned* p, unsigned v) { return __hip_atomic_fetch_add(p, v, __ATOMIC_RELAXED, __HIP_MEMORY_SCOPE_AGENT); }
__device__ __forceinline__ unsigned xb_xcc_id() { return (unsigned)__builtin_amdgcn_s_getreg((3 << 11) | 20) & 0xFu; }
#define XB_SPIN(cond, bar) do { unsigned _sp = 0; while (cond) { __builtin_amdgcn_s_sleep(1); \
    if ((++_sp & 255u) == 0u) { if (xb_ld(&(bar)[XB_TMO])) break; if (_sp > XB_SPIN_CAP) { atomicAdd(&(bar)[XB_TMO], 1u); break; } } } } while (0)
struct XcdBarrier { unsigned* bar; unsigned x; volatile LAS unsigned* st; int wv; };
__device__ __forceinline__ XcdBarrier xcd_barrier_post(unsigned* bar, volatile LAS unsigned* st, int wv) {
    XcdBarrier b; b.bar = bar; b.x = xb_xcc_id(); b.st = st; b.wv = wv;
    if (TID(wv) == 0) (void)xb_add(&bar[XB_XCNT(b.x)], 1u);
    return b;
}
__device__ __forceinline__ void xcd_barrier_complete(unsigned* bar, unsigned x, unsigned& nloc, unsigned& nx) {
    const unsigned G = gridDim.x * gridDim.y * gridDim.z;
    unsigned sum, cnt, mine, sp = 0u;
    for (;;) {
        sum = 0u; cnt = 0u; mine = 0u;
#pragma unroll
        for (unsigned j = 0; j < 16; ++j) { const unsigned c = xb_ld(&bar[XB_XCNT(j)]); sum += c; cnt += (c > 0u) ? 1u : 0u; mine = (j == x) ? c : mine; }
        if (sum == G) break;
        __builtin_amdgcn_s_sleep(1);
        if ((++sp & 255u) == 0u) { if (xb_ld(&bar[XB_TMO])) break; if (sp > XB_SPIN_CAP) { atomicAdd(&bar[XB_TMO], 1u); break; } }
    }
    nloc = mine > 0u ? mine : 1u; nx = cnt > 0u ? cnt : 1u;
}
__device__ __forceinline__ void xcd_barrier(const XcdBarrier& b) {
    asm volatile("s_waitcnt vmcnt(0)" ::: "memory");
    __syncthreads();
    if (TID(b.wv) == 0) {
        unsigned* bar = b.bar;
        __builtin_amdgcn_s_waitcnt(0);
        unsigned nloc = b.st[0], nx = b.st[1];
        if (nloc == 0u) { xcd_barrier_complete(bar, b.x, nloc, nx); b.st[0] = nloc; b.st[1] = nx; }
        const unsigned old = xb_add(&bar[XB_XSUB(b.x)], 1u);
        const unsigned gen = old / nloc;
        if (old + 1u == (gen + 1u) * nloc) {
            __builtin_amdgcn_fence(__ATOMIC_RELEASE, "agent");
            asm volatile("s_waitcnt vmcnt(0)" ::: "memory");
            const unsigned og = xb_add(&bar[XB_TOP], 1u);
            const unsigned tg = og / nx;
            if (og + 1u == (tg + 1u) * nx) xb_add(&bar[XB_TOPGEN], 1u);
            else XB_SPIN(xb_ld(&bar[XB_TOPGEN]) == tg, bar);
            __builtin_amdgcn_fence(__ATOMIC_ACQUIRE, "agent");
            xb_add(&bar[XB_XGEN(b.x)], 1u);
            asm volatile("s_waitcnt vmcnt(0)" ::: "memory");
        } else {
            XB_SPIN(xb_ld(&bar[XB_XGEN(b.x)]) == gen, bar);
            __builtin_amdgcn_fence(__ATOMIC_ACQUIRE, "agent");
            asm volatile("s_waitcnt vmcnt(0)" ::: "memory");
        }
    }
    __syncthreads();
}

namespace pg8 {
constexpr int BM = 256, BK = 64, HALF = 128, HTB = HALF * BK * 2, STAGE_BYTES = 8 * HTB, NXCD = 8, WGM = 8;
__host__ __device__ __forceinline__ int lds_byte(int r, int c) { const int st = (r >> 4) * 2 + (c >> 5), rr = r & 15, cc = c & 31, ob = rr * 64 + cc * 2; return st * 1024 + (ob ^ (((ob >> 9) & 1) << 5)); }
__host__ __device__ __forceinline__ void stage_rc(int b, int& R, int& C) { const int st = b / 1024, sb = b % 1024, swz = sb ^ (((sb >> 9) & 1) << 5); R = (st >> 1) * 16 + swz / 64; C = (st & 1) * 32 + (swz % 64) / 2; }
__host__ __device__ __forceinline__ int perm32(int rho) { const int n = rho >> 4, i = rho & 15; return 8 * (i >> 2) + 4 * n + (i & 3); }
struct Unit { int pm, pn; };
struct Gemm { const bf16_t* A; const bf16_t* Bt; int M, N, K; };
struct StaticOrder {
    int nM, nN, nwg, G, c;
    __device__ void init(int M, int N, int G_, int c_) { nM = M / BM; nN = N / BM; nwg = nM * nN; G = G_; c = c_; }
    __device__ bool next(int i, Unit& u) const {
        const long L = (long)i * G + c; if (L >= nwg) return false;
        int wgid = (int)L; { const int q = nwg / NXCD, r = nwg % NXCD, xcd = wgid % NXCD, off = wgid / NXCD; wgid = (xcd < r ? xcd * (q + 1) : r * (q + 1) + (xcd - r) * q) + off; }
        const int nig = WGM * nN, gid = wgid / nig, fm = gid * WGM, gsz = (nM - fm) < WGM ? (nM - fm) : WGM;
        u.pm = fm + ((wgid % nig) % gsz); u.pn = (wgid % nig) / gsz; return true;
    }
};
struct MoeOrder {
    const LAS int* tile_e; int ntiles, ntl, G, c;
    __device__ bool next(int i, Unit& u) const {
        const long L = (long)i * G + c; if (L >= (long)ntiles * ntl) return false;
        const int t = (int)(L / ntl), j = (int)(L % ntl); u.pm = t; u.pn = tile_e[t] * ntl + j; return true;
    }
};
template <bool NT> struct EpiBf16T {
    static constexpr bool PERM = true; static constexpr int NST = 16;
    bf16_t* O; int ldc;
    __device__ __forceinline__ void operator()(const f32x4 (&acc)[2][2][4][2], const Unit& u, int wr, int wc, int fr, int fq) const {
        const int row0 = u.pm * BM + wr * 64 + fr, col0 = u.pn * BM + wc * 32 + 8 * fq;
#pragma unroll
        for (int ai = 0; ai < 2; ++ai)
#pragma unroll
            for (int m = 0; m < 4; ++m) { bf16_t* rowp = O + (size_t)(row0 + ai * HALF + m * 16) * ldc + col0;
#pragma unroll
                for (int bj = 0; bj < 2; ++bj) { const f32x4 v0 = acc[ai][bj][m][0], v1 = acc[ai][bj][m][1];
                    u32x4 w; w.x = cvtpk(v0[0], v0[1]); w.y = cvtpk(v0[2], v0[3]); w.z = cvtpk(v1[0], v1[1]); w.w = cvtpk(v1[2], v1[3]);
                    if constexpr (NT) __builtin_nontemporal_store(w, (u32x4*)(rowp + bj * HALF)); else *(u32x4*)(rowp + bj * HALF) = w; } }
    }
};
typedef EpiBf16T<false> EpiBf16;
struct EpiSwiglu {
    static constexpr bool PERM = true; static constexpr int NST = 8;
    unsigned char* O;
    __device__ __forceinline__ void operator()(const f32x4 (&acc)[2][2][4][2], const Unit& u, int wr, int wc, int fr, int fq) const {
        const int row0 = u.pm * BM + wr * 64 + fr, col0 = (u.pn & 3) * 128 + wc * 32 + 8 * fq;
#pragma unroll
        for (int ai = 0; ai < 2; ++ai)
#pragma unroll
            for (int m = 0; m < 4; ++m) { unsigned char* rowp = O + (size_t)(row0 + ai * HALF + m * 16) * DEXP + col0;
                float h[8];
#pragma unroll
                for (int n = 0; n < 2; ++n)
#pragma unroll
                    for (int j = 0; j < 4; ++j) { const float g = acc[ai][0][m][n][j] * W1_INV, up = acc[ai][1][m][n][j] * (W1_INV * HID_SCALE); h[n * 4 + j] = g * __builtin_amdgcn_rcpf(1.f + __expf(-g)) * up; }
                *(u32x2*)rowp = (u32x2){pack_fp8x4(h[0], h[1], h[2], h[3]), pack_fp8x4(h[4], h[5], h[6], h[7])}; }
    }
};
struct EpiY8 {
    static constexpr bool PERM = true, BJ8 = true; static constexpr int NST = 8;
    unsigned char* O;
    __device__ __forceinline__ void operator()(const f32x4 (&acc)[2][2][4][2], const Unit& u, int wr, int wc, int fr, int fq) const {
        const int row0 = u.pm * BM + wr * 64 + fr, col0 = (u.pn & 7) * BM + wc * 64 + 16 * fq;
#pragma unroll
        for (int ai = 0; ai < 2; ++ai)
#pragma unroll
            for (int m = 0; m < 4; ++m) { unsigned char* rowp = O + (size_t)(row0 + ai * HALF + m * 16) * DM + col0;
                u32x4 w;
#pragma unroll
                for (int bj = 0; bj < 2; ++bj)
#pragma unroll
                    for (int n = 0; n < 2; ++n) { f32x4 v = acc[ai][bj][m][n] * (Y2_INV * Y8_SCALE);
#pragma unroll
                        for (int e = 0; e < 4; ++e) v[e] = __builtin_amdgcn_fmed3f(v[e], -448.f, 448.f);
                        w[bj * 2 + n] = pack_fp8x4(v[0], v[1], v[2], v[3]); }
                *(u32x4*)rowp = w; }
    }
};

template <class E, class = void> struct EpiBj8 { static constexpr bool value = false; };
template <class E> struct EpiBj8<E, decltype((void)E::BJ8)> { static constexpr bool value = E::BJ8; };
template <class Epi, class Sched, bool GATHER, bool FP8 = false>
__device__ __forceinline__ void gemm_phase(LAS unsigned char* lds, const Gemm g, const Sched& S, const Epi& E, const LAS int* gidx, int wv) {
    const int wid = wv, lane = lane_id(), tid = wid * 64 + lane, wr = wid >> 2, wc = wid & 3, fr = lane & 15, fq = lane >> 4;
    const int K = g.K, nt = K / BK;
    unsigned voffA[2], voffB[2]; int RA[2], CA[2];
#pragma unroll
    for (int i = 0; i < 2; ++i) { int R, C; stage_rc(tid * 16 + i * 8192, R, C); const int Rb = EpiBj8<Epi>::value ? (64 * (R >> 5) + 16 * ((R & 15) >> 2) + 4 * ((R >> 4) & 1) + (R & 3)) : Epi::PERM ? ((R & ~31) + perm32(R & 31)) : R;
        voffA[i] = (unsigned)(R * K + C) * 2u; voffB[i] = (unsigned)(Rb * K + C) * 2u; RA[i] = R; CA[i] = C; }
    const size_t kstep = (size_t)(BK * 2);
    const size_t hstep = (size_t)HALF * K * 2;
    const size_t tstep = 2 * hstep;
    const size_t bstep = EpiBj8<Epi>::value ? (size_t)8 * K * 2 : hstep;
    const unsigned ldsw = (unsigned)wid * 1024u;
    const int aoff = lds_byte(wr * 64 + fr, fq * 8), boff = lds_byte(wc * 32 + fr, fq * 8);
    const int c8 = 32 * (fq >> 1) + 16 * (fq & 1);
    const int aoff8[2] = {lds_byte(wr * 64 + fr, c8), lds_byte(wr * 64 + fr, c8 + 8)}, boff8[2] = {lds_byte(wc * 32 + fr, c8), lds_byte(wc * 32 + fr, c8 + 8)};
#define PG8_SA(b, h) (((b) * 2 + (h)) * HTB)
#define PG8_SB(b, h) ((4 + (b) * 2 + (h)) * HTB)
#define PG8_STAGE(bufoff, gbase, voff) do { _Pragma("unroll") for (int _i = 0; _i < 2; ++_i) \
        __builtin_amdgcn_global_load_lds((const unsigned*)((const char*)(gbase) + (voff)[_i]), (LAS unsigned*)(lds + (bufoff) + ldsw + _i * 8192), 16, 0, 0); } while (0)
#define PG8_STAGE_A(bufoff, kbase, ubase, h, gv) do { if constexpr (GATHER) { PG8_STAGE(bufoff, kbase, gv[h]); } else { PG8_STAGE(bufoff, (ubase) + (h) * hstep, voffA); } } while (0)
#define PG8_LDA(dst, b, h) do { if constexpr (FP8) { _Pragma("unroll") for (int m = 0; m < 4; ++m) { const i32x4 lo_ = *(const LAS i32x4*)(lds + PG8_SA(b, h) + aoff8[0] + m * 2048), hi_ = *(const LAS i32x4*)(lds + PG8_SA(b, h) + aoff8[1] + m * 2048); dst##8[m] = __builtin_shufflevector(lo_, hi_, 0, 1, 2, 3, 4, 5, 6, 7); } } \
        else { _Pragma("unroll") for (int m = 0; m < 4; ++m) _Pragma("unroll") for (int k = 0; k < 2; ++k) dst[m][k] = *(const LAS bf16x8*)(lds + PG8_SA(b, h) + aoff + m * 2048 + k * 1024); } } while (0)
#define PG8_LDB(dst, b, h) do { if constexpr (FP8) { _Pragma("unroll") for (int n = 0; n < 2; ++n) { const i32x4 lo_ = *(const LAS i32x4*)(lds + PG8_SB(b, h) + boff8[0] + n * 2048), hi_ = *(const LAS i32x4*)(lds + PG8_SB(b, h) + boff8[1] + n * 2048); dst##8[n] = __builtin_shufflevector(lo_, hi_, 0, 1, 2, 3, 4, 5, 6, 7); } } \
        else { _Pragma("unroll") for (int n = 0; n < 2; ++n) _Pragma("unroll") for (int k = 0; k < 2; ++k) dst[n][k] = *(const LAS bf16x8*)(lds + PG8_SB(b, h) + boff + n * 2048 + k * 1024); } } while (0)
#define PG8_MMA(ai, bj, At, Bt) do { __builtin_amdgcn_s_setprio(1); \
        if constexpr (FP8) { _Pragma("unroll") for (int m = 0; m < 4; ++m) _Pragma("unroll") for (int n = 0; n < 2; ++n) \
            asm volatile("s_nop 1\n\tv_mfma_f32_16x16x128_f8f6f4 %0, %1, %2, %0" : "+v"(acc[ai][bj][m][n]) : "v"(Bt##8[n]), "v"(At##8[m])); }     \
        else { _Pragma("unroll") for (int m = 0; m < 4; ++m) _Pragma("unroll") for (int n = 0; n < 2; ++n) _Pragma("unroll") for (int k = 0; k < 2; ++k) \
            acc[ai][bj][m][n] = __builtin_amdgcn_mfma_f32_16x16x32_bf16(Bt[n][k], At[m][k], acc[ai][bj][m][n], 0, 0, 0); } \
        __builtin_amdgcn_s_setprio(0); } while (0)
#define PG8_WAIT_V(n) asm volatile("s_waitcnt vmcnt(" #n ")" ::: "memory")
#define PG8_WAIT_L(n) asm volatile("s_waitcnt lgkmcnt(" #n ")" ::: "memory")
#define PG8_BAR __builtin_amdgcn_s_barrier()
#define PG8_SCHED __builtin_amdgcn_sched_barrier(0)
    Unit cur, nxt; int ui = 0;
    if (!S.next(0, cur)) return;
    f32x4 acc[2][2][4][2];
#pragma unroll
    for (int a = 0; a < 2; ++a)
#pragma unroll
        for (int b = 0; b < 2; ++b)
#pragma unroll
            for (int m = 0; m < 4; ++m)
#pragma unroll
                for (int n = 0; n < 2; ++n) acc[a][b][m][n] = (f32x4){0.f, 0.f, 0.f, 0.f};
    bf16x8 At[4][2], B0[2][2], B1[2][2]; i32x8 At8[4], B08[2], B18[2];
    unsigned gc[2][2], gn[2][2];
#define PG8_GLOAD(dst, pm_) do { _Pragma("unroll") for (int h_ = 0; h_ < 2; ++h_) _Pragma("unroll") for (int i_ = 0; i_ < 2; ++i_) \
        dst[h_][i_] = ((unsigned)gidx[(pm_) * BM + h_ * HALF + RA[i_]] * (unsigned)K + (unsigned)CA[i_]) * 2u; } while (0)
    if constexpr (GATHER) { PG8_GLOAD(gc, 0); } else { gc[0][0] = gc[0][1] = gc[1][0] = gc[1][1] = 0u; }
    gn[0][0] = gc[0][0]; gn[0][1] = gc[0][1]; gn[1][0] = gc[1][0]; gn[1][1] = gc[1][1];
    const char* cA = (const char*)g.A + (GATHER ? (size_t)0 : (size_t)cur.pm * tstep); const char* cB = (const char*)g.Bt + (size_t)cur.pn * tstep;
    PG8_STAGE(PG8_SB(0, 0), cB, voffB); PG8_STAGE_A(PG8_SA(0, 0), cA, cA, 0, gc); PG8_STAGE(PG8_SB(0, 1), cB + bstep, voffB); PG8_STAGE_A(PG8_SA(0, 1), cA, cA, 1, gc);
    if (wr == 1) PG8_BAR;
    PG8_WAIT_V(4); PG8_BAR;
    PG8_STAGE(PG8_SB(1, 0), cB + kstep, voffB); PG8_STAGE_A(PG8_SA(1, 0), cA + kstep, cA + kstep, 0, gc); PG8_STAGE(PG8_SB(1, 1), cB + bstep + kstep, voffB);
    PG8_WAIT_V(6); PG8_BAR;
    PG8_STAGE_A(PG8_SA(1, 1), cA + kstep, cA + kstep, 1, gc);
    for (;;) {
        const bool has_next = S.next(ui + 1, nxt);
        const char* nA = has_next ? (const char*)g.A + (GATHER ? (size_t)0 : (size_t)nxt.pm * tstep) : cA; const char* nB = has_next ? (const char*)g.Bt + (size_t)nxt.pn * tstep : cB;
        if constexpr (GATHER) { if (has_next) { PG8_GLOAD(gn, ui + 1); } }
        for (int t = 0; t < nt; t += 2) {
            const bool last = (t == nt - 2);
            const char* a1 = cA + (size_t)(t + 1) * kstep;
            const char* a2 = last ? nA : cA + (size_t)(t + 2) * kstep; const char* b2 = last ? nB : cB + (size_t)(t + 2) * kstep;
            const char* a3 = a2 + kstep; const char* b3 = b2 + kstep;
            unsigned g2[2][2];
            if constexpr (GATHER) {
#pragma unroll
                for (int h_ = 0; h_ < 2; ++h_)
#pragma unroll
                    for (int i_ = 0; i_ < 2; ++i_) g2[h_][i_] = last ? gn[h_][i_] : gc[h_][i_];
            }
            PG8_LDB(B0, 0, 0); PG8_SCHED; PG8_LDA(At, 0, 0);
            PG8_WAIT_L(8); PG8_BAR; PG8_WAIT_L(0); PG8_MMA(0, 0, At, B0); PG8_BAR; PG8_SCHED;
            PG8_LDB(B1, 0, 1); PG8_STAGE(PG8_SB(0, 0), b2, voffB);
            PG8_BAR; PG8_WAIT_L(0); PG8_MMA(0, 1, At, B1); PG8_BAR;
            PG8_LDA(At, 0, 1); PG8_STAGE_A(PG8_SA(0, 0), a2, a2, 0, g2);
            PG8_BAR; PG8_WAIT_L(0); PG8_MMA(1, 0, At, B0); PG8_BAR; PG8_SCHED;
            PG8_STAGE(PG8_SB(0, 1), b2 + bstep, voffB);
            if (t == 0 && ui > 0) asm volatile("s_waitcnt vmcnt(%0)" :: "i"(6 + Epi::NST) : "memory"); else PG8_WAIT_V(6);
            PG8_BAR; PG8_MMA(1, 1, At, B1); PG8_BAR;
            PG8_LDB(B0, 1, 0); PG8_SCHED; PG8_LDA(At, 1, 0); PG8_STAGE_A(PG8_SA(0, 1), a2, a2, 1, g2);
            PG8_WAIT_L(8); PG8_BAR; PG8_WAIT_L(0); PG8_MMA(0, 0, At, B0); PG8_BAR; PG8_SCHED;
            PG8_LDB(B1, 1, 1); PG8_STAGE(PG8_SB(1, 0), b3, voffB);
            PG8_BAR; PG8_WAIT_L(0); PG8_MMA(0, 1, At, B1); PG8_BAR;
            PG8_LDA(At, 1, 1); PG8_STAGE_A(PG8_SA(1, 0), a3, a3, 0, g2);
            PG8_BAR; PG8_WAIT_L(0); PG8_MMA(1, 0, At, B0); PG8_BAR; PG8_SCHED;
            PG8_STAGE(PG8_SB(1, 1), b3 + bstep, voffB);
            PG8_WAIT_V(6); PG8_BAR; PG8_MMA(1, 1, At, B1); PG8_BAR;
            PG8_STAGE_A(PG8_SA(1, 1), a3, a3, 1, g2);
        }
        if constexpr (FP8) { asm volatile("s_nop 15\n\ts_nop 15" ::: "memory"); }
        E(acc, cur, wr, wc, fr, fq);
        if (!has_next) break;
#pragma unroll
        for (int a = 0; a < 2; ++a)
#pragma unroll
            for (int b = 0; b < 2; ++b)
#pragma unroll
                for (int m = 0; m < 4; ++m)
#pragma unroll
                    for (int n = 0; n < 2; ++n) acc[a][b][m][n] = (f32x4){0.f, 0.f, 0.f, 0.f};
        cur = nxt; cA = nA; cB = nB; ++ui;
        gc[0][0] = gn[0][0]; gc[0][1] = gn[0][1]; gc[1][0] = gn[1][0]; gc[1][1] = gn[1][1];
    }
    PG8_WAIT_V(0);
    if (wr == 0) PG8_BAR;
    PG8_BAR;
#undef PG8_SA
#undef PG8_SB
#undef PG8_STAGE
#undef PG8_STAGE_A
#undef PG8_LDA
#undef PG8_LDB
#undef PG8_MMA
#undef PG8_WAIT_V
#undef PG8_WAIT_L
#undef PG8_BAR
#undef PG8_SCHED
#undef PG8_GLOAD
}
}

struct Frame { LAS unsigned char* lds; int tid, lane, wave, G, bid; };

__device__ __forceinline__ void p0_mod_unit(const Params& p, const Frame& F, int u) {
    LAS float* st = (LAS float*)F.lds;
    LAS float* red = (LAS float*)(F.lds + 67584);
    for (int idx = F.tid; idx < NB * DM; idx += 512) { const int b = idx >> 11, k = idx & 2047; st[(k + (k >> 6)) * 8 + b] = silu_f(p.c[idx]); }
    __syncthreads();
    if (F.tid < 384) {
        const int cgp = F.tid % 12, kg = F.tid / 12;
        f32x4 acc[8];
#pragma unroll
        for (int b = 0; b < 8; ++b) acc[b] = (f32x4){0.f, 0.f, 0.f, 0.f};
        const char* wbase = (const char*)(p.w_ada + 48 * u); const unsigned woff = (unsigned)((kg * 64) * (6 * DM) + 4 * cgp) * 4u;
#define MOD_LOAD8(dst, j) do { _Pragma("unroll") for (int q = 0; q < 8; ++q) dst[q] = __builtin_nontemporal_load((const f32x4*)(wbase + (woff + (unsigned)((j) * 8 + q) * (unsigned)(6 * DM * 4)))); } while (0)
#define MOD_USE8(src, j) do { _Pragma("unroll") for (int q = 0; q < 8; ++q) { const int kk = (j) * 8 + q; const f32x4 w = src[q]; \
            const f32x4 s0 = *(const LAS f32x4*)(st + (kg * 65 + kk) * 8), s1 = *(const LAS f32x4*)(st + (kg * 65 + kk) * 8 + 4); \
            acc[0] += w * s0[0]; acc[1] += w * s0[1]; acc[2] += w * s0[2]; acc[3] += w * s0[3]; acc[4] += w * s1[0]; acc[5] += w * s1[1]; acc[6] += w * s1[2]; acc[7] += w * s1[3]; } } while (0)
        f32x4 wa[8], wb[8];
        MOD_LOAD8(wa, 0); __builtin_amdgcn_sched_barrier(0);
#pragma unroll 1
        for (int j = 0; j < 8; j += 2) {
            MOD_LOAD8(wb, j + 1); __builtin_amdgcn_sched_barrier(0);
            MOD_USE8(wa, j); __builtin_amdgcn_sched_barrier(0);
            { const int jn = j + 2 < 8 ? j + 2 : 7; MOD_LOAD8(wa, jn); } __builtin_amdgcn_sched_barrier(0);
            MOD_USE8(wb, j + 1); __builtin_amdgcn_sched_barrier(0);
        }
#undef MOD_LOAD8
#undef MOD_USE8
#pragma unroll
        for (int b = 0; b < 8; ++b) *(LAS f32x4*)(red + (kg * 8 + b) * 48 + 4 * cgp) = acc[b];
    }
    __syncthreads();
    if (F.tid < 384) {
        const int b = F.tid / 48, col = F.tid % 48; float s = p.b_ada[48 * u + col];
#pragma unroll
        for (int kg = 0; kg < 32; ++kg) s += red[(kg * 8 + b) * 48 + col];
        ((float*)(p.ws + WS_MOD))[b * (6 * DM) + 48 * u + col] = s;
    }
    __syncthreads();
}
struct CvtJob { const float* src; bf16_t* dst; int ld_src, ld_dst, qrows; float f8scale; };
constexpr int CVT_NT = 4;
#ifndef CVT_WGS
#define CVT_WGS 96
#endif
template <class JobFn>
__device__ __forceinline__ void cvt_stream(const Frame& F, int first, int stride, int total, JobFn job) {
    int v = first; if (v >= total) return;
    const int kr = F.tid >> 5, nc = (F.tid & 31) * 4, n = F.tid >> 2, kc = (F.tid & 3) * 16;
    CvtJob cur = job(v); f32x4 r[CVT_NT][4];
#define CVT_LOAD(jb) do { _Pragma("unroll") for (int q = 0; q < CVT_NT; ++q) _Pragma("unroll") for (int i = 0; i < 4; ++i) r[q][i] = __builtin_nontemporal_load((const f32x4*)((jb).src + (size_t)(kr + 16 * i) * (jb).ld_src + 128 * q + nc)); } while (0)
    CVT_LOAD(cur);
    int buf = 0;
    for (;;) {
        LAS unsigned char* t = F.lds + buf * (CVT_NT * 16384);
#pragma unroll
        for (int q = 0; q < CVT_NT; ++q)
#pragma unroll
            for (int i = 0; i < 4; ++i) *(LAS u32x2*)(t + q * 16384 + (kr + 16 * i) * 256 + nc * 2) = pack4(r[q][i]);
        const int vn = v + stride; const bool more = vn < total; CvtJob nx = cur;
        if (more) { nx = job(vn); CVT_LOAD(nx); }
        asm volatile("s_waitcnt lgkmcnt(0)" ::: "memory"); __builtin_amdgcn_s_barrier(); asm volatile("" ::: "memory");
#pragma unroll
        for (int q = 0; q < CVT_NT; ++q) { unsigned w[8];
#pragma unroll
          for (int e = 0; e < 8; ++e) { const unsigned lo = *(const LAS bf16_t*)(t + q * 16384 + (kc + 2 * e) * 256 + n * 2), hi = *(const LAS bf16_t*)(t + q * 16384 + (kc + 2 * e + 1) * 256 + n * 2); w[e] = lo | (hi << 16); }
          if (cur.f8scale != 0.f) { const float sc = cur.f8scale; unsigned f[4];
#pragma unroll
              for (int e = 0; e < 4; ++e) f[e] = pack_fp8x4(bflo(w[2 * e]) * sc, bfhi(w[2 * e]) * sc, bflo(w[2 * e + 1]) * sc, bfhi(w[2 * e + 1]) * sc);
              *(u32x4*)((unsigned char*)cur.dst + (size_t)(q * cur.qrows + n) * cur.ld_dst + kc) = (u32x4){f[0], f[1], f[2], f[3]}; }
          else { u32x4* d = (u32x4*)(cur.dst + (size_t)(q * cur.qrows + n) * cur.ld_dst + kc); d[0] = (u32x4){w[0], w[1], w[2], w[3]}; d[1] = (u32x4){w[4], w[5], w[6], w[7]}; } }
        if (!more) break;
        v = vn; buf ^= 1; cur = nx;
    }
#undef CVT_LOAD
    __syncthreads();
}
constexpr int P0_MOD = 256, P0_WIN = 1792, P0_WOUT = 512, P0_GU = 8192, P0_DOWN = 4096, P0_SMALL = 16, P0_RT = 24;
__device__ __forceinline__ void p0_prologue(const Params& p, const Frame& F) {
    bf16_t* wout_t = (bf16_t*)(p.ws + WS_WOUT); bf16_t* win_t = (bf16_t*)(p.ws + WS_WIN);
    for (int v = F.bid; v < P0_MOD; v += F.G) p0_mod_unit(p, F, v);
    cvt_stream(F, F.bid, F.G, (P0_WIN + P0_WOUT) / CVT_NT, [&](int g) -> CvtJob {
        int idx = g * CVT_NT;
        if (idx < P0_WIN) { const int kt = idx / 56, nt = idx % 56, n0 = 128 * nt, oc = n0 + (n0 >= 4096 ? 16 : 0);
            return CvtJob{p.w_in + (size_t)kt * 64 * WIN_LD + oc, win_t + (size_t)n0 * DM + kt * 64, WIN_LD, DM, 128, 0.f}; }
        idx -= P0_WIN; const int kt = idx / 16, nt = idx % 16;
        return CvtJob{p.w_out + (size_t)kt * 64 * DM + 128 * nt, wout_t + (size_t)(128 * nt) * DM + kt * 64, DM, DM, 128, 0.f}; });
    for (int v = F.bid; v < P0_SMALL + P0_RT; v += F.G) {
        int idx = v;
        if (idx < P0_SMALL) { bf16_t* sw = (bf16_t*)(p.ws + WS_SMALLW);
            for (int j = 0; j < 8; ++j) { const int i = idx * 4096 + j * 512 + F.tid, s = i >> 11, k = i & 2047;
                const float val = s < 24 ? p.w_in[(size_t)k * WIN_LD + (s < 16 ? 4096 + s : 7184 + s - 16)] : 0.f; sw[i] = f2bf(val); }
            continue; } idx -= P0_SMALL;
        { bf16_t* rw = (bf16_t*)(p.ws + WS_RTW);
            for (int j = 0; j < 8; ++j) { const int i = idx * 4096 + j * 512 + F.tid, n = i >> 11, k = i & 2047;
                const float val = n < 4 ? p.w_rg[k * 4 + n] : (n < 36 ? p.w_re[(size_t)((n - 4) >> 3) * DM * 8 + k * 8 + ((n - 4) & 7)] : 0.f);
                const bf16_t hi = f2bf(val); rw[i] = hi; rw[48 * DM + i] = f2bf(val - bf1(hi)); } }
    }
}
__device__ __forceinline__ void moe_weight_tiles(const Params& p, const Frame& F, int first, int stride) {
    bf16_t* w1 = (bf16_t*)((unsigned char*)p.out + OUT_W1); bf16_t* w2 = (bf16_t*)((unsigned char*)p.out + OUT_W2);
    cvt_stream(F, first, stride, (P0_GU + P0_DOWN) / CVT_NT, [&](int g) -> CvtJob {
        int idx = g * CVT_NT;
        if (idx < P0_GU) { const int e = idx >> 8, r = idx & 255, which = r >> 7, r2 = r & 127, kt = r2 >> 2;
            return CvtJob{(which ? p.w_up : p.w_gate) + (size_t)e * DM * DEXP + (size_t)kt * 64 * DEXP, (bf16_t*)((unsigned char*)w1 + (size_t)(e * 1024 + which * 128) * DM + kt * 64), DEXP, DM, 256, W1_SCALE}; }
        idx -= P0_GU; const int e = idx >> 7, r = idx & 127, kt = r >> 4, nt = r & 15;
        return CvtJob{p.w_down + (size_t)e * DEXP * DM + (size_t)kt * 64 * DM + 128 * nt, (bf16_t*)((unsigned char*)w2 + (size_t)(e * 2048 + 128 * nt) * DEXP + kt * 64), DM, DEXP, 128, W2_SCALE}; });
}

constexpr int H1_SW = 16384, H1_SWLD = 4112;
__device__ __forceinline__ void p1_hpass(const Params& p, const Frame& F) {
    const float* mod = (const float*)(p.ws + WS_MOD); bf16_t* hb = (bf16_t*)(p.ws + WS_HBUF); const bf16_t* sw = (const bf16_t*)(p.ws + WS_SMALLW); float* sm = (float*)(p.ws + WS_SM);
    const int fr = F.lane & 15, fq = F.lane >> 4;
    for (int i = F.tid; i < 32 * 256; i += 512) { const int r = i >> 8, ch = i & 255; *(LAS u32x4*)(F.lds + H1_SW + r * H1_SWLD + ch * 16) = *(const u32x4*)(sw + (size_t)r * DM + ch * 8); }
    int bcur = -1;
    for (int wt0 = F.bid * 8; wt0 < NTOK / 16; wt0 += F.G * 8) {
        const int wt = wt0 + F.wave, row0 = wt * 16, b = (wt0 * 16) / SEQ;
        if (b != bcur) { __syncthreads(); bcur = b;
            for (int i = F.tid; i < DM; i += 512) { ((LAS float*)F.lds)[i] = 1.f + mod[(size_t)b * (6 * DM) + DM + i]; ((LAS float*)F.lds)[DM + i] = mod[(size_t)b * (6 * DM) + i]; }
            __syncthreads(); }
        const float* xr = p.x + (size_t)(row0 + fr) * DM + 8 * fq; bf16_t* hr = hb + (size_t)(row0 + fr) * DM + 8 * fq;
        f32x4 a0 = {0.f, 0.f, 0.f, 0.f}, a1 = {0.f, 0.f, 0.f, 0.f};
        f32x4 xa[8][2], xn[8][2];
#define H1_LOAD(dst, blk_) do { _Pragma("unroll") for (int j = 0; j < 8; ++j) { dst[j][0] = __builtin_nontemporal_load((const f32x4*)(xr + 32 * (8 * (blk_) + j))); dst[j][1] = __builtin_nontemporal_load((const f32x4*)(xr + 32 * (8 * (blk_) + j) + 4)); } } while (0)
#define H1_COMP(src, blk_) do { _Pragma("unroll") for (int j = 0; j < 8; ++j) { const int s = 8 * (blk_) + j; \
                const f32x4 c0 = *(const LAS f32x4*)(F.lds + (32 * s + 8 * fq) * 4), c1 = *(const LAS f32x4*)(F.lds + (32 * s + 8 * fq) * 4 + 16); \
                const f32x4 h0 = *(const LAS f32x4*)(F.lds + 8192 + (32 * s + 8 * fq) * 4), h1 = *(const LAS f32x4*)(F.lds + 8192 + (32 * s + 8 * fq) * 4 + 16); \
                const bf16x8 af = pack8(src[j][0] * c0 + h0, src[j][1] * c1 + h1); \
                *(bf16x8*)(hr + 32 * s) = af; \
                const bf16x8 b0 = *(const LAS bf16x8*)(F.lds + H1_SW + fr * H1_SWLD + (32 * s + 8 * fq) * 2), b1 = *(const LAS bf16x8*)(F.lds + H1_SW + (16 + fr) * H1_SWLD + (32 * s + 8 * fq) * 2); \
                a0 = mfma16(af, b0, a0); a1 = mfma16(af, b1, a1); } } while (0)
        H1_LOAD(xa, 0);
#pragma unroll 1
        for (int bp = 0; bp < 4; ++bp) {
            H1_LOAD(xn, 2 * bp + 1); H1_COMP(xa, 2 * bp);
            if (bp < 3) H1_LOAD(xa, 2 * bp + 2);
            H1_COMP(xn, 2 * bp + 1);
        }
#undef H1_LOAD
#undef H1_COMP
#pragma unroll
        for (int j = 0; j < 4; ++j) { float* o = sm + (size_t)(row0 + 4 * fq + j) * 32; o[fr] = a0[j]; o[16 + fr] = a1[j]; }
    }
    __syncthreads();
}

constexpr int D1_KN = 0, D1_QN = 17408, D1_VN = 34816, D1_AOFF = 52224, D1_TM = 61440, D1_TB = 70656, D1_TG = 79872, D1_ADIAG = 89088, D1_GATES = 93440;
constexpr int D1_CW = 94464;
struct D1Pre { u32x4 x[3][5]; float gb, ga; };
__device__ __forceinline__ void d1_prefetch(const Params& p, const Frame& F, int u, D1Pre& P) {
    const int bh = u >> 6, c = u & 63, b = bh >> 3, h = bh & 7, row0 = b * SEQ + c * 64;
    const bf16_t* proj = (const bf16_t*)(p.ws + WS_PROJ); const float* sm = (const float*)(p.ws + WS_SM);
    const int cg = F.tid & 15, t0 = 2 * (F.tid >> 4);
#pragma unroll
    for (int part = 0; part < 3; ++part)
#pragma unroll
        for (int j = 0; j < 5; ++j) { const int tt = c * 64 + t0 - 3 + j; const int tc = tt >= 0 ? t0 - 3 + j : 0;
            P.x[part][j] = *(const u32x4*)(proj + (size_t)(row0 + tc) * LDP + part * 1024 + h * HD + 8 * cg); }
    const float* r = sm + (size_t)(row0 + F.lane) * 32; P.gb = r[h]; P.ga = r[8 + h];
}
__device__ __forceinline__ void d1_chunk(const Params& p, const Frame& F, int u, D1Pre& P, int unext) {
    LAS unsigned char* lds = F.lds;
    const int tid = F.tid, lane = F.lane, wave = F.wave, fr = lane & 15, fq = lane >> 4;
    const int bh = u >> 6, c = u & 63, h = bh & 7;
    unsigned char* outc = p.ws + WS_DN + (size_t)u * DN_CHUNK;
    LAS float* Gs = (LAS float*)(lds + D1_GATES); LAS float* Bs = Gs + 64; LAS float* EGs = Gs + 128;
    if (wave == 0) {
        const float bl = P.gb, al = P.ga;
        const float beta = __builtin_amdgcn_rcpf(1.f + __expf(-bl));
        const float xs = al + p.dt_bias[h];
        const float sp = xs > 20.f ? xs : log1pf(__expf(xs));
        float G = -__expf(p.a_log[h]) * sp;
#pragma unroll
        for (int o = 1; o < 64; o <<= 1) { const float v = __shfl_up(G, o); if (lane >= o) G += v; }
        Gs[lane] = G; Bs[lane] = beta; EGs[lane] = __expf(G);
    }
    {
        const int cg = tid & 15, rp = tid >> 4, t0 = 2 * rp;
#pragma unroll
        for (int part = 0; part < 3; ++part) {
            float cw[4][8];
#pragma unroll
            for (int tp = 0; tp < 4; ++tp) { const f32x4 w0 = *(const LAS f32x4*)(lds + D1_CW + ((part * 4 + tp) * 128 + 8 * cg) * 4), w1 = *(const LAS f32x4*)(lds + D1_CW + ((part * 4 + tp) * 128 + 8 * cg + 4) * 4);
                cw[tp][0] = w0[0]; cw[tp][1] = w0[1]; cw[tp][2] = w0[2]; cw[tp][3] = w0[3]; cw[tp][4] = w1[0]; cw[tp][5] = w1[1]; cw[tp][6] = w1[2]; cw[tp][7] = w1[3]; }
            float o0[8], o1[8];
#pragma unroll
            for (int e = 0; e < 8; ++e) { o0[e] = 0.f; o1[e] = 0.f; }
#pragma unroll
            for (int j = 0; j < 5; ++j) { u32x4 xr = P.x[part][j];
                if (j < 3) { const bool valid = c * 64 + t0 - 3 + j >= 0; xr.x = valid ? xr.x : 0u; xr.y = valid ? xr.y : 0u; xr.z = valid ? xr.z : 0u; xr.w = valid ? xr.w : 0u; }
                float xf[8]; unpack8(xr, xf);
#pragma unroll
                for (int e = 0; e < 8; ++e) { const float xv = xf[e]; if (j < 4) o0[e] += cw[j][e] * xv; if (j >= 1) o1[e] += cw[j - 1][e] * xv; } }
            float s0 = 0.f, s1 = 0.f;
#pragma unroll
            for (int e = 0; e < 8; ++e) { o0[e] = silu_f(o0[e]); o1[e] = silu_f(o1[e]); s0 += o0[e] * o0[e]; s1 += o1[e] * o1[e]; }
            if (part < 2) {
#pragma unroll
                for (int o = 1; o < 16; o <<= 1) { s0 += __shfl_xor(s0, o); s1 += __shfl_xor(s1, o); }
                const float r0 = rsqrtf(s0 + NORM_EPS), r1 = rsqrtf(s1 + NORM_EPS);
#pragma unroll
                for (int e = 0; e < 8; ++e) { o0[e] *= r0; o1[e] *= r1; }
            }
            const int img = part == 0 ? D1_QN : (part == 1 ? D1_KN : D1_VN);
            *(LAS bf16x8*)(lds + img + t0 * 272 + cg * 16) = pack8((f32x4){o0[0], o0[1], o0[2], o0[3]}, (f32x4){o0[4], o0[5], o0[6], o0[7]});
            *(LAS bf16x8*)(lds + img + (t0 + 1) * 272 + cg * 16) = pack8((f32x4){o1[0], o1[1], o1[2], o1[3]}, (f32x4){o1[4], o1[5], o1[6], o1[7]});
            __builtin_amdgcn_sched_barrier(0);
        }
    }
    d1_prefetch(p, F, unext, P);
    __syncthreads();
#define D1_TILE_JOB(job_) do { const int job = (job_), kind = job >> 4, ti = (job >> 2) & 3, tj = job & 3; \
        const int icol = 16 * ti + fr, j0 = 16 * tj + 4 * fq; \
        if (tj > ti) { if (kind == 1) *(u32x2*)(outc + DN_QK + icol * 144 + j0 * 2) = (u32x2){0u, 0u}; break; } \
        f32x4 acc = {0.f, 0.f, 0.f, 0.f}; \
        const int ybase = kind ? D1_QN : D1_KN; \
        _Pragma("unroll") for (int s = 0; s < 4; ++s) { \
            const bf16x8 a = *(const LAS bf16x8*)(lds + D1_KN + (16 * tj + fr) * 272 + (32 * s + 8 * fq) * 2); \
            const bf16x8 bb = *(const LAS bf16x8*)(lds + ybase + (16 * ti + fr) * 272 + (32 * s + 8 * fq) * 2); \
            acc = mfma16(a, bb, acc); } \
        const float Gi = Gs[icol]; const f32x4 Gj = *(const LAS f32x4*)(Gs + j0); \
        f32x4 v; \
        if (kind == 0) { const float bi = Bs[icol]; \
            _Pragma("unroll") for (int e = 0; e < 4; ++e) v[e] = (j0 + e < icol) ? bi * acc[e] * __expf(Gi - Gj[e]) : 0.f; \
            if (tj < ti) *(LAS u32x2*)(lds + D1_AOFF + icol * 144 + j0 * 2) = pack4(v); \
            else *(LAS f32x4*)(lds + D1_ADIAG + ti * 1040 + fr * 64 + fq * 16) = v; \
        } else { \
            _Pragma("unroll") for (int e = 0; e < 4; ++e) v[e] = (j0 + e <= icol) ? acc[e] * __expf(Gi - Gj[e]) * QSCALE : 0.f; \
            *(u32x2*)(outc + DN_QK + icol * 144 + j0 * 2) = pack4(v); \
        } } while (0)
#pragma unroll 1
    for (int jj = 0; jj < 2; ++jj) D1_TILE_JOB(wave + 8 * jj);
    __syncthreads();
    if (wave == 0) {
        { const int blk = lane >> 4, jc = lane & 15; float t[16];
#pragma unroll
          for (int i = 0; i < 16; ++i) { float a4[4] = {(jc == i) ? 1.f : 0.f, 0.f, 0.f, 0.f};
#pragma unroll
              for (int m4 = 0; m4 < (i + 3) / 4; ++m4) { const f32x4 ar = *(const LAS f32x4*)(lds + D1_ADIAG + blk * 1040 + i * 64 + m4 * 16);
#pragma unroll
                  for (int e = 0; e < 4; ++e) if (4 * m4 + e < i) a4[e] -= ar[e] * t[4 * m4 + e]; }
              t[i] = (a4[0] + a4[1]) + (a4[2] + a4[3]); if ((i & 3) == 3) __builtin_amdgcn_sched_barrier(0); }
          const int j = 16 * blk + jc; const float bj = Bs[j], bgj = bj * EGs[j];
#pragma unroll
          for (int i = 0; i < 16; ++i) { const int off = (16 * blk + i) * 144 + j * 2;
              *(LAS bf16_t*)(lds + D1_TM + off) = f2bf(t[i]); *(LAS bf16_t*)(lds + D1_TB + off) = f2bf(t[i] * bj); *(LAS bf16_t*)(lds + D1_TG + off) = f2bf(t[i] * bgj); } }
        LGKM0();
        const int tmaddr = (int)(uintptr_t)(lds + D1_TM);
#pragma unroll
        for (int bb = 1; bb < 4; ++bb) {
            constexpr int NS_MAX = 2;
            bf16x8 a[NS_MAX]; s16x4 l[3][NS_MAX], hh[3][NS_MAX];
            const int ns = bb == 3 ? 2 : 1;
#pragma unroll
            for (int s_ = 0; s_ < NS_MAX; ++s_) if (s_ < ns) a[s_] = *(const LAS bf16x8*)(lds + D1_AOFF + (16 * bb + fr) * 144 + (32 * s_ + 8 * fq) * 2);
#pragma unroll
            for (int cc = 0; cc < 3; ++cc) if (cc < bb)
#pragma unroll
                for (int s_ = 0; s_ < NS_MAX; ++s_) if (s_ < ns) { const int ad = tmaddr + (32 * s_ + 8 * fq + (fr >> 2)) * 144 + (16 * cc + 4 * (fr & 3)) * 2; TRRD(l[cc][s_], ad, 0); TRRD(hh[cc][s_], ad, 576); }
            const u32x2 t2 = *(const LAS u32x2*)(lds + D1_TM + (16 * bb + fr) * 144 + (16 * bb + 4 * fq) * 2);
            LGKM0();
            f32x4 X[3];
#pragma unroll
            for (int cc = 0; cc < 3; ++cc) if (cc < bb) { X[cc] = (f32x4){0.f, 0.f, 0.f, 0.f};
#pragma unroll
                for (int s_ = 0; s_ < NS_MAX; ++s_) if (s_ < ns) X[cc] = mfma16(a[s_], join8(l[cc][s_], hh[cc][s_]), X[cc]); }
#pragma unroll
            for (int cc = 0; cc < 3; ++cc) if (cc < bb) {
                u32x4 aw = {t2.x, t2.y, 0u, 0u}, bw = {cvtpk(X[cc][0], X[cc][1]), cvtpk(X[cc][2], X[cc][3]), 0u, 0u};
                const f32x4 Tn = mfma16(*reinterpret_cast<bf16x8*>(&aw), *reinterpret_cast<bf16x8*>(&bw), (f32x4){0.f, 0.f, 0.f, 0.f});
                const int j = 16 * cc + fr; const float bj = Bs[j], bgj = bj * EGs[j];
#pragma unroll
                for (int e = 0; e < 4; ++e) { const int off = (16 * bb + 4 * fq + e) * 144 + j * 2; const float tv = -Tn[e];
                    *(LAS bf16_t*)(lds + D1_TM + off) = f2bf(tv); *(LAS bf16_t*)(lds + D1_TB + off) = f2bf(tv * bj); *(LAS bf16_t*)(lds + D1_TG + off) = f2bf(tv * bgj); }
            }
            LGKM0();
        }
    } else {
        const int t7 = tid - 64; const float Glast = Gs[63];
        for (int i = t7; i < 1024; i += 448) { const int r = i >> 4, ch = i & 15; float f[8]; unpack8(*(const LAS u32x4*)(lds + D1_QN + r * 272 + ch * 16), f); const float sc = EGs[r] * QSCALE;
            *(bf16x8*)(outc + DN_Q + r * 272 + ch * 16) = pack8((f32x4){f[0] * sc, f[1] * sc, f[2] * sc, f[3] * sc}, (f32x4){f[4] * sc, f[5] * sc, f[6] * sc, f[7] * sc}); }
        for (int i = t7; i < 1024; i += 448) { const int dk = i & 127, ich = i >> 7; float f[8];
#pragma unroll
            for (int e = 0; e < 8; ++e) f[e] = bf1(*(const LAS bf16_t*)(lds + D1_KN + (8 * ich + e) * 272 + dk * 2)) * __expf(Glast - Gs[8 * ich + e]);
            *(bf16x8*)(outc + DN_KT + dk * 144 + ich * 16) = pack8((f32x4){f[0], f[1], f[2], f[3]}, (f32x4){f[4], f[5], f[6], f[7]}); }
        if (t7 == 0) *(float*)(outc + DN_MISC) = __expf(Glast);
#pragma unroll 1
        for (int jq = 16 + wave - 1; jq < 32; jq += 7) D1_TILE_JOB(jq);
    }
#undef D1_TILE_JOB
    __syncthreads();
    { const int vnaddr = (int)(uintptr_t)(lds + D1_VN), knaddr = (int)(uintptr_t)(lds + D1_KN);
#pragma unroll
      for (int jp = 0; jp < 2; ++jp) {
        bf16x8 a[2][2]; s16x4 l[2][2], hh[2][2];
#pragma unroll
        for (int q = 0; q < 2; ++q)
#pragma unroll
            for (int s_ = 0; s_ < 2; ++s_) { const int it = 2 * jp + q;
                a[q][s_] = *(const LAS bf16x8*)(lds + D1_TB + (16 * it + fr) * 144 + (32 * s_ + 8 * fq) * 2);
                const int ad = vnaddr + (32 * s_ + 8 * fq + (fr >> 2)) * 272 + (16 * wave + 4 * (fr & 3)) * 2;
                TRRD(l[q][s_], ad, 0); TRRD(hh[q][s_], ad, 1088); }
        LGKM0();
#pragma unroll
        for (int q = 0; q < 2; ++q) { const int it = 2 * jp + q; f32x4 acc = {0.f, 0.f, 0.f, 0.f};
            acc = mfma16(a[q][0], join8(l[q][0], hh[q][0]), acc); acc = mfma16(a[q][1], join8(l[q][1], hh[q][1]), acc);
            *(u32x2*)(outc + DN_UT + (16 * wave + fr) * 128 + (16 * it + 4 * fq) * 2) = pack4(acc); }
      }
#pragma unroll
      for (int jp = 0; jp < 2; ++jp) {
        const int it = wave & 3;
        bf16x8 bb[2]; s16x4 l[2][2], hh[2][2];
#pragma unroll
        for (int s_ = 0; s_ < 2; ++s_) bb[s_] = *(const LAS bf16x8*)(lds + D1_TG + (16 * it + fr) * 144 + (32 * s_ + 8 * fq) * 2);
#pragma unroll
        for (int q = 0; q < 2; ++q)
#pragma unroll
            for (int s_ = 0; s_ < 2; ++s_) { const int dkt = 4 * jp + 2 * q + (wave >> 2);
                const int ad = knaddr + (32 * s_ + 8 * fq + (fr >> 2)) * 272 + (16 * dkt + 4 * (fr & 3)) * 2;
                TRRD(l[q][s_], ad, 0); TRRD(hh[q][s_], ad, 1088); }
        LGKM0();
#pragma unroll
        for (int q = 0; q < 2; ++q) { const int dkt = 4 * jp + 2 * q + (wave >> 2); f32x4 acc = {0.f, 0.f, 0.f, 0.f};
            acc = mfma16(join8(l[q][0], hh[q][0]), bb[0], acc); acc = mfma16(join8(l[q][1], hh[q][1]), bb[1], acc);
            *(u32x2*)(outc + DN_W + (16 * it + fr) * 272 + (16 * dkt + 4 * fq) * 2) = pack4(-acc); }
      } }
    __syncthreads();
}
__device__ __forceinline__ void fcum_unit(const Params& p, const Frame& F, int bh) {
    const float* sm = (const float*)(p.ws + WS_SM); float* fc = (float*)(p.ws + WS_FCUM) + (size_t)bh * SEQ;
    const int b = bh >> 3, h = bh & 7; const float fb = p.f_bias[h];
    LAS float* red = (LAS float*)F.lds;
    float v[8], s = 0.f;
#pragma unroll
    for (int e = 0; e < 8; ++e) { const float z = sm[(size_t)(b * SEQ + F.tid * 8 + e) * 32 + 16 + h] + fb; const float ls = fminf(z, 0.f) - log1pf(__expf(-fabsf(z))); s += ls; v[e] = s; }
    float inc = s;
#pragma unroll
    for (int o = 1; o < 64; o <<= 1) { const float t = __shfl_up(inc, o); if (F.lane >= o) inc += t; }
    if (F.lane == 63) red[F.wave] = inc;
    __syncthreads();
    float base = inc - s;
    for (int w = 0; w < F.wave; ++w) base += red[w];
#pragma unroll
    for (int e = 0; e < 8; ++e) fc[F.tid * 8 + e] = -(base + v[e]) * 11.313708498984761f;
    __syncthreads();
}
__device__ __forceinline__ int d1_unit(int bid, int i) { const int h = bid & 7, j = (bid >> 3) + 32 * i, b = j >> 6, c = j & 63; return ((b * 8 + h) << 6) + c; }
__device__ __forceinline__ void p3_dnprep(const Params& p, const Frame& F) {
    if (F.G == 256) {
        const int h = F.bid & 7;
        for (int i = F.tid; i < 3 * 4 * 128; i += 512) { const int part = i / 512, tp = (i >> 7) & 3, ch = i & 127; ((LAS float*)(F.lds + D1_CW))[i] = p.conv_w[tp * 3072 + part * 1024 + h * HD + ch]; }
        for (int i = F.tid; i < 2304; i += 512) *(LAS u32x4*)(F.lds + D1_AOFF + i * 16) = (u32x4){0u, 0u, 0u, 0u};
        D1Pre P; d1_prefetch(p, F, d1_unit(F.bid, 0), P);
        __syncthreads();
#pragma unroll 1
        for (int i = 0; i < 16; ++i) d1_chunk(p, F, d1_unit(F.bid, i), P, d1_unit(F.bid, i < 15 ? i + 1 : i));
    } else {
        for (int u = F.bid; u < 4096; u += F.G) { const int h = (u >> 6) & 7;
            __syncthreads();
            for (int i = F.tid; i < 3 * 4 * 128; i += 512) { const int part = i / 512, tp = (i >> 7) & 3, ch = i & 127; ((LAS float*)(F.lds + D1_CW))[i] = p.conv_w[tp * 3072 + part * 1024 + h * HD + ch]; }
            for (int i = F.tid; i < 2304; i += 512) *(LAS u32x4*)(F.lds + D1_AOFF + i * 16) = (u32x4){0u, 0u, 0u, 0u};
            D1Pre P; d1_prefetch(p, F, u, P);
            __syncthreads();
            d1_chunk(p, F, u, P, u); }
    }
    if (F.bid < 64) fcum_unit(p, F, F.bid);
    for (int u = F.bid; u < 256; u += F.G) { const int bh = u >> 2, seg = u & 3, b = bh >> 3, h = bh & 7;
        const bf16_t* proj = (const bf16_t*)(p.ws + WS_PROJ); float q2m = 0.f, k2m = 0.f;
        for (int r = F.tid >> 4; r < 1024; r += 32) { const bf16_t* rowp = proj + (size_t)(b * SEQ + seg * 1024 + r) * LDP + h * HD + 8 * (F.tid & 15);
            float qf[8], kf[8]; unpack8(*(const u32x4*)(rowp + FQ), qf); unpack8(*(const u32x4*)(rowp + FK), kf);
            float q2 = 0.f, k2 = 0.f;
#pragma unroll
            for (int e = 0; e < 8; ++e) { q2 += qf[e] * qf[e]; k2 += kf[e] * kf[e]; }
#pragma unroll
            for (int m = 1; m < 16; m <<= 1) { q2 += __shfl_xor(q2, m); k2 += __shfl_xor(k2, m); }
            q2m = fmaxf(q2m, q2); k2m = fmaxf(k2m, k2); }
#pragma unroll
        for (int m = 16; m < 64; m <<= 1) { q2m = fmaxf(q2m, __shfl_xor(q2m, m)); k2m = fmaxf(k2m, __shfl_xor(k2m, m)); }
        if (F.lane == 0) { unsigned* mx = (unsigned*)(p.ws + WS_CTL) + CW_QKMAX + 2 * bh; atomicMax(mx, __float_as_uint(q2m)); atomicMax(mx + 1, __float_as_uint(k2m)); } }
}

constexpr int SC_W = 0, SC_KT = 17408, SC_Q = 35840, SC_QK = 53248, SC_ST = 62464, SC_VT = 97280, SC_OB = 115712, SC_END = 133120, SC_UT = 133120, SC_DC = SC_UT + 16384, SC_NW = SC_DC + 64;
__device__ __forceinline__ void scan_unit(const Params& p, const Frame& F, int bh) {
    LAS unsigned char* lds = F.lds;
    const int tid = F.tid, lane = F.lane, wave = F.wave, fr = lane & 15, fq = lane >> 4;
    const int b = bh >> 3, h = bh & 7;
    const unsigned char* dn = p.ws + WS_DN + (size_t)bh * 64 * DN_CHUNK;
    const bf16_t* proj = (const bf16_t*)(p.ws + WS_PROJ); bf16_t* cat = (bf16_t*)(p.ws + WS_HBUF);
    if (wave < 4) {
        LAS unsigned char* ST = lds + SC_ST + wave * 8704; LAS unsigned char* VT = lds + SC_VT + wave * 4608;
        f32x4 S[8][2];
#pragma unroll
        for (int a = 0; a < 8; ++a) { S[a][0] = (f32x4){0.f, 0.f, 0.f, 0.f}; S[a][1] = (f32x4){0.f, 0.f, 0.f, 0.f}; }
#define LDF(base, pitch, rt, s) (*(const LAS bf16x8*)(lds + (base) + (16 * (rt) + fr) * (pitch) + (32 * (s) + 8 * fq) * 2))
#define SCHED() __builtin_amdgcn_sched_barrier(0)
#define SSTEP(c) do { \
            _Pragma("unroll") for (int dkt = 0; dkt < 8; ++dkt) _Pragma("unroll") for (int dvt = 0; dvt < 2; ++dvt) *(LAS u32x2*)(ST + (16 * dvt + fr) * 272 + (16 * dkt + 4 * fq) * 2) = pack4(S[dkt][dvt]); \
            LBAR();                                                                                 \
            bf16x8 bs[2][4], fa[8], fb[8]; \
            _Pragma("unroll") for (int dvt = 0; dvt < 2; ++dvt) _Pragma("unroll") for (int s = 0; s < 4; ++s) bs[dvt][s] = *(const LAS bf16x8*)(ST + (16 * dvt + fr) * 272 + (32 * s + 8 * fq) * 2); \
            _Pragma("unroll") for (int i = 0; i < 8; ++i) fa[i] = LDF(SC_W, 272, i >> 2, i & 3); \
            SCHED(); \
            f32x4 va[2][2], vb[2][2]; \
            const float DC = *(const LAS float*)(lds + SC_DC); \
            _Pragma("unroll") for (int it = 0; it < 2; ++it) _Pragma("unroll") for (int dvt = 0; dvt < 2; ++dvt) { \
                const u32x2 ua = *(const LAS u32x2*)(lds + SC_UT + (32 * wave + 16 * dvt + fr) * 128 + (16 * it + 4 * fq) * 2), ub = *(const LAS u32x2*)(lds + SC_UT + (32 * wave + 16 * dvt + fr) * 128 + (16 * (2 + it) + 4 * fq) * 2); \
                va[it][dvt] = (f32x4){bflo(ua.x), bfhi(ua.x), bflo(ua.y), bfhi(ua.y)}; vb[it][dvt] = (f32x4){bflo(ub.x), bfhi(ub.x), bflo(ub.y), bfhi(ub.y)}; } \
            _Pragma("unroll") for (int i = 0; i < 8; ++i) fb[i] = LDF(SC_W, 272, 2 + (i >> 2), i & 3); \
            SCHED(); \
            _Pragma("unroll") for (int i = 0; i < 8; ++i) { va[i >> 2][0] = mfma16(fa[i], bs[0][i & 3], va[i >> 2][0]); va[i >> 2][1] = mfma16(fa[i], bs[1][i & 3], va[i >> 2][1]); } \
            SCHED(); \
            _Pragma("unroll") for (int i = 0; i < 8; ++i) fa[i] = LDF(SC_KT, 144, i >> 1, i & 1); \
            _Pragma("unroll") for (int it = 0; it < 2; ++it) _Pragma("unroll") for (int dvt = 0; dvt < 2; ++dvt) *(LAS u32x2*)(VT + (16 * dvt + fr) * 144 + (16 * it + 4 * fq) * 2) = pack4(va[it][dvt]); \
            SCHED(); \
            _Pragma("unroll") for (int i = 0; i < 8; ++i) { vb[i >> 2][0] = mfma16(fb[i], bs[0][i & 3], vb[i >> 2][0]); vb[i >> 2][1] = mfma16(fb[i], bs[1][i & 3], vb[i >> 2][1]); } \
            _Pragma("unroll") for (int it = 0; it < 2; ++it) _Pragma("unroll") for (int dvt = 0; dvt < 2; ++dvt) *(LAS u32x2*)(VT + (16 * dvt + fr) * 144 + (16 * (2 + it) + 4 * fq) * 2) = pack4(vb[it][dvt]); \
            bf16x8 bv[2][2]; \
            _Pragma("unroll") for (int dvt = 0; dvt < 2; ++dvt) _Pragma("unroll") for (int s = 0; s < 2; ++s) bv[dvt][s] = *(const LAS bf16x8*)(VT + (16 * dvt + fr) * 144 + (32 * s + 8 * fq) * 2); \
            _Pragma("unroll") for (int i = 0; i < 8; ++i) fb[i] = LDF(SC_KT, 144, 4 + (i >> 1), i & 1); \
            SCHED(); \
            _Pragma("unroll") for (int dkt = 0; dkt < 8; ++dkt) { S[dkt][0] *= DC; S[dkt][1] *= DC; } \
            _Pragma("unroll") for (int i = 0; i < 8; ++i) { S[i >> 1][0] = mfma16(fa[i], bv[0][i & 1], S[i >> 1][0]); S[i >> 1][1] = mfma16(fa[i], bv[1][i & 1], S[i >> 1][1]); } \
            _Pragma("unroll") for (int i = 0; i < 8; ++i) { S[4 + (i >> 1)][0] = mfma16(fb[i], bv[0][i & 1], S[4 + (i >> 1)][0]); S[4 + (i >> 1)][1] = mfma16(fb[i], bv[1][i & 1], S[4 + (i >> 1)][1]); } \
            LBAR();                                                                                 \
              \
            bf16x8 bq[2][4];                                                                       \
            _Pragma("unroll") for (int dvt = 0; dvt < 2; ++dvt) _Pragma("unroll") for (int s = 0; s < 4; ++s) bq[dvt][s] = *(const LAS bf16x8*)(ST + (16 * dvt + fr) * 272 + (32 * s + 8 * fq) * 2); \
            _Pragma("unroll") for (int i = 0; i < 4; ++i) fa[i] = LDF(SC_Q, 272, 0, i); \
            fa[4] = LDF(SC_QK, 144, 0, 0); fa[5] = LDF(SC_QK, 144, 0, 1); \
            _Pragma("unroll") for (int i = 0; i < 4; ++i) fb[i] = LDF(SC_Q, 272, 1, i); \
            fb[4] = LDF(SC_QK, 144, 1, 0); fb[5] = LDF(SC_QK, 144, 1, 1); \
            SCHED(); \
            _Pragma("unroll") for (int it = 0; it < 4; ++it) { \
                f32x4 o0 = {0.f, 0.f, 0.f, 0.f}, o1 = {0.f, 0.f, 0.f, 0.f}; \
                if ((it & 1) == 0) { \
                    _Pragma("unroll") for (int i = 0; i < 4; ++i) { o0 = mfma16(fa[i], bq[0][i], o0); o1 = mfma16(fa[i], bq[1][i], o1); } \
                    _Pragma("unroll") for (int i = 0; i < 2; ++i) { o0 = mfma16(fa[4 + i], bv[0][i], o0); o1 = mfma16(fa[4 + i], bv[1][i], o1); } \
                    SCHED(); \
                    if (it + 2 < 4) { _Pragma("unroll") for (int i = 0; i < 4; ++i) fa[i] = LDF(SC_Q, 272, it + 2, i); fa[4] = LDF(SC_QK, 144, it + 2, 0); fa[5] = LDF(SC_QK, 144, it + 2, 1); } \
                } else { \
                    _Pragma("unroll") for (int i = 0; i < 4; ++i) { o0 = mfma16(fb[i], bq[0][i], o0); o1 = mfma16(fb[i], bq[1][i], o1); } \
                    _Pragma("unroll") for (int i = 0; i < 2; ++i) { o0 = mfma16(fb[4 + i], bv[0][i], o0); o1 = mfma16(fb[4 + i], bv[1][i], o1); } \
                    SCHED(); \
                    if (it + 2 < 4) { _Pragma("unroll") for (int i = 0; i < 4; ++i) fb[i] = LDF(SC_Q, 272, it + 2, i); fb[4] = LDF(SC_QK, 144, it + 2, 0); fb[5] = LDF(SC_QK, 144, it + 2, 1); } \
                } \
                _Pragma("unroll") for (int e = 0; e < 4; ++e) { const int i_ = 16 * it + 4 * fq + e; \
                    *(LAS bf16_t*)(lds + SC_OB + i_ * 272 + (32 * wave + fr) * 2) = f2bf(o0[e]); *(LAS bf16_t*)(lds + SC_OB + i_ * 272 + (32 * wave + 16 + fr) * 2) = f2bf(o1[e]); } \
                SCHED(); \
            } } while (0)
#pragma unroll 1
        for (int c2 = 0; c2 < 64; ++c2) { SSTEP(c2); }
#undef SSTEP
#undef LDF
#undef SCHED
        __syncthreads();
    } else {
        const int ht = tid - 256;
        u32x4 ra0[9], ra1[9], rb0[7], ru0[4], ru1[4]; float rd0, rd1;
#define LOADA(ra, ru, rd, cc) do { const int cc_ = (cc) < 64 ? (cc) : 63; const unsigned char* s_ = dn + (size_t)cc_ * DN_CHUNK; \
        _Pragma("unroll") for (int i = 0; i < 9; ++i) ra[i] = *(const u32x4*)(s_ + DN_W + (size_t)(ht + 256 * i) * 16); \
        _Pragma("unroll") for (int i = 0; i < 4; ++i) ru[i] = *(const u32x4*)(s_ + DN_UT + (size_t)(ht + 256 * i) * 16); rd = *(const float*)(s_ + DN_MISC); } while (0)
#define WRITEA(ra, ru, rd) do { _Pragma("unroll") for (int i = 0; i < 9; ++i) if (i < 8 || ht < 192) *(LAS u32x4*)(lds + SC_W + (ht + 256 * i) * 16) = ra[i]; \
        _Pragma("unroll") for (int i = 0; i < 4; ++i) *(LAS u32x4*)(lds + SC_UT + (ht + 256 * i) * 16) = ru[i]; if (ht == 0) *(LAS float*)(lds + SC_DC) = rd; } while (0)
#define LOADB(rb, cc) do { const int cc_ = (cc) < 64 ? (cc) : 63; const unsigned char* s_ = dn + (size_t)cc_ * DN_CHUNK + DN_Q; _Pragma("unroll") for (int i = 0; i < 7; ++i) rb[i] = *(const u32x4*)(s_ + (size_t)(ht + 256 * i) * 16); } while (0)
#define WRITEB(rb) do { _Pragma("unroll") for (int i = 0; i < 7; ++i) if (i < 6 || ht < 128) *(LAS u32x4*)(lds + SC_Q + (ht + 256 * i) * 16) = rb[i]; } while (0)
        LOADA(ra0, ru0, rd0, 0); WRITEA(ra0, ru0, rd0); LOADA(ra1, ru1, rd1, 1); LOADA(ra0, ru0, rd0, 2); LOADB(rb0, 0);
        const int ei = ht >> 2, ecg = ht & 3;
        const bf16_t* zbase = proj + (size_t)(b * SEQ + ei) * LDP + PZ + h * HD + 32 * ecg;
        if (ht < 32) *(LAS f32x4*)(lds + SC_NW + ht * 16) = *(const f32x4*)(p.norm_w + 4 * ht);
        u32x4 zr0[4];
#pragma unroll
        for (int k = 0; k < 4; ++k) zr0[k] = *(const u32x4*)(zbase + 8 * k);
#define EPILOG(ce) do { \
                const int row = b * SEQ + (ce) * 64 + ei; \
                float ss = 0.f; \
                _Pragma("unroll") for (int k = 0; k < 4; ++k) { float o[8]; unpack8(*(const LAS u32x4*)(lds + SC_OB + ei * 272 + (32 * ecg + 8 * k) * 2), o); \
                    _Pragma("unroll") for (int e = 0; e < 8; ++e) ss += o[e] * o[e]; } \
                ss += __shfl_xor(ss, 1); ss += __shfl_xor(ss, 2); \
                const float rs = rsqrtf(ss * (1.f / 128.f) + NORM_EPS); \
                bf16_t* op = cat + (size_t)row * DM + h * HD + 32 * ecg; \
                _Pragma("unroll") for (int k = 0; k < 4; ++k) { float z[8], o[8]; unpack8(zr0[k], z); unpack8(*(const LAS u32x4*)(lds + SC_OB + ei * 272 + (32 * ecg + 8 * k) * 2), o); float r[8]; \
                    const f32x4 nw0 = *(const LAS f32x4*)(lds + SC_NW + (32 * ecg + 8 * k) * 4), nw1 = *(const LAS f32x4*)(lds + SC_NW + (32 * ecg + 8 * k + 4) * 4); \
                    _Pragma("unroll") for (int e = 0; e < 8; ++e) r[e] = o[e] * rs * (e < 4 ? nw0[e] : nw1[e - 4]) * silu_f(z[e]); \
                    *(bf16x8*)(op + 8 * k) = pack8((f32x4){r[0], r[1], r[2], r[3]}, (f32x4){r[4], r[5], r[6], r[7]}); } } while (0)
#define HSTEP(c, RBX, RAY, RUY, RDY) do { \
            LBAR();                                                                                 \
            WRITEB(RBX); LOADB(RBX, (c) + 1); \
            { const int ce = (c) > 0 ? (c) - 1 : 0; EPILOG(ce); } \
            { _Pragma("unroll") for (int k = 0; k < 4; ++k) zr0[k] = *(const u32x4*)(zbase + (size_t)(c) * 64 * LDP + 8 * k); }     \
            LBAR();                                                                                 \
            WRITEA(RAY, RUY, RDY); LOADA(RAY, RUY, RDY, (c) + 3); \
            } while (0)
#pragma unroll 1
        for (int c2 = 0; c2 < 64; c2 += 2) { HSTEP(c2, rb0, ra1, ru1, rd1); HSTEP(c2 + 1, rb0, ra0, ru0, rd0); }
        __syncthreads();
        EPILOG(63);
#undef HSTEP
#undef EPILOG
#undef LOADA
#undef WRITEA
#undef LOADB
#undef WRITEB
    }
    __syncthreads();
}

namespace fox {
constexpr int D = 128, NW = 8, QBLK = 32, KVBLK = 64, QB = NW * QBLK;
constexpr int SHM_V = KVBLK * D * 2, SHM_K = KVBLK * D * 2;
constexpr int OFF_WS = 2 * SHM_V + 2 * SHM_K, OFF_BIAS = OFF_WS + NW * 64 * 4, OFF_Q = OFF_BIAS + 2 * 64 * 4, LDS_NEED = OFF_Q + NW * 8192;
constexpr float SCALE = 0.08838834764831845f, INV_SCALE = 11.313708498984761f, THR = 8.f;
constexpr int W = SEQ;
#define KSWZ(row, colB) ((row) * 256 + ((colB) ^ (((row) & 7) << 4)))
#define SBAR() __builtin_amdgcn_sched_barrier(0)
__device__ __forceinline__ int v_st(int k, int c) { const int kk = (k & ~0xC) | ((k & 4) << 1) | ((k & 8) >> 1); return ((kk >> 3) * 4 + (c >> 5)) * 512 + ((kk & 7) * 32 + (c & 31)) * 2; }
__device__ __forceinline__ int v_rd_base(int lane) { return ((lane & 3) << 3) | (((lane >> 2) & 3) << 6) | (((lane >> 4) & 1) << 5) | (((lane >> 5) & 1) << 8); }
constexpr int v_rd_off(int d0, int ks, int half) { return d0 * 512 + ks * 4096 + half * 2048; }
__device__ __forceinline__ int crow(int r, int hi) { return (r & 3) + 8 * (r >> 2) + 4 * hi; }
__device__ __forceinline__ void mask_tile(f32x16& p0, f32x16& p1, int dq, unsigned Wm) {
    const float NEG = -__builtin_inff();
#pragma unroll
    for (int r = 0; r < 16; ++r) {
        const int c = (r & 3) + 8 * (r >> 2);
        if ((unsigned)(dq - c) >= Wm) p0[r] = NEG;
        if ((unsigned)(dq - c - 32) >= Wm) p1[r] = NEG;
    }
}
__device__ __forceinline__ void partialSM(f32x16& p0, f32x16& p1, float& m_reg, float& mn, float& alpha) {
    float pmax = p0[0]; for (int r = 1; r < 16; ++r) pmax = fmaxf(pmax, p0[r]); for (int r = 0; r < 16; ++r) pmax = fmaxf(pmax, p1[r]);
    { auto rr = __builtin_amdgcn_permlane32_swap(__float_as_uint(pmax), __float_as_uint(pmax), false, false);
      pmax = fmaxf(__uint_as_float(rr[0]), __uint_as_float(rr[1])); }
    constexpr float C2 = 1.4426950408889634f * SCALE;
    if (__builtin_expect(__all((pmax - m_reg) * SCALE <= THR), 1)) { mn = m_reg; alpha = 1.f; }
    else { mn = fmaxf(m_reg, pmax); alpha = __builtin_amdgcn_exp2f((m_reg - mn) * C2); m_reg = mn; }
    const float mnL = -mn * C2;
    for (int r = 0; r < 16; ++r) p0[r] = fmaf(p0[r], C2, mnL); for (int r = 0; r < 16; ++r) p1[r] = fmaf(p1[r], C2, mnL);
    for (int r = 0; r < 16; ++r) p0[r] = __builtin_amdgcn_exp2f(p0[r]);
}
__device__ __forceinline__ void finishSM(f32x16& p0, f32x16& p1, float alpha, float& l_reg, bf16x8& pa0, bf16x8& pa1, bf16x8& pa2, bf16x8& pa3) {
    for (int r = 0; r < 16; ++r) p1[r] = __builtin_amdgcn_exp2f(p1[r]);
    float ps = 0; for (int r = 0; r < 16; ++r) ps += p0[r]; for (int r = 0; r < 16; ++r) ps += p1[r];
    { auto rr = __builtin_amdgcn_permlane32_swap(__float_as_uint(ps), __float_as_uint(ps), false, false);
      ps = __uint_as_float(rr[0]) + __uint_as_float(rr[1]); }
    l_reg = l_reg * alpha + ps;
#define PK4(P, B_, OUT) do { unsigned a0 = cvtpk(P[B_+0], P[B_+1]), a1 = cvtpk(P[B_+2], P[B_+3]);                          \
        unsigned b0 = cvtpk(P[B_+4], P[B_+5]), b1 = cvtpk(P[B_+6], P[B_+7]);                                             \
        auto r0 = __builtin_amdgcn_permlane32_swap(a0, b0, false, false); auto r1 = __builtin_amdgcn_permlane32_swap(a1, b1, false, false); \
        u32x4 w = {r0[0], r1[0], r0[1], r1[1]}; OUT = *reinterpret_cast<bf16x8*>(&w); } while (0)
    PK4(p0, 0, pa0); PK4(p0, 8, pa1); PK4(p1, 0, pa2); PK4(p1, 8, pa3);
#undef PK4
}
template <int KB>
__device__ __forceinline__ void qkt(f32x16& p0, f32x16& p1, const char* K_lds, const char* bias_lds, int r32, int hi, const char* qf) {
    const char* bb = bias_lds + KB * 256 + hi * 16;
#pragma unroll
    for (int g = 0; g < 4; ++g) { const f32x4 b0 = *reinterpret_cast<const f32x4*>(bb + g * 32), b1 = *reinterpret_cast<const f32x4*>(bb + 128 + g * 32);
        p0[4 * g] = b0[0]; p0[4 * g + 1] = b0[1]; p0[4 * g + 2] = b0[2]; p0[4 * g + 3] = b0[3];
        p1[4 * g] = b1[0]; p1[4 * g + 1] = b1[1]; p1[4 * g + 2] = b1[2]; p1[4 * g + 3] = b1[3]; }
    const char* kb[4];
#pragma unroll
    for (int dd = 0; dd < 4; ++dd) kb[dd] = K_lds + KB * SHM_K + KSWZ(r32, (dd * 16 + hi * 8) * 2);
#pragma unroll
    for (int d0 = 0; d0 < 8; ++d0) { const char* a = kb[d0 & 3] + (d0 >> 2) * 128;
        bf16x8 b0 = *reinterpret_cast<const bf16x8*>(a);
        bf16x8 b1 = *reinterpret_cast<const bf16x8*>(a + 32 * 256);
        const bf16x8 q = *reinterpret_cast<const bf16x8*>(qf + d0 * 1024);
        p0 = __builtin_amdgcn_mfma_f32_32x32x16_bf16(b0, q, p0, 0, 0, 0);
        p1 = __builtin_amdgcn_mfma_f32_32x32x16_bf16(b1, q, p1, 0, 0, 0); }
}
template <int VB>
__device__ __forceinline__ void pv_tile(f32x16* o, int vb0, bf16x8 pa0, bf16x8 pa1, bf16x8 pa2, bf16x8 pa3) {
    s16x4 ra[4], rb[4];
#define PV_RD(dst, hb) do { constexpr int b_ = VB * SHM_V + v_rd_off((hb) >> 1, 0, 0) + ((hb) & 1) * 8192; \
        TRRD(dst[0], vb0, b_); TRRD(dst[1], vb0, b_ + 2048); TRRD(dst[2], vb0, b_ + 4096); TRRD(dst[3], vb0, b_ + 6144); } while (0)
#define PV_MM(src, hb) do { \
        o[(hb) >> 1] = __builtin_amdgcn_mfma_f32_32x32x16_bf16(((hb) & 1) ? pa2 : pa0, join8(src[0], src[1]), o[(hb) >> 1], 0, 0, 0); \
        o[(hb) >> 1] = __builtin_amdgcn_mfma_f32_32x32x16_bf16(((hb) & 1) ? pa3 : pa1, join8(src[2], src[3]), o[(hb) >> 1], 0, 0, 0); } while (0)
#define PV_W4() do { asm volatile("s_waitcnt lgkmcnt(4)" ::: "memory"); SBAR(); } while (0)
#define PV_W0() do { asm volatile("s_waitcnt lgkmcnt(0)" ::: "memory"); SBAR(); } while (0)
    PV_RD(ra, 0);
    PV_RD(rb, 1); PV_W4(); PV_MM(ra, 0); SBAR();
    PV_RD(ra, 2); PV_W4(); PV_MM(rb, 1); SBAR();
    PV_RD(rb, 3); PV_W4(); PV_MM(ra, 2); SBAR();
    PV_RD(ra, 4); PV_W4(); PV_MM(rb, 3); SBAR();
    PV_RD(rb, 5); PV_W4(); PV_MM(ra, 4); SBAR();
    PV_RD(ra, 6); PV_W4(); PV_MM(rb, 5); SBAR();
    PV_RD(rb, 7); PV_W4(); PV_MM(ra, 6); SBAR();
    PV_W0(); PV_MM(rb, 7);
#undef PV_RD
#undef PV_MM
#undef PV_W4
#undef PV_W0
}
struct BlockRef { int bh, qb, jlo; };
__device__ __forceinline__ const bf16_t* ref_Q(unsigned char* ws, BlockRef r) { return (const bf16_t*)(ws + WS_PROJ) + (size_t)((r.bh >> 3) * SEQ + r.qb * QB) * LDP + FQ + (r.bh & 7) * HD; }
__device__ __forceinline__ const bf16_t* ref_K(unsigned char* ws, BlockRef r) { return (const bf16_t*)(ws + WS_PROJ) + (size_t)((r.bh >> 3) * SEQ) * LDP + FK + (r.bh & 7) * HD; }
__device__ __forceinline__ bf16_t* ref_O(unsigned char* ws, BlockRef r) { return (bf16_t*)(ws + WS_HBUF) + (size_t)((r.bh >> 3) * SEQ + r.qb * QB) * DM + 1024 + (r.bh & 7) * HD; }
__device__ __forceinline__ const float* ref_F(unsigned char* ws, BlockRef r) { return (const float*)(ws + WS_FCUM) + (size_t)r.bh * SEQ; }
struct Seam { bf16x8 qr[8]; bf16x8 st_v0, st_v1, st_k0, st_k1; };
#define ROW(p_, k0, rr) ((p_) + (unsigned)(((k0) + (rr)) * LDP + sc))
#define VMWN(n) asm volatile("s_waitcnt vmcnt(%0)" :: "i"(n) : "memory")
#define LD8(ptr) (*reinterpret_cast<const bf16x8*>(ptr))
#define SLOAD_H(Kp, Vp, Fp, k0, bf) do { const bf16_t* r0_ = ROW(Kp, k0, sr); const bf16_t* r1_ = ROW(Kp, k0, 32 + sr);             \
                         S.st_v0 = LD8(r0_ + (FV - FK)); S.st_v1 = LD8(r1_ + (FV - FK)); S.st_k0 = LD8(r0_); S.st_k1 = LD8(r1_); \
                         if (wid == 0) __builtin_amdgcn_global_load_lds((const unsigned*)((Fp) + (k0) + lane), (LAS unsigned*)(lds_las + OFF_BIAS + (bf) * 256), 4, 0, 0); } while (0)
#define SWRITE_HK(bf) do { *(bf16x8*)(K_lds + (bf) * SHM_K + kws) = S.st_k0; *(bf16x8*)(K_lds + (bf) * SHM_K + kws + 32 * 256) = S.st_k1; } while (0)
#define SWRITE_HV(bf) do { *(bf16x8*)(V_lds + (bf) * SHM_V + vst0) = S.st_v0; *(bf16x8*)(V_lds + (bf) * SHM_V + vst1) = S.st_v1; } while (0)
#define SWRITE_H(bf) do { SWRITE_HV(bf); SWRITE_HK(bf); } while (0)
__device__ __forceinline__ void prime(unsigned char* wsb, const BlockRef cur, char* lds, LAS unsigned char* lds_las, Seam& S, int wv) {
    const int wid = wv, lane = lane_id(), tid = wid * 64 + lane, r32 = lane & 31, hi = lane >> 5;
    const int sr = tid >> 4, sc = (tid & 15) * 8, kws = KSWZ(sr, sc * 2); char* K_lds = lds + 2 * SHM_V; char* bias_lds = lds + OFF_BIAS;
    { const bf16_t* q_ = ref_Q(wsb, cur); for (int d0 = 0; d0 < 8; ++d0) S.qr[d0] = LD8(q_ + (unsigned)((wid * QBLK + r32) * LDP + d0 * 16 + hi * 8)); }
    SLOAD_H(ref_K(wsb, cur), 0, ref_F(wsb, cur), cur.jlo * KVBLK, 0); VM0(); SWRITE_HK(0);
    for (int d0 = 0; d0 < 8; ++d0) *(bf16x8*)(lds + OFF_Q + wid * 8192 + d0 * 1024 + lane * 16) = S.qr[d0];
    __syncthreads();
}
__device__ __forceinline__ void block(unsigned char* wsb, const BlockRef cur, const BlockRef nxt, char* lds, LAS unsigned char* lds_las, Seam& S, int wv) {
    const int wid = wv, lane = lane_id(), tid = wid * 64 + lane, r32 = lane & 31, hi = lane >> 5;
    const int P0 = cur.qb * QB;
    const int j_hi = (P0 + QB - 1) / KVBLK + 1, j_lo = cur.jlo;
    const int NT = j_hi - j_lo;
    const int qlo = P0 + wid * QBLK, qm = qlo + r32 - 4 * hi;
    char* V_lds = lds; char* K_lds = lds + 2 * SHM_V; char* bias_lds = lds + OFF_BIAS; const char* qf = lds + OFF_Q + wid * 8192 + lane * 16;
    float* ws = (float*)(lds + OFF_WS) + wid * 64; float* li_l = ws, * al_l = ws + 32;
    float m_reg = -1e30f, l_reg = 0; f32x16 o[4] = {};
    const int sr = tid >> 4, sc = (tid & 15) * 8, vst0 = v_st(sr, sc), vst1 = v_st(32 + sr, sc), kws = KSWZ(sr, sc * 2);
    const int vb0 = (int)(uintptr_t)V_lds + v_rd_base(lane);
    const bf16_t* Kh = ref_K(wsb, cur); const float* Fh = ref_F(wsb, cur);
#define RESC(a) do { if (__any((a) < 1.f)) { if (hi == 0) al_l[r32] = (a); asm volatile("s_waitcnt lgkmcnt(0)" ::: "memory");              \
                     for (int d_ = 0; d_ < 4; ++d_) for (int r = 0; r < 16; ++r) o[d_][r] *= al_l[crow(r, hi)]; } } while (0)
#define KBASE(t) ((j_lo + (t)) * KVBLK)
#define MASKT(P0_, P1_, t) do { const int kb_ = KBASE(t); if (kb_ + KVBLK - 1 > qlo) mask_tile(P0_, P1_, qm - kb_, (unsigned)W); } while (0)
    constexpr int NQL = 8;
#define SEAM_K0() do { VMWN(NQL); SWRITE_HK(0); SBAR(); } while (0)
    f32x16 pA0, pA1, pB0, pB1; float mnA, mnB, alA, alB; bf16x8 pa0, pa1, pa2, pa3;
    SWRITE_HV(0); SBAR();
    if (NT > 1) { SLOAD_H(Kh, 0, Fh, KBASE(1), 1); }
    SBAR(); qkt<0>(pA0, pA1, K_lds, bias_lds, r32, hi, qf);
    MASKT(pA0, pA1, 0); partialSM(pA0, pA1, m_reg, mnA, alA);
    if (NT > 1) { VM0(); SWRITE_H(1); }
    __syncthreads();
#define HALF_STEP(PX0, PX1, mnX, alX, PY0, PY1, alY, t, KB, VB, SB) do {                                                      \
        SBAR(); qkt<KB>(PX0, PX1, K_lds, bias_lds, r32, hi, qf);                                             \
        finishSM(PY0, PY1, alY, l_reg, pa0, pa1, pa2, pa3); SBAR();                                                           \
        if ((t) + 1 < NT) { SLOAD_H(Kh, 0, Fh, KBASE((t) + 1), SB); SBAR(); }                                               \
        pv_tile<VB>(o, vb0, pa0, pa1, pa2, pa3); MASKT(PX0, PX1, (t)); partialSM(PX0, PX1, m_reg, mnX, alX);                                        \
        __syncthreads();                                                                                                      \
        if ((t) + 1 < NT) { VM0(); SWRITE_H(SB); }                                                                          \
        RESC(alX); __syncthreads(); } while (0)
    for (int t = 1; t + 1 < NT; t += 2) {
        HALF_STEP(pB0, pB1, mnB, alB, pA0, pA1, alA, t, 1, 0, 0);
        HALF_STEP(pA0, pA1, mnA, alA, pB0, pB1, alB, t + 1, 0, 1, 1);
    }
    const bool even = (NT & 1) == 0;
    if (even) { SBAR(); qkt<1>(pB0, pB1, K_lds, bias_lds, r32, hi, qf); SBAR(); }
    SLOAD_H(ref_K(wsb, nxt), 0, ref_F(wsb, nxt), nxt.jlo * KVBLK, 0); SBAR();
    { const bf16_t* q_ = ref_Q(wsb, nxt);
#pragma unroll
    for (int d0 = 0; d0 < 8; ++d0) S.qr[d0] = LD8(q_ + (unsigned)((wid * QBLK + r32) * LDP + d0 * 16 + hi * 8)); }
    SBAR();
    finishSM(pA0, pA1, alA, l_reg, pa0, pa1, pa2, pa3); SBAR();
    pv_tile<0>(o, vb0, pa0, pa1, pa2, pa3);
    if (even) { MASKT(pB0, pB1, NT - 1); partialSM(pB0, pB1, m_reg, mnB, alB); __syncthreads(); RESC(alB);
        finishSM(pB0, pB1, alB, l_reg, pa0, pa1, pa2, pa3); SBAR(); pv_tile<1>(o, vb0, pa0, pa1, pa2, pa3); }
    SBAR(); SEAM_K0();
    if (hi == 0) li_l[r32] = l_reg; asm volatile("s_waitcnt lgkmcnt(0)" ::: "memory");
    float rli[16];
#pragma unroll
    for (int r = 0; r < 16; ++r) rli[r] = __builtin_amdgcn_rcpf(li_l[crow(r, hi)]);
    bf16_t* Ow = ref_O(wsb, cur) + (size_t)(wid * QBLK) * DM;
#pragma unroll
    for (int r = 0; r < 16; ++r) { const int orow = crow(r, hi);
#pragma unroll
        for (int d0 = 0; d0 < 4; ++d0) { const float v = o[d0][r] * rli[r];
            const float vn = __shfl_xor(v, 1);
            if ((r32 & 1) == 0) *(unsigned*)(Ow + (unsigned)(orow * DM + d0 * 32 + r32)) = cvtpk(v, vn); } }
#pragma unroll
    for (int d0 = 0; d0 < 8; ++d0) *(bf16x8*)(lds + OFF_Q + wid * 8192 + d0 * 1024 + lane * 16) = S.qr[d0];
    __syncthreads();
#undef RESC
#undef KBASE
#undef MASKT
#undef SEAM_K0
#undef HALF_STEP
}
#undef ROW
#undef VMWN
#undef SLOAD_H
#undef SWRITE_HK
#undef SWRITE_HV
#undef SWRITE_H
#undef LD8
}

__device__ __forceinline__ int attn_pull(unsigned* qbase, int& qx, int x0, bool& dead) {
    if (dead) return -1;
    for (;;) {
        const int k = (int)__hip_atomic_fetch_add(qbase + 64 * qx, 1u, __ATOMIC_RELAXED, __HIP_MEMORY_SCOPE_AGENT);
        if (k < 128) return qx * 128 + k;
        qx = (qx + 1) & 7; if (qx == x0) { dead = true; return -1; }
    }
}
__device__ __forceinline__ int fox_jlo(const Params& p, int bh, int qb, int lane) {
    const float* Bv = (const float*)(p.ws + WS_FCUM) + (size_t)bh * SEQ;
    const unsigned* mx = (const unsigned*)(p.ws + WS_CTL) + CW_QKMAX + 2 * bh;
    const float q2 = __uint_as_float(__hip_atomic_load(mx, __ATOMIC_RELAXED, __HIP_MEMORY_SCOPE_AGENT)), k2 = __uint_as_float(__hip_atomic_load(mx + 1, __ATOMIC_RELAXED, __HIP_MEMORY_SCOPE_AGENT));
    const float thr = (26.f + 2.f * fox::SCALE * sqrtf(q2 * k2) * 1.01f) * fox::INV_SCALE;
    const float b1 = Bv[64 * lane + 63], b0 = Bv[qb * fox::QB];
    const unsigned long long m = __ballot(b1 < b0 - thr);
    return __builtin_popcountll(m);
}
__device__ __forceinline__ fox::BlockRef attn_ref(const Params& p, int item, int lane) { fox::BlockRef r; const int x = item >> 7, k = item & 127; r.bh = 8 * x + (k & 7); r.qb = 15 - (k >> 3);
    r.jlo = __builtin_amdgcn_readfirstlane(fox_jlo(p, r.bh, r.qb, lane)); return r; }
__device__ __forceinline__ void p4_attention(const Params& p, const Frame& F, char* lds_generic) {
    using namespace fox;
    unsigned* qbase = (unsigned*)(p.ws + WS_CTL) + CW_QUEUE;
    volatile LAS int* qslot = (volatile LAS int*)(F.lds + LDS_MISC + 64);
    const int x0 = (int)(xb_xcc_id() & 7u); int qx = x0; bool dead = false;
    if (F.tid == 0) { qslot[0] = attn_pull(qbase, qx, x0, dead); qslot[1] = attn_pull(qbase, qx, x0, dead); }
    __syncthreads();
    int L = qslot[0], Ln = qslot[1];
    if (L < 0) { __syncthreads(); return; }
    BlockRef cur = attn_ref(p, L, F.lane);
    Seam S;
    prime(p.ws, cur, lds_generic, F.lds, S, F.wave);
    for (int it = 0;; ++it) {
        const bool last = Ln < 0;
        const BlockRef nxt = last ? cur : attn_ref(p, Ln, F.lane);
        if (F.tid == 0) qslot[it & 1] = attn_pull(qbase, qx, x0, dead);
        block(p.ws, cur, nxt, lds_generic, F.lds, S, F.wave);
        if (last) break;
        cur = nxt; L = Ln; Ln = qslot[it & 1];
    }
    __syncthreads();
}

constexpr int L1_G1P = 0, L1_LNG = 8192, L1_LNB = 16384, L1_SC2P = 24576, L1_SH2 = 32768, L1_LG = 40960;
__device__ __forceinline__ void p6_ln1_router(const Params& p, const Frame& F) {
    const float* mod = (const float*)(p.ws + WS_MOD); const bf16_t* y1 = (const bf16_t*)(p.ws + WS_Y1); bf16_t* x1 = (bf16_t*)(p.ws + WS_X1); bf16_t* h2 = (bf16_t*)(p.ws + WS_H2);
    const bf16_t* rw = (const bf16_t*)(p.ws + WS_RTW); unsigned char* h2f8 = p.ws + WS_H2F8;
    unsigned* cnt = (unsigned*)(p.ws + WS_CTL) + CW_CNT;
    int* rt_e = (int*)(p.ws + WS_RT + RT_E); float* rt_w = (float*)(p.ws + WS_RT + RT_W); int* rt_pos = (int*)(p.ws + WS_RT + RT_POS); int* elist = (int*)(p.ws + WS_ELIST);
    LAS float* lg = (LAS float*)(F.lds + L1_LG + F.wave * 4096);
    const int fr = F.lane & 15, fq = F.lane >> 4;
    int bcur = -1;
    for (int g0 = F.bid; g0 < NTOK / 128; g0 += F.G) {
        const int b = (g0 * 128) / SEQ;
        if (b != bcur) { __syncthreads(); bcur = b; const float* mb = mod + (size_t)b * (6 * DM);
            for (unsigned i = (unsigned)F.tid; i < (unsigned)DM; i += 512u) { LAS float* L = (LAS float*)F.lds; const float* m2 = mb + 2 * DM; const float* m3 = mb + 3 * DM; const float* m4 = mb + 4 * DM;
                L[L1_G1P / 4 + i] = 1.f + m2[i]; L[L1_LNG / 4 + i] = p.ln1_g[i]; L[L1_LNB / 4 + i] = p.ln1_b[i]; L[L1_SC2P / 4 + i] = 1.f + m4[i]; L[L1_SH2 / 4 + i] = m3[i]; }
            __syncthreads(); }
        const int row0 = g0 * 128 + F.wave * 16;
#pragma unroll 1
        for (int pr = 0; pr < 8; ++pr) {
            f32x4 xa[2][8]; u32x4 ya[2][4];
#pragma unroll
            for (int r = 0; r < 2; ++r)
#pragma unroll
                for (int i = 0; i < 4; ++i) { const size_t o = (size_t)(row0 + 2 * pr + r) * DM + i * 512 + F.lane * 8;
                    xa[r][2 * i] = __builtin_nontemporal_load((const f32x4*)(p.x + o)); xa[r][2 * i + 1] = __builtin_nontemporal_load((const f32x4*)(p.x + o + 4)); ya[r][i] = *(const u32x4*)(y1 + o); }
#pragma unroll
            for (int r = 0; r < 2; ++r) {
                float v[32]; float s = 0.f;
#pragma unroll
                for (int i = 0; i < 4; ++i) { const int col = i * 512 + F.lane * 8; float yf[8]; unpack8(ya[r][i], yf);
                    const f32x4 ga = *(const LAS f32x4*)(F.lds + L1_G1P + col * 4), gb = *(const LAS f32x4*)(F.lds + L1_G1P + col * 4 + 16);
#pragma unroll
                    for (int e = 0; e < 4; ++e) { v[i * 8 + e] = ALPHA * xa[r][2 * i][e] + ga[e] * yf[e]; v[i * 8 + 4 + e] = ALPHA * xa[r][2 * i + 1][e] + gb[e] * yf[4 + e]; }
#pragma unroll
                    for (int e = 0; e < 8; ++e) s += v[i * 8 + e]; }
                const float mean = wave_sum(s) * (1.f / DM);
                float q = 0.f;
#pragma unroll
                for (int k = 0; k < 32; ++k) { const float d = v[k] - mean; q += d * d; }
                const float rstd = rsqrtf(wave_sum(q) * (1.f / DM) + LN_EPS);
#pragma unroll
                for (int i = 0; i < 4; ++i) { const int col = i * 512 + F.lane * 8; const size_t o = (size_t)(row0 + 2 * pr + r) * DM + col;
                    const f32x4 g0v = *(const LAS f32x4*)(F.lds + L1_LNG + col * 4), g1v = *(const LAS f32x4*)(F.lds + L1_LNG + col * 4 + 16), b0 = *(const LAS f32x4*)(F.lds + L1_LNB + col * 4), b1 = *(const LAS f32x4*)(F.lds + L1_LNB + col * 4 + 16);
                    const f32x4 c0 = *(const LAS f32x4*)(F.lds + L1_SC2P + col * 4), c1 = *(const LAS f32x4*)(F.lds + L1_SC2P + col * 4 + 16), s0 = *(const LAS f32x4*)(F.lds + L1_SH2 + col * 4), s1 = *(const LAS f32x4*)(F.lds + L1_SH2 + col * 4 + 16);
                    f32x4 o0, o1, h0, h1;
#pragma unroll
                    for (int e = 0; e < 4; ++e) { o0[e] = (v[i * 8 + e] - mean) * rstd * g0v[e] + b0[e]; o1[e] = (v[i * 8 + 4 + e] - mean) * rstd * g1v[e] + b1[e];
                        h0[e] = o0[e] * c0[e] + s0[e]; h1[e] = o1[e] * c1[e] + s1[e]; }
                    __builtin_nontemporal_store(pack8(o0, o1), (bf16x8*)(x1 + o));
                    *(bf16x8*)(h2 + o) = pack8(h0, h1); }
                __builtin_amdgcn_sched_barrier(0);
            }
        }
        VM0();
        f32x4 acc[3]; acc[0] = acc[1] = acc[2] = (f32x4){0.f, 0.f, 0.f, 0.f};
        const bf16_t* ar = h2 + (size_t)(row0 + fr) * DM + 8 * fq;
#pragma unroll 2
        for (int s_ = 0; s_ < 64; ++s_) {
            const bf16x8 a = *(const bf16x8*)(ar + 32 * s_);
            { float af[8]; unpack8(*reinterpret_cast<const u32x4*>(&a), af);
              *(u32x2*)(h2f8 + (unsigned)((row0 + fr) * DM + 32 * s_ + 8 * fq)) = (u32x2){pack_fp8x4(af[0], af[1], af[2], af[3]), pack_fp8x4(af[4], af[5], af[6], af[7])}; }
#pragma unroll
            for (int ct = 0; ct < 3; ++ct) { const bf16_t* bp = rw + (size_t)(16 * ct + fr) * DM + 32 * s_ + 8 * fq;
                acc[ct] = mfma16(a, *(const bf16x8*)bp, acc[ct]); acc[ct] = mfma16(a, *(const bf16x8*)(bp + 48 * DM), acc[ct]); }
        }
#pragma unroll
        for (int ct = 0; ct < 3; ++ct)
#pragma unroll
            for (int j = 0; j < 4; ++j) lg[(4 * fq + j) * 48 + 16 * ct + fr] = acc[ct][j];
        asm volatile("s_waitcnt lgkmcnt(0)" ::: "memory");
        if (F.lane < 16) {
            const int t = row0 + F.lane; const LAS float* l = lg + F.lane * 48;
            float gl[4];
#pragma unroll
            for (int g = 0; g < 4; ++g) gl[g] = l[g] + p.b_rg[g];
            float gm = gl[0]; int gi = 0;
#pragma unroll
            for (int g = 1; g < 4; ++g) if (gl[g] > gm) { gm = gl[g]; gi = g; }
            float gs = 0.f;
#pragma unroll
            for (int g = 0; g < 4; ++g) gs += __expf(gl[g] - gm);
            const float gw = 1.f / gs;
            float el[8];
#pragma unroll
            for (int e = 0; e < 8; ++e) el[e] = l[4 + 8 * gi + e] + p.b_re[8 * gi + e];
            float m0 = el[0]; int e0 = 0;
#pragma unroll
            for (int e = 1; e < 8; ++e) if (el[e] > m0) { m0 = el[e]; e0 = e; }
            float m1 = -__builtin_inff(); int e1 = 0;
#pragma unroll
            for (int e = 0; e < 8; ++e) if (e != e0 && el[e] > m1) { m1 = el[e]; e1 = e; }
            const float p1 = __expf(m1 - m0); const float w0 = gw / (1.f + p1), w1 = gw * p1 / (1.f + p1);
            const int x0 = 8 * gi + e0, x1i = 8 * gi + e1;
            const unsigned q0 = atomicAdd(cnt + x0, 1u), q1 = atomicAdd(cnt + x1i, 1u);
            rt_e[2 * t] = x0; rt_e[2 * t + 1] = x1i; rt_w[2 * t] = w0; rt_w[2 * t + 1] = w1; rt_pos[2 * t] = (int)q0; rt_pos[2 * t + 1] = (int)q1;
            elist[(unsigned)x0 * (unsigned)NTOK + q0] = t; elist[(unsigned)x1i * (unsigned)NTOK + q1] = t;
        }
    }
    __syncthreads();
}
__device__ __forceinline__ void slot_prefix(const Params& p, const Frame& F, LAS int* ps) {
    if (F.tid == 0) { const unsigned* cnt = (const unsigned*)(p.ws + WS_CTL) + CW_CNT; int run = 0;
        for (int e = 0; e < NEXP; ++e) { const int c = (int)__hip_atomic_load(cnt + e, __ATOMIC_RELAXED, __HIP_MEMORY_SCOPE_AGENT); ps[e] = run; ps[32 + e] = c; run += (c + 255) / 256 * 256; } ps[64] = run; }
}
constexpr int L2_G2P = 0, L2_LNG = 8192, L2_LNB = 16384, L2_PS = 24576;
__device__ __forceinline__ void p11_final(const Params& p, const Frame& F) {
    const float* mod = (const float*)(p.ws + WS_MOD); const bf16_t* x1 = (const bf16_t*)(p.ws + WS_X1); const unsigned char* yb = p.ws + WS_YB; const int* rt_e = (const int*)(p.ws + WS_RT + RT_E); const int* rt_pos = (const int*)(p.ws + WS_RT + RT_POS); const float* rt_w = (const float*)(p.ws + WS_RT + RT_W);
    LAS int* ps = (LAS int*)(F.lds + L2_PS);
    slot_prefix(p, F, ps);
    int bcur = -1;
    for (int g0 = F.bid; g0 < NTOK / 128; g0 += F.G) {
        const int b = (g0 * 128) / SEQ;
        if (b != bcur) { __syncthreads(); bcur = b; const float* mb = mod + (size_t)b * (6 * DM);
            for (unsigned i = (unsigned)F.tid; i < (unsigned)DM; i += 512u) { LAS float* L = (LAS float*)F.lds; const float* m5 = mb + 5 * DM; L[L2_G2P / 4 + i] = 1.f + m5[i]; L[L2_LNG / 4 + i] = p.ln2_g[i]; L[L2_LNB / 4 + i] = p.ln2_b[i]; }
            __syncthreads(); }
        const int row0 = g0 * 128 + F.wave * 16;
#pragma unroll 1
        for (int pr = 0; pr < 8; ++pr) {
            u32x4 xv[2][4]; u32x2 ya[2][4], yc[2][4]; float wa[2], wc[2];
#pragma unroll
            for (int r = 0; r < 2; ++r) { const int row = row0 + 2 * pr + r; const int sa = ps[rt_e[2 * row]] + rt_pos[2 * row], sb = ps[rt_e[2 * row + 1]] + rt_pos[2 * row + 1]; wa[r] = rt_w[2 * row] * Y8_INV; wc[r] = rt_w[2 * row + 1] * Y8_INV;
#pragma unroll
                for (int i = 0; i < 4; ++i) { const int col = i * 512 + F.lane * 8;
                    xv[r][i] = *(const u32x4*)(x1 + (size_t)row * DM + col); ya[r][i] = *(const u32x2*)(yb + (size_t)sa * DM + col); yc[r][i] = *(const u32x2*)(yb + (size_t)sb * DM + col); } }
#pragma unroll
            for (int r = 0; r < 2; ++r) { const int row = row0 + 2 * pr + r;
                float v[32]; float s = 0.f;
#pragma unroll
                for (int i = 0; i < 4; ++i) { const int col = i * 512 + F.lane * 8; float xf[8], yf[8], zf[8]; unpack8(xv[r][i], xf); unpack8_fp8(ya[r][i], yf); unpack8_fp8(yc[r][i], zf);
                    const f32x4 ga = *(const LAS f32x4*)(F.lds + L2_G2P + col * 4), gb = *(const LAS f32x4*)(F.lds + L2_G2P + col * 4 + 16);
#pragma unroll
                    for (int e = 0; e < 4; ++e) { v[i * 8 + e] = ALPHA * xf[e] + ga[e] * (wa[r] * yf[e] + wc[r] * zf[e]); v[i * 8 + 4 + e] = ALPHA * xf[4 + e] + gb[e] * (wa[r] * yf[4 + e] + wc[r] * zf[4 + e]); }
#pragma unroll
                    for (int e = 0; e < 8; ++e) s += v[i * 8 + e]; }
                const float mean = wave_sum(s) * (1.f / DM);
                float q = 0.f;
#pragma unroll
                for (int k = 0; k < 32; ++k) { const float d = v[k] - mean; q += d * d; }
                const float rstd = rsqrtf(wave_sum(q) * (1.f / DM) + LN_EPS);
#pragma unroll
                for (int i = 0; i < 4; ++i) { const int col = i * 512 + F.lane * 8;
                    const f32x4 g0v = *(const LAS f32x4*)(F.lds + L2_LNG + col * 4), g1v = *(const LAS f32x4*)(F.lds + L2_LNG + col * 4 + 16), b0 = *(const LAS f32x4*)(F.lds + L2_LNB + col * 4), b1 = *(const LAS f32x4*)(F.lds + L2_LNB + col * 4 + 16);
                    f32x4 o0, o1;
#pragma unroll
                    for (int e = 0; e < 4; ++e) { o0[e] = (v[i * 8 + e] - mean) * rstd * g0v[e] + b0[e]; o1[e] = (v[i * 8 + 4 + e] - mean) * rstd * g1v[e] + b1[e]; }
                    __builtin_nontemporal_store(o0, (f32x4*)(p.out + (size_t)row * DM + col)); __builtin_nontemporal_store(o1, (f32x4*)(p.out + (size_t)row * DM + col + 4)); }
                __builtin_amdgcn_sched_barrier(0);
            }
        }
    }
    __syncthreads();
}

typedef const __attribute__((address_space(4))) Params* kparams_t;
__device__ __forceinline__ Params load_params() {
#if defined(__HIP_DEVICE_COMPILE__)
    kparams_t pp = (kparams_t)__builtin_amdgcn_kernarg_segment_ptr(); asm volatile("" : "+s"(pp)); return *pp;
#else
    return Params{};
#endif
}
__device__ __forceinline__ Frame make_frame(unsigned char* lds_raw, int wv) {
    Frame F; F.lds = (LAS unsigned char*)lds_raw; F.lane = lane_id(); F.wave = wv; F.tid = wv * 64 + F.lane; F.G = gridDim.x; F.bid = blockIdx.x; return F;
}
constexpr int MOE_TL = 320, MOE_GI = 448;
template <bool TOK> __device__ __forceinline__ LAS int* moe_tables(const Params& p, const Frame& F, int& ntiles, int ntl) {
    LAS int* tl = (LAS int*)(F.lds + pg8::STAGE_BYTES); LAS int* ps = tl + MOE_TL;
    slot_prefix(p, F, ps);
    __syncthreads();
    ntiles = ps[64] / 256;
    for (int i = F.tid; i < ntiles; i += 512) { int e = 0;
#pragma unroll 1
        for (int x = 1; x < NEXP; ++x) if (ps[x] <= 256 * i) e = x;
        tl[i] = e; }
    __syncthreads();
    if constexpr (TOK) { const int* elist = (const int*)(p.ws + WS_ELIST);
        for (int u = 0; u < 24; ++u) { const int L = u * F.G + F.bid; if (L >= ntiles * ntl) break;
            if (F.tid < 256) { const int t = L / ntl, e = tl[t], pos = 256 * t - ps[e] + F.tid; tl[MOE_GI + u * 256 + F.tid] = pos < ps[32 + e] ? elist[(unsigned)e * (unsigned)NTOK + (unsigned)pos] : 0; } }
        __syncthreads(); }
    return tl;
}
template <unsigned MASK> __global__ void __launch_bounds__(512, 2) fwd(Params p_unused) {
    extern __shared__ __attribute__((aligned(16))) unsigned char lds_raw[];
    volatile LAS unsigned* misc = (volatile LAS unsigned*)((LAS unsigned char*)lds_raw + LDS_MISC);
    const int wv = __builtin_amdgcn_readfirstlane((int)threadIdx.x >> 6);
    __builtin_assume(wv >= 0 && wv < 8);
    if (wv == 0) misc[lane_id()] = 0u;
    __syncthreads();
    int lo, hi; unsigned* barw;
    { const Params p = load_params(); lo = p.ph_lo; hi = p.ph_hi; barw = (unsigned*)(p.ws + WS_CTL); }
    XcdBarrier bar; bar.bar = barw; bar.x = 0; bar.st = misc;
    bar.wv = wv;
    if (hi - lo > 1) bar = xcd_barrier_post(barw, misc, wv);
#define IN(k) (((MASK >> (k)) & 1u) && lo <= (k) && (k) < hi)
#define SEAM(k) do { if (IN(k) && IN((k) + 1)) xcd_barrier(bar); } while (0)
#ifndef PROBE_REP
#define PROBE_REP 0u
#endif
#define PHASE(k, ...) if (IN(k)) __VA_ARGS__ if (((PROBE_REP >> (k)) & 1u) && IN(k)) { xcd_barrier(bar); __VA_ARGS__ } SEAM(k);
    PHASE(0, { const Params p = load_params(); const Frame F = make_frame(lds_raw, wv); p0_prologue(p, F); })
    PHASE(1, { const Params p = load_params(); const Frame F = make_frame(lds_raw, wv); p1_hpass(p, F); })
    PHASE(2, { const Params p = load_params(); const Frame F = make_frame(lds_raw, wv); pg8::Gemm g{(const bf16_t*)(p.ws + WS_HBUF), (const bf16_t*)(p.ws + WS_WIN), NTOK, LDP, DM}; pg8::StaticOrder S; S.init(NTOK, LDP, F.G, F.bid);
        pg8::EpiBf16T<true> E{(bf16_t*)(p.ws + WS_PROJ), LDP}; pg8::gemm_phase<pg8::EpiBf16T<true>, pg8::StaticOrder, false>(F.lds, g, S, E, nullptr, F.wave); })
    PHASE(3, { const Params p = load_params(); const Frame F = make_frame(lds_raw, wv); p3_dnprep(p, F); })
    PHASE(4, { const Params p = load_params(); const Frame F = make_frame(lds_raw, wv); if (F.bid < 64) scan_unit(p, F, F.bid); else if (F.bid < 64 + CVT_WGS) moe_weight_tiles(p, F, F.bid - 64, CVT_WGS);
        p4_attention(p, F, (char*)lds_raw); })
    PHASE(6, { const Params p = load_params(); const Frame F = make_frame(lds_raw, wv); pg8::Gemm g{(const bf16_t*)(p.ws + WS_HBUF), (const bf16_t*)(p.ws + WS_WOUT), NTOK, DM, DM}; pg8::StaticOrder S; S.init(NTOK, DM, F.G, F.bid);
        pg8::EpiBf16 E{(bf16_t*)(p.ws + WS_Y1), DM}; pg8::gemm_phase<pg8::EpiBf16, pg8::StaticOrder, false>(F.lds, g, S, E, nullptr, F.wave); })
    PHASE(7, { const Params p = load_params(); const Frame F = make_frame(lds_raw, wv); p6_ln1_router(p, F); })
    PHASE(10, { const Params p = load_params(); const Frame F = make_frame(lds_raw, wv); int ntiles;
        LAS int* tl = moe_tables<true>(p, F, ntiles, 4);
        pg8::Gemm g{(const bf16_t*)(p.ws + WS_H2F8), (const bf16_t*)((const unsigned char*)p.out + OUT_W1), 0, 0, DM / 2};
        pg8::MoeOrder S{tl, ntiles, 4, F.G, F.bid};
        pg8::EpiSwiglu E{p.ws + WS_HID}; pg8::gemm_phase<pg8::EpiSwiglu, pg8::MoeOrder, true, true>(F.lds, g, S, E, tl + MOE_GI, F.wave); })
    PHASE(11, { const Params p = load_params(); const Frame F = make_frame(lds_raw, wv); int ntiles;
        LAS int* tl = moe_tables<false>(p, F, ntiles, 8);
        pg8::Gemm g{(const bf16_t*)(p.ws + WS_HID), (const bf16_t*)((const unsigned char*)p.out + OUT_W2), 0, 0, DEXP / 2};
        pg8::MoeOrder S{tl, ntiles, 8, F.G, F.bid};
        pg8::EpiY8 E{p.ws + WS_YB}; pg8::gemm_phase<pg8::EpiY8, pg8::MoeOrder, false, true>(F.lds, g, S, E, nullptr, F.wave); })
    PHASE(12, { const Params p = load_params(); const Frame F = make_frame(lds_raw, wv); p11_final(p, F); })
#undef IN
#undef SEAM
#undef PHASE
}

typedef void (*kern_t)(Params);
template <int K> struct PhaseTab { static void fill(kern_t* t) { t[K] = fwd<(1u << K)>; PhaseTab<K - 1>::fill(t); } };
template <> struct PhaseTab<-1> { static void fill(kern_t*) {} };
extern "C" void kernel_launch(void* const* d_in, const int* in_sizes, int n_in, void* d_out, int out_size, void* d_ws, size_t ws_size, hipStream_t stream) {
    static int grid = 0; static kern_t tab[NPHASE + 1];
    if (grid == 0) {
        if (n_in != 22 || out_size != NTOK * DM || ws_size < WS_END) { fprintf(stderr, "kernel_launch: unexpected shapes (n_in %d, out %d, ws %zu)\n", n_in, out_size, ws_size); grid = -1; return; }
        int dev = 0, cus = 0, per_cu = 0;
        if (hipGetDevice(&dev) != hipSuccess || hipDeviceGetAttribute(&cus, hipDeviceAttributeMultiprocessorCount, dev) != hipSuccess) { grid = -1; return; }
#if MK_ONE_LAUNCH
        tab[NPHASE] = fwd<0xffffu>;
        const int k0 = NPHASE, k1 = NPHASE + 1;
#else
        PhaseTab<NPHASE - 1>::fill(tab);
        const int k0 = 0, k1 = NPHASE;
#endif
        for (int k = k0; k < k1; ++k) {
            if (hipFuncSetAttribute((const void*)tab[k], hipFuncAttributeMaxDynamicSharedMemorySize, LDS_BYTES) != hipSuccess) { fprintf(stderr, "kernel_launch: hipFuncSetAttribute failed\n"); grid = -1; return; }
            if (hipOccupancyMaxActiveBlocksPerMultiprocessor(&per_cu, (const void*)tab[k], 512, LDS_BYTES) != hipSuccess || per_cu < 1) { fprintf(stderr, "kernel_launch: occupancy query says %d\n", per_cu); (void)hipGetLastError(); }
        }
        grid = cus;
        if (grid < 128) { fprintf(stderr, "kernel_launch: built for a 256-CU device (got %d CUs)\n", cus); grid = -1; return; }
    }
    if (grid < 0) return;
    (void)hipMemsetAsync((char*)d_ws + WS_CTL, 0, CTL_BYTES, stream);
    Params p{};
    p.x = (const float*)d_in[0]; p.c = (const float*)d_in[1]; p.w_ada = (const float*)d_in[2]; p.b_ada = (const float*)d_in[3]; p.w_in = (const float*)d_in[4]; p.conv_w = (const float*)d_in[5];
    p.a_log = (const float*)d_in[6]; p.dt_bias = (const float*)d_in[7]; p.norm_w = (const float*)d_in[8]; p.f_bias = (const float*)d_in[9]; p.w_out = (const float*)d_in[10];
    p.ln1_g = (const float*)d_in[11]; p.ln1_b = (const float*)d_in[12]; p.w_rg = (const float*)d_in[13]; p.b_rg = (const float*)d_in[14]; p.w_re = (const float*)d_in[15]; p.b_re = (const float*)d_in[16];
    p.w_gate = (const float*)d_in[17]; p.w_up = (const float*)d_in[18]; p.w_down = (const float*)d_in[19]; p.ln2_g = (const float*)d_in[20]; p.ln2_b = (const float*)d_in[21];
    p.out = (float*)d_out; p.ws = (unsigned char*)d_ws;
#if MK_ONE_LAUNCH
    p.ph_lo = 0; p.ph_hi = NPHASE;
    hipLaunchKernelGGL(tab[NPHASE], dim3(grid), dim3(512), LDS_BYTES, stream, p);
#else
    for (int k = 0; k < NPHASE; ++k) { p.ph_lo = k; p.ph_hi = k + 1; hipLaunchKernelGGL(tab[k], dim3(grid), dim3(512), LDS_BYTES, stream, p); }
#endif
}
```

```cpp
#include <hip/hip_runtime.h>
#include <cstdio>
#include <cstdint>

#ifndef MK_ONE_LAUNCH
#define MK_ONE_LAUNCH 1
#endif

#define LAS __attribute__((address_space(3)))
typedef unsigned short bf16_t;
typedef short bf16x8 __attribute__((ext_vector_type(8)));
typedef short s16x4 __attribute__((ext_vector_type(4)));
typedef float f32x4 __attribute__((ext_vector_type(4)));
typedef float f32x2 __attribute__((ext_vector_type(2)));
typedef float f32x16 __attribute__((ext_vector_type(16)));
typedef unsigned u32x4 __attribute__((ext_vector_type(4)));
typedef unsigned u32x2 __attribute__((ext_vector_type(2)));

constexpr int NB = 8, SEQ = 4096, DM = 2048, NTOK = NB * SEQ;
constexpr int NH = 8, HD = 128;
constexpr int LDP = 7168;
constexpr int PQ = 0, PK = 1024, PV = 2048, PZ = 3072, FQ = 4096, FK = 5120, FV = 6144;
constexpr int WIN_LD = 7192;
constexpr int NEXP = 32, DEXP = 512, PMAX = 2 * NTOK + NEXP * 256;
constexpr float LN_EPS = 1e-5f, NORM_EPS = 1e-6f;
constexpr float ALPHA = 1.189207115002721f;
constexpr float QSCALE = 0.08838834764831845f;
constexpr int NPHASE = 13;

constexpr size_t WS_CTL   = 0;
constexpr size_t CTL_BYTES = 65536;
constexpr int CW_CNT = 4096  , CW_QUEUE = 5120, CW_NTILES = 6144, CW_TILE_E = 7168, CW_QKMAX = 8192;
constexpr size_t WS_MOD   = 65536;
constexpr size_t WS_SMALLW= WS_MOD + 393216;
constexpr size_t WS_RTW   = WS_SMALLW + 131072;
constexpr size_t WS_WOUT  = WS_RTW + 393216;
constexpr size_t WS_WIN   = WS_WOUT + 8388608;
constexpr size_t WS_SM    = WS_WIN + 29360128;
constexpr size_t WS_FCUM  = WS_SM + 4194304;
constexpr size_t WS_HBUF  = WS_FCUM + 1048576;
constexpr size_t WS_PROJ  = WS_HBUF + 134217728;
constexpr size_t WS_DN    = WS_PROJ + 469762048;
constexpr int DN_W = 0, DN_KT = 17408, DN_Q = 35840, DN_QK = 53248, DN_UT = 62464, DN_MISC = 78848, DN_CHUNK = 79104;
constexpr size_t WS_RT    = WS_DN + (size_t)4096 * DN_CHUNK;
constexpr size_t RT_E = 0, RT_W = 262144, RT_POS = 524288, RT_SLOT = 786432, RT_TOK = 1048576, RT_WB = 1048576 + 294912;
constexpr size_t WS_ELIST = WS_RT + 1048576 + 2 * 294912;
constexpr size_t WS_END   = WS_ELIST + (size_t)NEXP * NTOK * 4;
constexpr size_t WS_H2    = WS_PROJ;
constexpr size_t WS_X1    = WS_H2 + 134217728;
constexpr size_t WS_H2F8  = WS_X1 + 134217728;
constexpr size_t WS_HID   = WS_X1 + 268435456;
constexpr size_t WS_YB    = WS_HID + (size_t)PMAX * 512 * 2;
constexpr size_t WS_Y1    = WS_YB;
static_assert(WS_YB + (size_t)PMAX * 2048 * 2 <= WS_RT, "overlay");
static_assert(WS_END <= (size_t)1 << 30, "workspace");
constexpr size_t OUT_W1 = 0;
constexpr size_t OUT_W2 = 134217728;
constexpr float Y8_SCALE = 16.f, Y8_INV = 1.f / 16.f;
constexpr float W2_SCALE = 32.f, HID_SCALE = 8.f, Y2_INV = 1.f / (32.f * 8.f), W1_SCALE = 32.f, W1_INV = 1.f / 32.f;

constexpr int LDS_BYTES = 160 * 1024 - 512;
constexpr int LDS_MISC = LDS_BYTES - 256;

struct Params {
    const float* x; const float* c; const float* w_ada; const float* b_ada; const float* w_in; const float* conv_w; const float* a_log; const float* dt_bias;
    const float* norm_w; const float* f_bias; const float* w_out; const float* ln1_g; const float* ln1_b; const float* w_rg; const float* b_rg; const float* w_re;
    const float* b_re; const float* w_gate; const float* w_up; const float* w_down; const float* ln2_g; const float* ln2_b;
    float* out; unsigned char* ws; int ph_lo, ph_hi;
};

typedef __bf16 bf16v2 __attribute__((ext_vector_type(2)));
__device__ __forceinline__ unsigned cvtpk(float lo, float hi) { bf16v2 v; v[0] = (__bf16)lo; v[1] = (__bf16)hi; return __builtin_bit_cast(unsigned, v); }
__device__ __forceinline__ float bflo(unsigned w) { return __uint_as_float(w << 16); }
__device__ __forceinline__ float bfhi(unsigned w) { return __uint_as_float(w & 0xffff0000u); }
__device__ __forceinline__ float bf1(bf16_t h) { return __uint_as_float(((unsigned)h) << 16); }
__device__ __forceinline__ bf16_t f2bf(float f) { return (bf16_t)(cvtpk(f, 0.f) & 0xffffu); }
__device__ __forceinline__ float silu_f(float x) { return x * __builtin_amdgcn_rcpf(1.f + __expf(-x)); }
__device__ __forceinline__ f32x4 mfma16(bf16x8 a, bf16x8 b, f32x4 c) { return __builtin_amdgcn_mfma_f32_16x16x32_bf16(a, b, c, 0, 0, 0); }
__device__ __forceinline__ u32x2 pack4(f32x4 v) { u32x2 r; r.x = cvtpk(v[0], v[1]); r.y = cvtpk(v[2], v[3]); return r; }
__device__ __forceinline__ bf16x8 pack8(f32x4 a, f32x4 b) { u32x4 w = {cvtpk(a[0], a[1]), cvtpk(a[2], a[3]), cvtpk(b[0], b[1]), cvtpk(b[2], b[3])}; return *reinterpret_cast<bf16x8*>(&w); }
__device__ __forceinline__ void unpack8(u32x4 w, float* f) { f[0] = bflo(w.x); f[1] = bfhi(w.x); f[2] = bflo(w.y); f[3] = bfhi(w.y); f[4] = bflo(w.z); f[5] = bfhi(w.z); f[6] = bflo(w.w); f[7] = bfhi(w.w); }
typedef int i32x8 __attribute__((ext_vector_type(8)));
typedef int i32x4 __attribute__((ext_vector_type(4)));
typedef float f32x2_t __attribute__((ext_vector_type(2)));
__device__ __forceinline__ void unpack8_fp8(u32x2 w, float* f) { const f32x2_t a = __builtin_amdgcn_cvt_pk_f32_fp8((int)w.x, false), b = __builtin_amdgcn_cvt_pk_f32_fp8((int)w.x, true), c = __builtin_amdgcn_cvt_pk_f32_fp8((int)w.y, false), d = __builtin_amdgcn_cvt_pk_f32_fp8((int)w.y, true);
    f[0] = a[0]; f[1] = a[1]; f[2] = b[0]; f[3] = b[1]; f[4] = c[0]; f[5] = c[1]; f[6] = d[0]; f[7] = d[1]; }
__device__ __forceinline__ unsigned pack_fp8x4(float a, float b, float c, float d) { int w = __builtin_amdgcn_cvt_pk_fp8_f32(a, b, 0, false); w = __builtin_amdgcn_cvt_pk_fp8_f32(c, d, w, true); return (unsigned)w; }
__device__ __forceinline__ float wave_sum(float v) {
#pragma unroll
    for (int o = 32; o >= 1; o >>= 1) v += __shfl_xor(v, o);
    return v;
}
#define TRRD(dst, addr, off) asm volatile("ds_read_b64_tr_b16 %0, %1 offset:%2" : "=&v"(dst) : "v"(addr), "i"(off) : "memory")
#define LGKM0() do { asm volatile("s_waitcnt lgkmcnt(0)" ::: "memory"); __builtin_amdgcn_sched_barrier(0); } while (0)
#define VM0() asm volatile("s_waitcnt vmcnt(0)" ::: "memory")
#define LBAR() do { asm volatile("s_waitcnt lgkmcnt(0)" ::: "memory"); __builtin_amdgcn_s_barrier(); asm volatile("" ::: "memory"); } while (0)
__device__ __forceinline__ bf16x8 join8(s16x4 l, s16x4 h) { return (bf16x8){l[0], l[1], l[2], l[3], h[0], h[1], h[2], h[3]}; }

__device__ __forceinline__ int lane_id() { int l; asm volatile("v_mbcnt_lo_u32_b32 %0, -1, 0\n\tv_mbcnt_hi_u32_b32 %0, -1, %0" : "=v"(l)); __builtin_assume(l >= 0 && l < 64); return l; }
#define TID(wv) ((wv) * 64 + lane_id())
#define XB_TMO      128
#define XB_XCNT(j)  (256  + 64 * (j))
#define XB_XSUB(j)  (1280 + 64 * (j))
#define XB_XGEN(j)  (2304 + 64 * (j))
#define XB_TOP      3328
#define XB_TOPGEN   3392
#define XCD_BAR_WORDS 3456
#define XB_SPIN_CAP (1u << 18)
__device__ __forceinline__ unsigned xb_ld(unsigned* p)              { return __hip_atomic_load(p, __ATOMIC_RELAXED, __HIP_MEMORY_SCOPE_AGENT); }
__device__ __forceinline__ unsigned xb_add(unsigned* p, unsigned v) { return __hip_atomic_fetch_add(p, v, __ATOMIC_RELAXED, __HIP_MEMORY_SCOPE_AGENT); }
__device__ __forceinline__ unsigned xb_xcc_id() { return (unsigned)__builtin_amdgcn_s_getreg((3 << 11) | 20) & 0xFu; }
#define XB_SPIN(cond, bar) do { unsigned _sp = 0; while (cond) { __builtin_amdgcn_s_sleep(1); \
    if ((++_sp & 255u) == 0u) { if (xb_ld(&(bar)[XB_TMO])) break; if (_sp > XB_SPIN_CAP) { atomicAdd(&(bar)[XB_TMO], 1u); break; } } } } while (0)
struct XcdBarrier { unsigned* bar; unsigned x; volatile LAS unsigned* st; int wv; };
__device__ __forceinline__ XcdBarrier xcd_barrier_post(unsigned* bar, volatile LAS unsigned* st, int wv) {
    XcdBarrier b; b.bar = bar; b.x = xb_xcc_id(); b.st = st; b.wv = wv;
    if (TID(wv) == 0) (void)xb_add(&bar[XB_XCNT(b.x)], 1u);
    return b;
}
__device__ __forceinline__ void xcd_barrier_complete(unsigned* bar, unsigned x, unsigned& nloc, unsigned& nx) {
    const unsigned G = gridDim.x * gridDim.y * gridDim.z;
    unsigned sum, cnt, mine, sp = 0u;
    for (;;) {
        sum = 0u; cnt = 0u; mine = 0u;
#pragma unroll
        for (unsigned j = 0; j < 16; ++j) { const unsigned c = xb_ld(&bar[XB_XCNT(j)]); sum += c; cnt += (c > 0u) ? 1u : 0u; mine = (j == x) ? c : mine; }
        if (sum == G) break;
        __builtin_amdgcn_s_sleep(1);
        if ((++sp & 255u) == 0u) { if (xb_ld(&bar[XB_TMO])) break; if (sp > XB_SPIN_CAP) { atomicAdd(&bar[XB_TMO], 1u); break; } }
    }
    nloc = mine > 0u ? mine : 1u; nx = cnt > 0u ? cnt : 1u;
}
__device__ __forceinline__ void xcd_barrier(const XcdBarrier& b) {
    asm volatile("s_waitcnt vmcnt(0)" ::: "memory");
    __syncthreads();
    if (TID(b.wv) == 0) {
        unsigned* bar = b.bar;
        __builtin_amdgcn_s_waitcnt(0);
        unsigned nloc = b.st[0], nx = b.st[1];
        if (nloc == 0u) { xcd_barrier_complete(bar, b.x, nloc, nx); b.st[0] = nloc; b.st[1] = nx; }
        const unsigned old = xb_add(&bar[XB_XSUB(b.x)], 1u);
        const unsigned gen = old / nloc;
        if (old + 1u == (gen + 1u) * nloc) {
            __builtin_amdgcn_fence(__ATOMIC_RELEASE, "agent");
            asm volatile("s_waitcnt vmcnt(0)" ::: "memory");
            const unsigned og = xb_add(&bar[XB_TOP], 1u);
            const unsigned tg = og / nx;
            if (og + 1u == (tg + 1u) * nx) xb_add(&bar[XB_TOPGEN], 1u);
            else XB_SPIN(xb_ld(&bar[XB_TOPGEN]) == tg, bar);
            __builtin_amdgcn_fence(__ATOMIC_ACQUIRE, "agent");
            xb_add(&bar[XB_XGEN(b.x)], 1u);
            asm volatile("s_waitcnt vmcnt(0)" ::: "memory");
        } else {
            XB_SPIN(xb_ld(&bar[XB_XGEN(b.x)]) == gen, bar);
            __builtin_amdgcn_fence(__ATOMIC_ACQUIRE, "agent");
            asm volatile("s_waitcnt vmcnt(0)" ::: "memory");
        }
    }
    __syncthreads();
}

namespace pg8 {
constexpr int BM = 256, BK = 64, HALF = 128, HTB = HALF * BK * 2, STAGE_BYTES = 8 * HTB, NXCD = 8, WGM = 8;
__host__ __device__ __forceinline__ int lds_byte(int r, int c) { const int st = (r >> 4) * 2 + (c >> 5), rr = r & 15, cc = c & 31, ob = rr * 64 + cc * 2; return st * 1024 + (ob ^ (((ob >> 9) & 1) << 5)); }
__host__ __device__ __forceinline__ void stage_rc(int b, int& R, int& C) { const int st = b / 1024, sb = b % 1024, swz = sb ^ (((sb >> 9) & 1) << 5); R = (st >> 1) * 16 + swz / 64; C = (st & 1) * 32 + (swz % 64) / 2; }
__host__ __device__ __forceinline__ int perm32(int rho) { const int n = rho >> 4, i = rho & 15; return 8 * (i >> 2) + 4 * n + (i & 3); }
struct Unit { int pm, pn; };
struct Gemm { const bf16_t* A; const bf16_t* Bt; int M, N, K; };
struct StaticOrder {
    int nM, nN, nwg, G, c;
    __device__ void init(int M, int N, int G_, int c_) { nM = M / BM; nN = N / BM; nwg = nM * nN; G = G_; c = c_; }
    __device__ bool next(int i, Unit& u) const {
        const long L = (long)i * G + c; if (L >= nwg) return false;
        int wgid = (int)L; { const int q = nwg / NXCD, r = nwg % NXCD, xcd = wgid % NXCD, off = wgid / NXCD; wgid = (xcd < r ? xcd * (q + 1) : r * (q + 1) + (xcd - r) * q) + off; }
        const int nig = WGM * nN, gid = wgid / nig, fm = gid * WGM, gsz = (nM - fm) < WGM ? (nM - fm) : WGM;
        u.pm = fm + ((wgid % nig) % gsz); u.pn = (wgid % nig) / gsz; return true;
    }
};
struct MoeOrder {
    const LAS int* tile_e; int ntiles, ntl, G, c;
    __device__ bool next(int i, Unit& u) const {
        const long L = (long)i * G + c; if (L >= (long)ntiles * ntl) return false;
        const int t = (int)(L / ntl), j = (int)(L % ntl); u.pm = t; u.pn = tile_e[t] * ntl + j; return true;
    }
};
template <bool NT> struct EpiBf16T {
    static constexpr bool PERM = true; static constexpr int NST = 16;
    bf16_t* O; int ldc;
    __device__ __forceinline__ void operator()(const f32x4 (&acc)[2][2][4][2], const Unit& u, int wr, int wc, int fr, int fq) const {
        const int row0 = u.pm * BM + wr * 64 + fr, col0 = u.pn * BM + wc * 32 + 8 * fq;
#pragma unroll
        for (int ai = 0; ai < 2; ++ai)
#pragma unroll
            for (int m = 0; m < 4; ++m) { bf16_t* rowp = O + (size_t)(row0 + ai * HALF + m * 16) * ldc + col0;
#pragma unroll
                for (int bj = 0; bj < 2; ++bj) { const f32x4 v0 = acc[ai][bj][m][0], v1 = acc[ai][bj][m][1];
                    u32x4 w; w.x = cvtpk(v0[0], v0[1]); w.y = cvtpk(v0[2], v0[3]); w.z = cvtpk(v1[0], v1[1]); w.w = cvtpk(v1[2], v1[3]);
                    if constexpr (NT) __builtin_nontemporal_store(w, (u32x4*)(rowp + bj * HALF)); else *(u32x4*)(rowp + bj * HALF) = w; } }
    }
};
typedef EpiBf16T<false> EpiBf16;
struct EpiSwiglu {
    static constexpr bool PERM = true; static constexpr int NST = 8;
    unsigned char* O;
    __device__ __forceinline__ void operator()(const f32x4 (&acc)[2][2][4][2], const Unit& u, int wr, int wc, int fr, int fq) const {
        const int row0 = u.pm * BM + wr * 64 + fr, col0 = (u.pn & 3) * 128 + wc * 32 + 8 * fq;
#pragma unroll
        for (int ai = 0; ai < 2; ++ai)
#pragma unroll
            for (int m = 0; m < 4; ++m) { unsigned char* rowp = O + (size_t)(row0 + ai * HALF + m * 16) * DEXP + col0;
                float h[8];
#pragma unroll
                for (int n = 0; n < 2; ++n)
#pragma unroll
                    for (int j = 0; j < 4; ++j) { const float g = acc[ai][0][m][n][j] * W1_INV, up = acc[ai][1][m][n][j] * (W1_INV * HID_SCALE); h[n * 4 + j] = g * __builtin_amdgcn_rcpf(1.f + __expf(-g)) * up; }
                *(u32x2*)rowp = (u32x2){pack_fp8x4(h[0], h[1], h[2], h[3]), pack_fp8x4(h[4], h[5], h[6], h[7])}; }
    }
};
struct EpiY8 {
    static constexpr bool PERM = true, BJ8 = true; static constexpr int NST = 8;
    unsigned char* O;
    __device__ __forceinline__ void operator()(const f32x4 (&acc)[2][2][4][2], const Unit& u, int wr, int wc, int fr, int fq) const {
        const int row0 = u.pm * BM + wr * 64 + fr, col0 = (u.pn & 7) * BM + wc * 64 + 16 * fq;
#pragma unroll
        for (int ai = 0; ai < 2; ++ai)
#pragma unroll
            for (int m = 0; m < 4; ++m) { unsigned char* rowp = O + (size_t)(row0 + ai * HALF + m * 16) * DM + col0;
                u32x4 w;
#pragma unroll
                for (int bj = 0; bj < 2; ++bj)
#pragma unroll
                    for (int n = 0; n < 2; ++n) { f32x4 v = acc[ai][bj][m][n] * (Y2_INV * Y8_SCALE);
#pragma unroll
                        for (int e = 0; e < 4; ++e) v[e] = __builtin_amdgcn_fmed3f(v[e], -448.f, 448.f);
                        w[bj * 2 + n] = pack_fp8x4(v[0], v[1], v[2], v[3]); }
                *(u32x4*)rowp = w; }
    }
};

template <class E, class = void> struct EpiBj8 { static constexpr bool value = false; };
template <class E> struct EpiBj8<E, decltype((void)E::BJ8)> { static constexpr bool value = E::BJ8; };
template <class Epi, class Sched, bool GATHER, bool FP8 = false>
__device__ __forceinline__ void gemm_phase(LAS unsigned char* lds, const Gemm g, const Sched& S, const Epi& E, const LAS int* gidx, int wv) {
    const int wid = wv, lane = lane_id(), tid = wid * 64 + lane, wr = wid >> 2, wc = wid & 3, fr = lane & 15, fq = lane >> 4;
    const int K = g.K, nt = K / BK;
    unsigned voffA[2], voffB[2]; int RA[2], CA[2];
#pragma unroll
    for (int i = 0; i < 2; ++i) { int R, C; stage_rc(tid * 16 + i * 8192, R, C); const int Rb = EpiBj8<Epi>::value ? (64 * (R >> 5) + 16 * ((R & 15) >> 2) + 4 * ((R >> 4) & 1) + (R & 3)) : Epi::PERM ? ((R & ~31) + perm32(R & 31)) : R;
        voffA[i] = (unsigned)(R * K + C) * 2u; voffB[i] = (unsigned)(Rb * K + C) * 2u; RA[i] = R; CA[i] = C; }
    const size_t kstep = (size_t)(BK * 2);
    const size_t hstep = (size_t)HALF * K * 2;
    const size_t tstep = 2 * hstep;
    const size_t bstep = EpiBj8<Epi>::value ? (size_t)8 * K * 2 : hstep;
    const unsigned ldsw = (unsigned)wid * 1024u;
    const int aoff = lds_byte(wr * 64 + fr, fq * 8), boff = lds_byte(wc * 32 + fr, fq * 8);
    const int c8 = 32 * (fq >> 1) + 16 * (fq & 1);
    const int aoff8[2] = {lds_byte(wr * 64 + fr, c8), lds_byte(wr * 64 + fr, c8 + 8)}, boff8[2] = {lds_byte(wc * 32 + fr, c8), lds_byte(wc * 32 + fr, c8 + 8)};
#define PG8_SA(b, h) (((b) * 2 + (h)) * HTB)
#define PG8_SB(b, h) ((4 + (b) * 2 + (h)) * HTB)
#define PG8_STAGE(bufoff, gbase, voff) do { _Pragma("unroll") for (int _i = 0; _i < 2; ++_i) \
        __builtin_amdgcn_global_load_lds((const unsigned*)((const char*)(gbase) + (voff)[_i]), (LAS unsigned*)(lds + (bufoff) + ldsw + _i * 8192), 16, 0, 0); } while (0)
#define PG8_STAGE_A(bufoff, kbase, ubase, h, gv) do { if constexpr (GATHER) { PG8_STAGE(bufoff, kbase, gv[h]); } else { PG8_STAGE(bufoff, (ubase) + (h) * hstep, voffA); } } while (0)
#define PG8_LDA(dst, b, h) do { if constexpr (FP8) { _Pragma("unroll") for (int m = 0; m < 4; ++m) { const i32x4 lo_ = *(const LAS i32x4*)(lds + PG8_SA(b, h) + aoff8[0] + m * 2048), hi_ = *(const LAS i32x4*)(lds + PG8_SA(b, h) + aoff8[1] + m * 2048); dst##8[m] = __builtin_shufflevector(lo_, hi_, 0, 1, 2, 3, 4, 5, 6, 7); } } \
        else { _Pragma("unroll") for (int m = 0; m < 4; ++m) _Pragma("unroll") for (int k = 0; k < 2; ++k) dst[m][k] = *(const LAS bf16x8*)(lds + PG8_SA(b, h) + aoff + m * 2048 + k * 1024); } } while (0)
#define PG8_LDB(dst, b, h) do { if constexpr (FP8) { _Pragma("unroll") for (int n = 0; n < 2; ++n) { const i32x4 lo_ = *(const LAS i32x4*)(lds + PG8_SB(b, h) + boff8[0] + n * 2048), hi_ = *(const LAS i32x4*)(lds + PG8_SB(b, h) + boff8[1] + n * 2048); dst##8[n] = __builtin_shufflevector(lo_, hi_, 0, 1, 2, 3, 4, 5, 6, 7); } } \
        else { _Pragma("unroll") for (int n = 0; n < 2; ++n) _Pragma("unroll") for (int k = 0; k < 2; ++k) dst[n][k] = *(const LAS bf16x8*)(lds + PG8_SB(b, h) + boff + n * 2048 + k * 1024); } } while (0)
#define PG8_MMA(ai, bj, At, Bt) do { __builtin_amdgcn_s_setprio(1); \
        if constexpr (FP8) { _Pragma("unroll") for (int m = 0; m < 4; ++m) _Pragma("unroll") for (int n = 0; n < 2; ++n) \
            asm volatile("s_nop 1\n\tv_mfma_f32_16x16x128_f8f6f4 %0, %1, %2, %0" : "+v"(acc[ai][bj][m][n]) : "v"(Bt##8[n]), "v"(At##8[m])); }     \
        else { _Pragma("unroll") for (int m = 0; m < 4; ++m) _Pragma("unroll") for (int n = 0; n < 2; ++n) _Pragma("unroll") for (int k = 0; k < 2; ++k) \
            acc[ai][bj][m][n] = __builtin_amdgcn_mfma_f32_16x16x32_bf16(Bt[n][k], At[m][k], acc[ai][bj][m][n], 0, 0, 0); } \
        __builtin_amdgcn_s_setprio(0); } while (0)
#define PG8_WAIT_V(n) asm volatile("s_waitcnt vmcnt(" #n ")" ::: "memory")
#define PG8_WAIT_L(n) asm volatile("s_waitcnt lgkmcnt(" #n ")" ::: "memory")
#define PG8_BAR __builtin_amdgcn_s_barrier()
#define PG8_SCHED __builtin_amdgcn_sched_barrier(0)
    Unit cur, nxt; int ui = 0;
    if (!S.next(0, cur)) return;
    f32x4 acc[2][2][4][2];
#pragma unroll
    for (int a = 0; a < 2; ++a)
#pragma unroll
        for (int b = 0; b < 2; ++b)
#pragma unroll
            for (int m = 0; m < 4; ++m)
#pragma unroll
                for (int n = 0; n < 2; ++n) acc[a][b][m][n] = (f32x4){0.f, 0.f, 0.f, 0.f};
    bf16x8 At[4][2], B0[2][2], B1[2][2]; i32x8 At8[4], B08[2], B18[2];
    unsigned gc[2][2], gn[2][2];
#define PG8_GLOAD(dst, pm_) do { _Pragma("unroll") for (int h_ = 0; h_ < 2; ++h_) _Pragma("unroll") for (int i_ = 0; i_ < 2; ++i_) \
        dst[h_][i_] = ((unsigned)gidx[(pm_) * BM + h_ * HALF + RA[i_]] * (unsigned)K + (unsigned)CA[i_]) * 2u; } while (0)
    if constexpr (GATHER) { PG8_GLOAD(gc, 0); } else { gc[0][0] = gc[0][1] = gc[1][0] = gc[1][1] = 0u; }
    gn[0][0] = gc[0][0]; gn[0][1] = gc[0][1]; gn[1][0] = gc[1][0]; gn[1][1] = gc[1][1];
    const char* cA = (const char*)g.A + (GATHER ? (size_t)0 : (size_t)cur.pm * tstep); const char* cB = (const char*)g.Bt + (size_t)cur.pn * tstep;
    PG8_STAGE(PG8_SB(0, 0), cB, voffB); PG8_STAGE_A(PG8_SA(0, 0), cA, cA, 0, gc); PG8_STAGE(PG8_SB(0, 1), cB + bstep, voffB); PG8_STAGE_A(PG8_SA(0, 1), cA, cA, 1, gc);
    if (wr == 1) PG8_BAR;
    PG8_WAIT_V(4); PG8_BAR;
    PG8_STAGE(PG8_SB(1, 0), cB + kstep, voffB); PG8_STAGE_A(PG8_SA(1, 0), cA + kstep, cA + kstep, 0, gc); PG8_STAGE(PG8_SB(1, 1), cB + bstep + kstep, voffB);
    PG8_WAIT_V(6); PG8_BAR;
    PG8_STAGE_A(PG8_SA(1, 1), cA + kstep, cA + kstep, 1, gc);
    for (;;) {
        const bool has_next = S.next(ui + 1, nxt);
        const char* nA = has_next ? (const char*)g.A + (GATHER ? (size_t)0 : (size_t)nxt.pm * tstep) : cA; const char* nB = has_next ? (const char*)g.Bt + (size_t)nxt.pn * tstep : cB;
        if constexpr (GATHER) { if (has_next) { PG8_GLOAD(gn, ui + 1); } }
        for (int t = 0; t < nt; t += 2) {
            const bool last = (t == nt - 2);
            const char* a1 = cA + (size_t)(t + 1) * kstep;
            const char* a2 = last ? nA : cA + (size_t)(t + 2) * kstep; const char* b2 = last ? nB : cB + (size_t)(t + 2) * kstep;
            const char* a3 = a2 + kstep; const char* b3 = b2 + kstep;
            unsigned g2[2][2];
            if constexpr (GATHER) {
#pragma unroll
                for (int h_ = 0; h_ < 2; ++h_)
#pragma unroll
                    for (int i_ = 0; i_ < 2; ++i_) g2[h_][i_] = last ? gn[h_][i_] : gc[h_][i_];
            }
            PG8_LDB(B0, 0, 0); PG8_SCHED; PG8_LDA(At, 0, 0);
            PG8_WAIT_L(8); PG8_BAR; PG8_WAIT_L(0); PG8_MMA(0, 0, At, B0); PG8_BAR; PG8_SCHED;
            PG8_LDB(B1, 0, 1); PG8_STAGE(PG8_SB(0, 0), b2, voffB);
            PG8_BAR; PG8_WAIT_L(0); PG8_MMA(0, 1, At, B1); PG8_BAR;
            PG8_LDA(At, 0, 1); PG8_STAGE_A(PG8_SA(0, 0), a2, a2, 0, g2);
            PG8_BAR; PG8_WAIT_L(0); PG8_MMA(1, 0, At, B0); PG8_BAR; PG8_SCHED;
            PG8_STAGE(PG8_SB(0, 1), b2 + bstep, voffB);
            if (t == 0 && ui > 0) asm volatile("s_waitcnt vmcnt(%0)" :: "i"(6 + Epi::NST) : "memory"); else PG8_WAIT_V(6);
            PG8_BAR; PG8_MMA(1, 1, At, B1); PG8_BAR;
            PG8_LDB(B0, 1, 0); PG8_SCHED; PG8_LDA(At, 1, 0); PG8_STAGE_A(PG8_SA(0, 1), a2, a2, 1, g2);
            PG8_WAIT_L(8); PG8_BAR; PG8_WAIT_L(0); PG8_MMA(0, 0, At, B0); PG8_BAR; PG8_SCHED;
            PG8_LDB(B1, 1, 1); PG8_STAGE(PG8_SB(1, 0), b3, voffB);
            PG8_BAR; PG8_WAIT_L(0); PG8_MMA(0, 1, At, B1); PG8_BAR;
            PG8_LDA(At, 1, 1); PG8_STAGE_A(PG8_SA(1, 0), a3, a3, 0, g2);
            PG8_BAR; PG8_WAIT_L(0); PG8_MMA(1, 0, At, B0); PG8_BAR; PG8_SCHED;
            PG8_STAGE(PG8_SB(1, 1), b3 + bstep, voffB);
            PG8_WAIT_V(6); PG8_BAR; PG8_MMA(1, 1, At, B1); PG8_BAR;
            PG8_STAGE_A(PG8_SA(1, 1), a3, a3, 1, g2);
        }
        if constexpr (FP8) { asm volatile("s_nop 15\n\ts_nop 15" ::: "memory"); }
        E(acc, cur, wr, wc, fr, fq);
        if (!has_next) break;
#pragma unroll
        for (int a = 0; a < 2; ++a)
#pragma unroll
            for (int b = 0; b < 2; ++b)
#pragma unroll
                for (int m = 0; m < 4; ++m)
#pragma unroll
                    for (int n = 0; n < 2; ++n) acc[a][b][m][n] = (f32x4){0.f, 0.f, 0.f, 0.f};
        cur = nxt; cA = nA; cB = nB; ++ui;
        gc[0][0] = gn[0][0]; gc[0][1] = gn[0][1]; gc[1][0] = gn[1][0]; gc[1][1] = gn[1][1];
    }
    PG8_WAIT_V(0);
    if (wr == 0) PG8_BAR;
    PG8_BAR;
#undef PG8_SA
#undef PG8_SB
#undef PG8_STAGE
#undef PG8_STAGE_A
#undef PG8_LDA
#undef PG8_LDB
#undef PG8_MMA
#undef PG8_WAIT_V
#undef PG8_WAIT_L
#undef PG8_BAR
#undef PG8_SCHED
#undef PG8_GLOAD
}
}

struct Frame { LAS unsigned char* lds; int tid, lane, wave, G, bid; };

__device__ __forceinline__ void p0_mod_unit(const Params& p, const Frame& F, int u) {
    LAS float* st = (LAS float*)F.lds;
    LAS float* red = (LAS float*)(F.lds + 67584);
    for (int idx = F.tid; idx < NB * DM; idx += 512) { const int b = idx >> 11, k = idx & 2047; st[(k + (k >> 6)) * 8 + b] = silu_f(p.c[idx]); }
    __syncthreads();
    if (F.tid < 384) {
        const int cgp = F.tid % 12, kg = F.tid / 12;
        f32x4 acc[8];
#pragma unroll
        for (int b = 0; b < 8; ++b) acc[b] = (f32x4){0.f, 0.f, 0.f, 0.f};
        const char* wbase = (const char*)(p.w_ada + 48 * u); const unsigned woff = (unsigned)((kg * 64) * (6 * DM) + 4 * cgp) * 4u;
#define MOD_LOAD8(dst, j) do { _Pragma("unroll") for (int q = 0; q < 8; ++q) dst[q] = __builtin_nontemporal_load((const f32x4*)(wbase + (woff + (unsigned)((j) * 8 + q) * (unsigned)(6 * DM * 4)))); } while (0)
#define MOD_USE8(src, j) do { _Pragma("unroll") for (int q = 0; q < 8; ++q) { const int kk = (j) * 8 + q; const f32x4 w = src[q]; \
            const f32x4 s0 = *(const LAS f32x4*)(st + (kg * 65 + kk) * 8), s1 = *(const LAS f32x4*)(st + (kg * 65 + kk) * 8 + 4); \
            acc[0] += w * s0[0]; acc[1] += w * s0[1]; acc[2] += w * s0[2]; acc[3] += w * s0[3]; acc[4] += w * s1[0]; acc[5] += w * s1[1]; acc[6] += w * s1[2]; acc[7] += w * s1[3]; } } while (0)
        f32x4 wa[8], wb[8];
        MOD_LOAD8(wa, 0); __builtin_amdgcn_sched_barrier(0);
#pragma unroll 1
        for (int j = 0; j < 8; j += 2) {
            MOD_LOAD8(wb, j + 1); __builtin_amdgcn_sched_barrier(0);
            MOD_USE8(wa, j); __builtin_amdgcn_sched_barrier(0);
            { const int jn = j + 2 < 8 ? j + 2 : 7; MOD_LOAD8(wa, jn); } __builtin_amdgcn_sched_barrier(0);
            MOD_USE8(wb, j + 1); __builtin_amdgcn_sched_barrier(0);
        }
#undef MOD_LOAD8
#undef MOD_USE8
#pragma unroll
        for (int b = 0; b < 8; ++b) *(LAS f32x4*)(red + (kg * 8 + b) * 48 + 4 * cgp) = acc[b];
    }
    __syncthreads();
    if (F.tid < 384) {
        const int b = F.tid / 48, col = F.tid % 48; float s = p.b_ada[48 * u + col];
#pragma unroll
        for (int kg = 0; kg < 32; ++kg) s += red[(kg * 8 + b) * 48 + col];
        ((float*)(p.ws + WS_MOD))[b * (6 * DM) + 48 * u + col] = s;
    }
    __syncthreads();
}
struct CvtJob { const float* src; bf16_t* dst; int ld_src, ld_dst, qrows; float f8scale; };
constexpr int CVT_NT = 4;
#ifndef CVT_WGS
#define CVT_WGS 80
#endif
template <class JobFn>
__device__ __forceinline__ void cvt_stream(const Frame& F, int first, int stride, int total, JobFn job) {
    int v = first; if (v >= total) return;
    const int kr = F.tid >> 5, nc = (F.tid & 31) * 4, n = F.tid >> 2, kc = (F.tid & 3) * 16;
    CvtJob cur = job(v); f32x4 r[CVT_NT][4];
#define CVT_LOAD(jb) do { _Pragma("unroll") for (int q = 0; q < CVT_NT; ++q) _Pragma("unroll") for (int i = 0; i < 4; ++i) r[q][i] = __builtin_nontemporal_load((const f32x4*)((jb).src + (size_t)(kr + 16 * i) * (jb).ld_src + 128 * q + nc)); } while (0)
    CVT_LOAD(cur);
    int buf = 0;
    for (;;) {
        LAS unsigned char* t = F.lds + buf * (CVT_NT * 16384);
#pragma unroll
        for (int q = 0; q < CVT_NT; ++q)
#pragma unroll
            for (int i = 0; i < 4; ++i) *(LAS u32x2*)(t + q * 16384 + (kr + 16 * i) * 256 + nc * 2) = pack4(r[q][i]);
        const int vn = v + stride; const bool more = vn < total; CvtJob nx = cur;
        if (more) { nx = job(vn); CVT_LOAD(nx); }
        asm volatile("s_waitcnt lgkmcnt(0)" ::: "memory"); __builtin_amdgcn_s_barrier(); asm volatile("" ::: "memory");
#pragma unroll
        for (int q = 0; q < CVT_NT; ++q) { unsigned w[8];
#pragma unroll
          for (int e = 0; e < 8; ++e) { const unsigned lo = *(const LAS bf16_t*)(t + q * 16384 + (kc + 2 * e) * 256 + n * 2), hi = *(const LAS bf16_t*)(t + q * 16384 + (kc + 2 * e + 1) * 256 + n * 2); w[e] = lo | (hi << 16); }
          if (cur.f8scale != 0.f) { const float sc = cur.f8scale; unsigned f[4];
#pragma unroll
              for (int e = 0; e < 4; ++e) f[e] = pack_fp8x4(bflo(w[2 * e]) * sc, bfhi(w[2 * e]) * sc, bflo(w[2 * e + 1]) * sc, bfhi(w[2 * e + 1]) * sc);
              *(u32x4*)((unsigned char*)cur.dst + (size_t)(q * cur.qrows + n) * cur.ld_dst + kc) = (u32x4){f[0], f[1], f[2], f[3]}; }
          else { u32x4* d = (u32x4*)(cur.dst + (size_t)(q * cur.qrows + n) * cur.ld_dst + kc); d[0] = (u32x4){w[0], w[1], w[2], w[3]}; d[1] = (u32x4){w[4], w[5], w[6], w[7]}; } }
        if (!more) break;
        v = vn; buf ^= 1; cur = nx;
    }
#undef CVT_LOAD
    __syncthreads();
}
constexpr int P0_MOD = 256, P0_WIN = 1792, P0_WOUT = 512, P0_GU = 8192, P0_DOWN = 4096, P0_SMALL = 16, P0_RT = 24;
__device__ __forceinline__ void p0_prologue(const Params& p, const Frame& F) {
    bf16_t* wout_t = (bf16_t*)(p.ws + WS_WOUT); bf16_t* win_t = (bf16_t*)(p.ws + WS_WIN);
    for (int v = F.bid; v < P0_MOD; v += F.G) p0_mod_unit(p, F, v);
    cvt_stream(F, F.bid, F.G, (P0_WIN + P0_WOUT) / CVT_NT, [&](int g) -> CvtJob {
        int idx = g * CVT_NT;
        if (idx < P0_WIN) { const int kt = idx / 56, nt = idx % 56, n0 = 128 * nt, oc = n0 + (n0 >= 4096 ? 16 : 0);
            return CvtJob{p.w_in + (size_t)kt * 64 * WIN_LD + oc, win_t + (size_t)n0 * DM + kt * 64, WIN_LD, DM, 128, 0.f}; }
        idx -= P0_WIN; const int kt = idx / 16, nt = idx % 16;
        return CvtJob{p.w_out + (size_t)kt * 64 * DM + 128 * nt, wout_t + (size_t)(128 * nt) * DM + kt * 64, DM, DM, 128, 0.f}; });
    for (int v = F.bid; v < P0_SMALL + P0_RT; v += F.G) {
        int idx = v;
        if (idx < P0_SMALL) { bf16_t* sw = (bf16_t*)(p.ws + WS_SMALLW);
            for (int j = 0; j < 8; ++j) { const int i = idx * 4096 + j * 512 + F.tid, s = i >> 11, k = i & 2047;
                const float val = s < 24 ? p.w_in[(size_t)k * WIN_LD + (s < 16 ? 4096 + s : 7184 + s - 16)] : 0.f; sw[i] = f2bf(val); }
            continue; } idx -= P0_SMALL;
        { bf16_t* rw = (bf16_t*)(p.ws + WS_RTW);
            for (int j = 0; j < 8; ++j) { const int i = idx * 4096 + j * 512 + F.tid, n = i >> 11, k = i & 2047;
                const float val = n < 4 ? p.w_rg[k * 4 + n] : (n < 36 ? p.w_re[(size_t)((n - 4) >> 3) * DM * 8 + k * 8 + ((n - 4) & 7)] : 0.f);
                const int o = ((((n >> 4) * 64 + (k >> 5)) * 64) + ((k & 31) >> 3) * 16 + (n & 15)) * 8 + (k & 7);
                const bf16_t hi = f2bf(val); rw[o] = hi; rw[48 * DM + o] = f2bf(val - bf1(hi)); } }
    }
}
__device__ __forceinline__ void moe_weight_tiles(const Params& p, const Frame& F, int first, int stride) {
    bf16_t* w1 = (bf16_t*)((unsigned char*)p.out + OUT_W1); bf16_t* w2 = (bf16_t*)((unsigned char*)p.out + OUT_W2);
    cvt_stream(F, first, stride, (P0_GU + P0_DOWN) / CVT_NT, [&](int g) -> CvtJob {
        int idx = g * CVT_NT;
        if (idx < P0_GU) { const int e = idx >> 8, r = idx & 255, which = r >> 7, r2 = r & 127, kt = r2 >> 2;
            return CvtJob{(which ? p.w_up : p.w_gate) + (size_t)e * DM * DEXP + (size_t)kt * 64 * DEXP, (bf16_t*)((unsigned char*)w1 + (size_t)(e * 1024 + which * 128) * DM + kt * 64), DEXP, DM, 256, W1_SCALE}; }
        idx -= P0_GU; const int e = idx >> 7, r = idx & 127, kt = r >> 4, nt = r & 15;
        return CvtJob{p.w_down + (size_t)e * DEXP * DM + (size_t)kt * 64 * DM + 128 * nt, (bf16_t*)((unsigned char*)w2 + (size_t)(e * 2048 + 128 * nt) * DEXP + kt * 64), DM, DEXP, 128, W2_SCALE}; });
}

constexpr int H1_SW = 16384, H1_SWLD = 4112;
__device__ __forceinline__ void p1_hpass(const Params& p, const Frame& F) {
    const float* mod = (const float*)(p.ws + WS_MOD); bf16_t* hb = (bf16_t*)(p.ws + WS_HBUF); const bf16_t* sw = (const bf16_t*)(p.ws + WS_SMALLW); float* sm = (float*)(p.ws + WS_SM);
    const int fr = F.lane & 15, fq = F.lane >> 4;
    for (int i = F.tid; i < 32 * 256; i += 512) { const int r = i >> 8, ch = i & 255; *(LAS u32x4*)(F.lds + H1_SW + r * H1_SWLD + ch * 16) = *(const u32x4*)(sw + (size_t)r * DM + ch * 8); }
    int bcur = -1;
    for (int wt0 = F.bid * 8; wt0 < NTOK / 16; wt0 += F.G * 8) {
        const int wt = wt0 + F.wave, row0 = wt * 16, b = (wt0 * 16) / SEQ;
        if (b != bcur) { __syncthreads(); bcur = b;
            for (int i = F.tid; i < DM; i += 512) { ((LAS float*)F.lds)[i] = 1.f + mod[(size_t)b * (6 * DM) + DM + i]; ((LAS float*)F.lds)[DM + i] = mod[(size_t)b * (6 * DM) + i]; }
            __syncthreads(); }
        const float* xr = p.x + (size_t)(row0 + fr) * DM + 8 * fq; bf16_t* hr = hb + (size_t)(row0 + fr) * DM + 8 * fq;
        f32x4 a0 = {0.f, 0.f, 0.f, 0.f}, a1 = {0.f, 0.f, 0.f, 0.f};
        f32x4 xa[8][2], xn[8][2];
#define H1_LOAD(dst, blk_) do { _Pragma("unroll") for (int j = 0; j < 8; ++j) { dst[j][0] = __builtin_nontemporal_load((const f32x4*)(xr + 32 * (8 * (blk_) + j))); dst[j][1] = __builtin_nontemporal_load((const f32x4*)(xr + 32 * (8 * (blk_) + j) + 4)); } } while (0)
#define H1_COMP(src, blk_) do { _Pragma("unroll") for (int j = 0; j < 8; ++j) { const int s = 8 * (blk_) + j; \
                const f32x4 c0 = *(const LAS f32x4*)(F.lds + (32 * s + 8 * fq) * 4), c1 = *(const LAS f32x4*)(F.lds + (32 * s + 8 * fq) * 4 + 16); \
                const f32x4 h0 = *(const LAS f32x4*)(F.lds + 8192 + (32 * s + 8 * fq) * 4), h1 = *(const LAS f32x4*)(F.lds + 8192 + (32 * s + 8 * fq) * 4 + 16); \
                const bf16x8 af = pack8(src[j][0] * c0 + h0, src[j][1] * c1 + h1); \
                *(bf16x8*)(hr + 32 * s) = af; \
                const bf16x8 b0 = *(const LAS bf16x8*)(F.lds + H1_SW + fr * H1_SWLD + (32 * s + 8 * fq) * 2), b1 = *(const LAS bf16x8*)(F.lds + H1_SW + (16 + fr) * H1_SWLD + (32 * s + 8 * fq) * 2); \
                a0 = mfma16(af, b0, a0); a1 = mfma16(af, b1, a1); } } while (0)
        H1_LOAD(xa, 0);
#pragma unroll 1
        for (int bp = 0; bp < 4; ++bp) {
            H1_LOAD(xn, 2 * bp + 1); H1_COMP(xa, 2 * bp);
            if (bp < 3) H1_LOAD(xa, 2 * bp + 2);
            H1_COMP(xn, 2 * bp + 1);
        }
#undef H1_LOAD
#undef H1_COMP
#pragma unroll
        for (int j = 0; j < 4; ++j) { float* o = sm + (size_t)(row0 + 4 * fq + j) * 32; o[fr] = a0[j]; o[16 + fr] = a1[j]; }
    }
    __syncthreads();
}

constexpr int D1_KN = 0, D1_QN = 17408, D1_VN = 34816, D1_AOFF = 52224, D1_TM = 61440, D1_TB = 70656, D1_TG = 79872, D1_ADIAG = 89088, D1_GATES = 93440;
constexpr int D1_CW = 94464;
struct D1Pre { u32x4 x[3][5]; float gb, ga; };
__device__ __forceinline__ void d1_prefetch(const Params& p, const Frame& F, int u, D1Pre& P) {
    const int bh = u >> 6, c = u & 63, b = bh >> 3, h = bh & 7, row0 = b * SEQ + c * 64;
    const bf16_t* proj = (const bf16_t*)(p.ws + WS_PROJ); const float* sm = (const float*)(p.ws + WS_SM);
    const int cg = F.tid & 15, t0 = 2 * (F.tid >> 4);
#pragma unroll
    for (int part = 0; part < 3; ++part)
#pragma unroll
        for (int j = 0; j < 5; ++j) { const int tt = c * 64 + t0 - 3 + j; const int tc = tt >= 0 ? t0 - 3 + j : 0;
            P.x[part][j] = *(const u32x4*)(proj + (size_t)(row0 + tc) * LDP + part * 1024 + h * HD + 8 * cg); }
    const float* r = sm + (size_t)(row0 + F.lane) * 32; P.gb = r[h]; P.ga = r[8 + h];
}
__device__ __forceinline__ void d1_chunk(const Params& p, const Frame& F, int u, D1Pre& P, int unext, float dtb, float nega) {
    LAS unsigned char* lds = F.lds;
    const int tid = F.tid, lane = F.lane, wave = F.wave, fr = lane & 15, fq = lane >> 4;
    const int bh = u >> 6, c = u & 63, h = bh & 7;
    unsigned char* outc = p.ws + WS_DN + (size_t)u * DN_CHUNK;
    LAS float* Gs = (LAS float*)(lds + D1_GATES); LAS float* Bs = Gs + 64; LAS float* EGs = Gs + 128;
    if (wave == 0) {
        const float bl = P.gb, al = P.ga;
        const float beta = __builtin_amdgcn_rcpf(1.f + __expf(-bl));
        const float xs = al + dtb;
        const float sp = xs > 20.f ? xs : log1pf(__expf(xs));
        float G = nega * sp;
#pragma unroll
        for (int o = 1; o < 64; o <<= 1) { const float v = __shfl_up(G, o); if (lane >= o) G += v; }
        Gs[lane] = G; Bs[lane] = beta; EGs[lane] = __expf(G);
    }
    {
        const int cg = tid & 15, rp = tid >> 4, t0 = 2 * rp;
#pragma unroll
        for (int part = 0; part < 3; ++part) {
            float cw[4][8];
#pragma unroll
            for (int tp = 0; tp < 4; ++tp) { const f32x4 w0 = *(const LAS f32x4*)(lds + D1_CW + ((part * 4 + tp) * 128 + 8 * cg) * 4), w1 = *(const LAS f32x4*)(lds + D1_CW + ((part * 4 + tp) * 128 + 8 * cg + 4) * 4);
                cw[tp][0] = w0[0]; cw[tp][1] = w0[1]; cw[tp][2] = w0[2]; cw[tp][3] = w0[3]; cw[tp][4] = w1[0]; cw[tp][5] = w1[1]; cw[tp][6] = w1[2]; cw[tp][7] = w1[3]; }
            float o0[8], o1[8];
#pragma unroll
            for (int e = 0; e < 8; ++e) { o0[e] = 0.f; o1[e] = 0.f; }
#pragma unroll
            for (int j = 0; j < 5; ++j) { u32x4 xr = P.x[part][j];
                if (j < 3) { const bool valid = c * 64 + t0 - 3 + j >= 0; xr.x = valid ? xr.x : 0u; xr.y = valid ? xr.y : 0u; xr.z = valid ? xr.z : 0u; xr.w = valid ? xr.w : 0u; }
                float xf[8]; unpack8(xr, xf);
#pragma unroll
                for (int e = 0; e < 8; ++e) { const float xv = xf[e]; if (j < 4) o0[e] += cw[j][e] * xv; if (j >= 1) o1[e] += cw[j - 1][e] * xv; } }
            float s0 = 0.f, s1 = 0.f;
#pragma unroll
            for (int e = 0; e < 8; ++e) { o0[e] = silu_f(o0[e]); o1[e] = silu_f(o1[e]); s0 += o0[e] * o0[e]; s1 += o1[e] * o1[e]; }
            if (part < 2) {
#pragma unroll
                for (int o = 1; o < 16; o <<= 1) { s0 += __shfl_xor(s0, o); s1 += __shfl_xor(s1, o); }
                const float r0 = rsqrtf(s0 + NORM_EPS), r1 = rsqrtf(s1 + NORM_EPS);
#pragma unroll
                for (int e = 0; e < 8; ++e) { o0[e] *= r0; o1[e] *= r1; }
            }
            const int img = part == 0 ? D1_QN : (part == 1 ? D1_KN : D1_VN);
            *(LAS bf16x8*)(lds + img + t0 * 272 + cg * 16) = pack8((f32x4){o0[0], o0[1], o0[2], o0[3]}, (f32x4){o0[4], o0[5], o0[6], o0[7]});
            *(LAS bf16x8*)(lds + img + (t0 + 1) * 272 + cg * 16) = pack8((f32x4){o1[0], o1[1], o1[2], o1[3]}, (f32x4){o1[4], o1[5], o1[6], o1[7]});
            __builtin_amdgcn_sched_barrier(0);
        }
    }
    d1_prefetch(p, F, unext, P);
    __syncthreads();
#define D1_TILE_JOB(job_) do { const int job = (job_), kind = job >> 4, ti = (job >> 2) & 3, tj = job & 3; \
        const int icol = 16 * ti + fr, j0 = 16 * tj + 4 * fq; \
        if (tj > ti) { if (kind == 1) *(u32x2*)(outc + DN_QK + icol * 144 + j0 * 2) = (u32x2){0u, 0u}; break; } \
        f32x4 acc = {0.f, 0.f, 0.f, 0.f}; \
        const int ybase = kind ? D1_QN : D1_KN; \
        _Pragma("unroll") for (int s = 0; s < 4; ++s) { \
            const bf16x8 a = *(const LAS bf16x8*)(lds + D1_KN + (16 * tj + fr) * 272 + (32 * s + 8 * fq) * 2); \
            const bf16x8 bb = *(const LAS bf16x8*)(lds + ybase + (16 * ti + fr) * 272 + (32 * s + 8 * fq) * 2); \
            acc = mfma16(a, bb, acc); } \
        const float Gi = Gs[icol]; const f32x4 Gj = *(const LAS f32x4*)(Gs + j0); \
        f32x4 v; \
        if (kind == 0) { const float bi = Bs[icol]; \
            _Pragma("unroll") for (int e = 0; e < 4; ++e) v[e] = (j0 + e < icol) ? bi * acc[e] * __expf(Gi - Gj[e]) : 0.f; \
            if (tj < ti) *(LAS u32x2*)(lds + D1_AOFF + icol * 144 + j0 * 2) = pack4(v); \
            else *(LAS f32x4*)(lds + D1_ADIAG + ti * 1040 + fr * 64 + fq * 16) = v; \
        } else { \
            _Pragma("unroll") for (int e = 0; e < 4; ++e) v[e] = (j0 + e <= icol) ? acc[e] * __expf(Gi - Gj[e]) * QSCALE : 0.f; \
            *(u32x2*)(outc + DN_QK + icol * 144 + j0 * 2) = pack4(v); \
        } } while (0)
#pragma unroll 1
    for (int jj = 0; jj < 2; ++jj) D1_TILE_JOB(wave + 8 * jj);
    __syncthreads();
    if (wave == 0) {
        { const int blk = lane >> 4, jc = lane & 15; float t[16];
#pragma unroll
          for (int i = 0; i < 16; ++i) { float a4[4] = {(jc == i) ? 1.f : 0.f, 0.f, 0.f, 0.f};
#pragma unroll
              for (int m4 = 0; m4 < (i + 3) / 4; ++m4) { const f32x4 ar = *(const LAS f32x4*)(lds + D1_ADIAG + blk * 1040 + i * 64 + m4 * 16);
#pragma unroll
                  for (int e = 0; e < 4; ++e) if (4 * m4 + e < i) a4[e] -= ar[e] * t[4 * m4 + e]; }
              t[i] = (a4[0] + a4[1]) + (a4[2] + a4[3]); if ((i & 3) == 3) __builtin_amdgcn_sched_barrier(0); }
          const int j = 16 * blk + jc; const float bj = Bs[j], bgj = bj * EGs[j];
#pragma unroll
          for (int i = 0; i < 16; ++i) { const int off = (16 * blk + i) * 144 + j * 2;
              *(LAS bf16_t*)(lds + D1_TM + off) = f2bf(t[i]); *(LAS bf16_t*)(lds + D1_TB + off) = f2bf(t[i] * bj); *(LAS bf16_t*)(lds + D1_TG + off) = f2bf(t[i] * bgj); } }
        LGKM0();
        const int tmaddr = (int)(uintptr_t)(lds + D1_TM);
#pragma unroll
        for (int bb = 1; bb < 4; ++bb) {
            constexpr int NS_MAX = 2;
            bf16x8 a[NS_MAX]; s16x4 l[3][NS_MAX], hh[3][NS_MAX];
            const int ns = bb == 3 ? 2 : 1;
#pragma unroll
            for (int s_ = 0; s_ < NS_MAX; ++s_) if (s_ < ns) a[s_] = *(const LAS bf16x8*)(lds + D1_AOFF + (16 * bb + fr) * 144 + (32 * s_ + 8 * fq) * 2);
#pragma unroll
            for (int cc = 0; cc < 3; ++cc) if (cc < bb)
#pragma unroll
                for (int s_ = 0; s_ < NS_MAX; ++s_) if (s_ < ns) { const int ad = tmaddr + (32 * s_ + 8 * fq + (fr >> 2)) * 144 + (16 * cc + 4 * (fr & 3)) * 2; TRRD(l[cc][s_], ad, 0); TRRD(hh[cc][s_], ad, 576); }
            const u32x2 t2 = *(const LAS u32x2*)(lds + D1_TM + (16 * bb + fr) * 144 + (16 * bb + 4 * fq) * 2);
            LGKM0();
            f32x4 X[3];
#pragma unroll
            for (int cc = 0; cc < 3; ++cc) if (cc < bb) { X[cc] = (f32x4){0.f, 0.f, 0.f, 0.f};
#pragma unroll
                for (int s_ = 0; s_ < NS_MAX; ++s_) if (s_ < ns) X[cc] = mfma16(a[s_], join8(l[cc][s_], hh[cc][s_]), X[cc]); }
#pragma unroll
            for (int cc = 0; cc < 3; ++cc) if (cc < bb) {
                u32x4 aw = {t2.x, t2.y, 0u, 0u}, bw = {cvtpk(X[cc][0], X[cc][1]), cvtpk(X[cc][2], X[cc][3]), 0u, 0u};
                const f32x4 Tn = mfma16(*reinterpret_cast<bf16x8*>(&aw), *reinterpret_cast<bf16x8*>(&bw), (f32x4){0.f, 0.f, 0.f, 0.f});
                const int j = 16 * cc + fr; const float bj = Bs[j], bgj = bj * EGs[j];
#pragma unroll
                for (int e = 0; e < 4; ++e) { const int off = (16 * bb + 4 * fq + e) * 144 + j * 2; const float tv = -Tn[e];
                    *(LAS bf16_t*)(lds + D1_TM + off) = f2bf(tv); *(LAS bf16_t*)(lds + D1_TB + off) = f2bf(tv * bj); *(LAS bf16_t*)(lds + D1_TG + off) = f2bf(tv * bgj); }
            }
            LGKM0();
        }
    } else {
        const int t7 = tid - 64; const float Glast = Gs[63];
        for (int i = t7; i < 1024; i += 448) { const int r = i >> 4, ch = i & 15; float f[8]; unpack8(*(const LAS u32x4*)(lds + D1_QN + r * 272 + ch * 16), f); const float sc = EGs[r] * QSCALE;
            *(bf16x8*)(outc + DN_Q + r * 272 + ch * 16) = pack8((f32x4){f[0] * sc, f[1] * sc, f[2] * sc, f[3] * sc}, (f32x4){f[4] * sc, f[5] * sc, f[6] * sc, f[7] * sc}); }
        for (int i = t7; i < 1024; i += 448) { const int dk = i & 127, ich = i >> 7; float f[8];
#pragma unroll
            for (int e = 0; e < 8; ++e) f[e] = bf1(*(const LAS bf16_t*)(lds + D1_KN + (8 * ich + e) * 272 + dk * 2)) * __expf(Glast - Gs[8 * ich + e]);
            *(bf16x8*)(outc + DN_KT + dk * 144 + ich * 16) = pack8((f32x4){f[0], f[1], f[2], f[3]}, (f32x4){f[4], f[5], f[6], f[7]}); }
        if (t7 == 0) *(float*)(outc + DN_MISC) = __expf(Glast);
#pragma unroll 1
        for (int jq = 16 + wave - 1; jq < 32; jq += 7) D1_TILE_JOB(jq);
    }
#undef D1_TILE_JOB
    __syncthreads();
    { const int vnaddr = (int)(uintptr_t)(lds + D1_VN), knaddr = (int)(uintptr_t)(lds + D1_KN);
#pragma unroll
      for (int jp = 0; jp < 2; ++jp) {
        bf16x8 a[2][2]; s16x4 l[2][2], hh[2][2];
#pragma unroll
        for (int q = 0; q < 2; ++q)
#pragma unroll
            for (int s_ = 0; s_ < 2; ++s_) { const int it = 2 * jp + q;
                a[q][s_] = *(const LAS bf16x8*)(lds + D1_TB + (16 * it + fr) * 144 + (32 * s_ + 8 * fq) * 2);
                const int ad = vnaddr + (32 * s_ + 8 * fq + (fr >> 2)) * 272 + (16 * wave + 4 * (fr & 3)) * 2;
                TRRD(l[q][s_], ad, 0); TRRD(hh[q][s_], ad, 1088); }
        LGKM0();
#pragma unroll
        for (int q = 0; q < 2; ++q) { const int it = 2 * jp + q; f32x4 acc = {0.f, 0.f, 0.f, 0.f};
            acc = mfma16(a[q][0], join8(l[q][0], hh[q][0]), acc); acc = mfma16(a[q][1], join8(l[q][1], hh[q][1]), acc);
            *(u32x2*)(outc + DN_UT + (16 * wave + fr) * 128 + (16 * it + 4 * fq) * 2) = pack4(acc); }
      }
#pragma unroll
      for (int jp = 0; jp < 2; ++jp) {
        const int it = wave & 3;
        bf16x8 bb[2]; s16x4 l[2][2], hh[2][2];
#pragma unroll
        for (int s_ = 0; s_ < 2; ++s_) bb[s_] = *(const LAS bf16x8*)(lds + D1_TG + (16 * it + fr) * 144 + (32 * s_ + 8 * fq) * 2);
#pragma unroll
        for (int q = 0; q < 2; ++q)
#pragma unroll
            for (int s_ = 0; s_ < 2; ++s_) { const int dkt = 4 * jp + 2 * q + (wave >> 2);
                const int ad = knaddr + (32 * s_ + 8 * fq + (fr >> 2)) * 272 + (16 * dkt + 4 * (fr & 3)) * 2;
                TRRD(l[q][s_], ad, 0); TRRD(hh[q][s_], ad, 1088); }
        LGKM0();
#pragma unroll
        for (int q = 0; q < 2; ++q) { const int dkt = 4 * jp + 2 * q + (wave >> 2); f32x4 acc = {0.f, 0.f, 0.f, 0.f};
            acc = mfma16(join8(l[q][0], hh[q][0]), bb[0], acc); acc = mfma16(join8(l[q][1], hh[q][1]), bb[1], acc);
            *(u32x2*)(outc + DN_W + (16 * it + fr) * 272 + (16 * dkt + 4 * fq) * 2) = pack4(-acc); }
      } }
    __syncthreads();
}
__device__ __forceinline__ void fcum_unit(const Params& p, const Frame& F, int bh) {
    const float* sm = (const float*)(p.ws + WS_SM); float* fc = (float*)(p.ws + WS_FCUM) + (size_t)bh * SEQ;
    const int b = bh >> 3, h = bh & 7; const float fb = p.f_bias[h];
    LAS float* red = (LAS float*)F.lds;
    float v[8], s = 0.f;
#pragma unroll
    for (int e = 0; e < 8; ++e) { const float z = sm[(size_t)(b * SEQ + F.tid * 8 + e) * 32 + 16 + h] + fb; const float ls = fminf(z, 0.f) - log1pf(__expf(-fabsf(z))); s += ls; v[e] = s; }
    float inc = s;
#pragma unroll
    for (int o = 1; o < 64; o <<= 1) { const float t = __shfl_up(inc, o); if (F.lane >= o) inc += t; }
    if (F.lane == 63) red[F.wave] = inc;
    __syncthreads();
    float base = inc - s;
    for (int w = 0; w < F.wave; ++w) base += red[w];
#pragma unroll
    for (int e = 0; e < 8; ++e) fc[F.tid * 8 + e] = -(base + v[e]) * 11.313708498984761f;
    __syncthreads();
}
__device__ __forceinline__ int d1_unit(int bid, int i) { const int h = bid & 7, j = (bid >> 3) + 32 * i, b = j >> 6, c = j & 63; return ((b * 8 + h) << 6) + c; }
__device__ __forceinline__ void p3_dnprep(const Params& p, const Frame& F) {
    if (F.G == 256) {
        const int h = F.bid & 7;
        for (int i = F.tid; i < 3 * 4 * 128; i += 512) { const int part = i / 512, tp = (i >> 7) & 3, ch = i & 127; ((LAS float*)(F.lds + D1_CW))[i] = p.conv_w[tp * 3072 + part * 1024 + h * HD + ch]; }
        for (int i = F.tid; i < 2304; i += 512) *(LAS u32x4*)(F.lds + D1_AOFF + i * 16) = (u32x4){0u, 0u, 0u, 0u};
        D1Pre P; d1_prefetch(p, F, d1_unit(F.bid, 0), P);
        const float dtb = p.dt_bias[h], nega = -__expf(p.a_log[h]);
        __syncthreads();
#pragma unroll 1
        for (int i = 0; i < 16; ++i) d1_chunk(p, F, d1_unit(F.bid, i), P, d1_unit(F.bid, i < 15 ? i + 1 : i), dtb, nega);
    } else {
        for (int u = F.bid; u < 4096; u += F.G) { const int h = (u >> 6) & 7;
            __syncthreads();
            for (int i = F.tid; i < 3 * 4 * 128; i += 512) { const int part = i / 512, tp = (i >> 7) & 3, ch = i & 127; ((LAS float*)(F.lds + D1_CW))[i] = p.conv_w[tp * 3072 + part * 1024 + h * HD + ch]; }
            for (int i = F.tid; i < 2304; i += 512) *(LAS u32x4*)(F.lds + D1_AOFF + i * 16) = (u32x4){0u, 0u, 0u, 0u};
            D1Pre P; d1_prefetch(p, F, u, P);
            __syncthreads();
            d1_chunk(p, F, u, P, u, p.dt_bias[h], -__expf(p.a_log[h])); }
    }
    if (F.bid < 64) fcum_unit(p, F, F.bid);
    for (int u = F.bid; u < 256; u += F.G) { const int bh = u >> 2, seg = u & 3, b = bh >> 3, h = bh & 7;
        const bf16_t* proj = (const bf16_t*)(p.ws + WS_PROJ); float q2m = 0.f, k2m = 0.f;
#pragma unroll 8
        for (int r = F.tid >> 4; r < 1024; r += 32) { const bf16_t* rowp = proj + (size_t)(b * SEQ + seg * 1024 + r) * LDP + h * HD + 8 * (F.tid & 15);
            float qf[8], kf[8]; unpack8(*(const u32x4*)(rowp + FQ), qf); unpack8(*(const u32x4*)(rowp + FK), kf);
            float q2 = 0.f, k2 = 0.f;
#pragma unroll
            for (int e = 0; e < 8; ++e) { q2 += qf[e] * qf[e]; k2 += kf[e] * kf[e]; }
#pragma unroll
            for (int m = 1; m < 16; m <<= 1) { q2 += __shfl_xor(q2, m); k2 += __shfl_xor(k2, m); }
            q2m = fmaxf(q2m, q2); k2m = fmaxf(k2m, k2); }
#pragma unroll
        for (int m = 16; m < 64; m <<= 1) { q2m = fmaxf(q2m, __shfl_xor(q2m, m)); k2m = fmaxf(k2m, __shfl_xor(k2m, m)); }
        if (F.lane == 0) { unsigned* mx = (unsigned*)(p.ws + WS_CTL) + CW_QKMAX + 32 * bh; atomicMax(mx, __float_as_uint(q2m)); atomicMax(mx + 1, __float_as_uint(k2m)); } }
}

constexpr int SC_W = 0, SC_KT = 17408, SC_Q = 35840, SC_QK = 53248, SC_ST = 62464, SC_VT = 97280, SC_OB = 115712, SC_END = 133120, SC_UT = 133120, SC_DC = SC_UT + 16384, SC_NW = SC_DC + 64;
__device__ __forceinline__ void scan_unit(const Params& p, const Frame& F, int bh) {
    LAS unsigned char* lds = F.lds;
    const int tid = F.tid, lane = F.lane, wave = F.wave, fr = lane & 15, fq = lane >> 4;
    const int b = bh >> 3, h = bh & 7;
    const unsigned char* dn = p.ws + WS_DN + (size_t)bh * 64 * DN_CHUNK;
    const bf16_t* proj = (const bf16_t*)(p.ws + WS_PROJ); bf16_t* cat = (bf16_t*)(p.ws + WS_HBUF);
    if (wave < 4) {
        LAS unsigned char* ST = lds + SC_ST + wave * 8704; LAS unsigned char* VT = lds + SC_VT + wave * 4608;
        f32x4 S[8][2];
#pragma unroll
        for (int a = 0; a < 8; ++a) { S[a][0] = (f32x4){0.f, 0.f, 0.f, 0.f}; S[a][1] = (f32x4){0.f, 0.f, 0.f, 0.f}; }
#define LDF(base, pitch, rt, s) (*(const LAS bf16x8*)(lds + (base) + (16 * (rt) + fr) * (pitch) + (32 * (s) + 8 * fq) * 2))
#define SCHED() __builtin_amdgcn_sched_barrier(0)
#define SSTEP(c) do { \
            _Pragma("unroll") for (int dkt = 0; dkt < 8; ++dkt) _Pragma("unroll") for (int dvt = 0; dvt < 2; ++dvt) *(LAS u32x2*)(ST + (16 * dvt + fr) * 272 + (16 * dkt + 4 * fq) * 2) = pack4(S[dkt][dvt]); \
            LBAR();                                                                                 \
            bf16x8 bs[2][4], fa[8], fb[8]; \
            _Pragma("unroll") for (int dvt = 0; dvt < 2; ++dvt) _Pragma("unroll") for (int s = 0; s < 4; ++s) bs[dvt][s] = *(const LAS bf16x8*)(ST + (16 * dvt + fr) * 272 + (32 * s + 8 * fq) * 2); \
            _Pragma("unroll") for (int i = 0; i < 8; ++i) fa[i] = LDF(SC_W, 272, i >> 2, i & 3); \
            SCHED(); \
            f32x4 va[2][2], vb[2][2]; \
            const float DC = *(const LAS float*)(lds + SC_DC); \
            _Pragma("unroll") for (int it = 0; it < 2; ++it) _Pragma("unroll") for (int dvt = 0; dvt < 2; ++dvt) { \
                const u32x2 ua = *(const LAS u32x2*)(lds + SC_UT + (32 * wave + 16 * dvt + fr) * 128 + (16 * it + 4 * fq) * 2), ub = *(const LAS u32x2*)(lds + SC_UT + (32 * wave + 16 * dvt + fr) * 128 + (16 * (2 + it) + 4 * fq) * 2); \
                va[it][dvt] = (f32x4){bflo(ua.x), bfhi(ua.x), bflo(ua.y), bfhi(ua.y)}; vb[it][dvt] = (f32x4){bflo(ub.x), bfhi(ub.x), bflo(ub.y), bfhi(ub.y)}; } \
            _Pragma("unroll") for (int i = 0; i < 8; ++i) fb[i] = LDF(SC_W, 272, 2 + (i >> 2), i & 3); \
            SCHED(); \
            _Pragma("unroll") for (int i = 0; i < 8; ++i) { va[i >> 2][0] = mfma16(fa[i], bs[0][i & 3], va[i >> 2][0]); va[i >> 2][1] = mfma16(fa[i], bs[1][i & 3], va[i >> 2][1]); } \
            SCHED(); \
            _Pragma("unroll") for (int i = 0; i < 8; ++i) fa[i] = LDF(SC_KT, 144, i >> 1, i & 1); \
            _Pragma("unroll") for (int it = 0; it < 2; ++it) _Pragma("unroll") for (int dvt = 0; dvt < 2; ++dvt) *(LAS u32x2*)(VT + (16 * dvt + fr) * 144 + (16 * it + 4 * fq) * 2) = pack4(va[it][dvt]); \
            SCHED(); \
            _Pragma("unroll") for (int i = 0; i < 8; ++i) { vb[i >> 2][0] = mfma16(fb[i], bs[0][i & 3], vb[i >> 2][0]); vb[i >> 2][1] = mfma16(fb[i], bs[1][i & 3], vb[i >> 2][1]); } \
            _Pragma("unroll") for (int it = 0; it < 2; ++it) _Pragma("unroll") for (int dvt = 0; dvt < 2; ++dvt) *(LAS u32x2*)(VT + (16 * dvt + fr) * 144 + (16 * (2 + it) + 4 * fq) * 2) = pack4(vb[it][dvt]); \
            bf16x8 bv[2][2]; \
            _Pragma("unroll") for (int dvt = 0; dvt < 2; ++dvt) _Pragma("unroll") for (int s = 0; s < 2; ++s) bv[dvt][s] = *(const LAS bf16x8*)(VT + (16 * dvt + fr) * 144 + (32 * s + 8 * fq) * 2); \
            _Pragma("unroll") for (int i = 0; i < 8; ++i) fb[i] = LDF(SC_KT, 144, 4 + (i >> 1), i & 1); \
            SCHED(); \
            _Pragma("unroll") for (int dkt = 0; dkt < 8; ++dkt) { S[dkt][0] *= DC; S[dkt][1] *= DC; } \
            _Pragma("unroll") for (int i = 0; i < 8; ++i) { S[i >> 1][0] = mfma16(fa[i], bv[0][i & 1], S[i >> 1][0]); S[i >> 1][1] = mfma16(fa[i], bv[1][i & 1], S[i >> 1][1]); } \
            _Pragma("unroll") for (int i = 0; i < 8; ++i) { S[4 + (i >> 1)][0] = mfma16(fb[i], bv[0][i & 1], S[4 + (i >> 1)][0]); S[4 + (i >> 1)][1] = mfma16(fb[i], bv[1][i & 1], S[4 + (i >> 1)][1]); } \
            LBAR();                                                                                 \
              \
            bf16x8 bq[2][4];                                                                       \
            _Pragma("unroll") for (int dvt = 0; dvt < 2; ++dvt) _Pragma("unroll") for (int s = 0; s < 4; ++s) bq[dvt][s] = *(const LAS bf16x8*)(ST + (16 * dvt + fr) * 272 + (32 * s + 8 * fq) * 2); \
            _Pragma("unroll") for (int i = 0; i < 4; ++i) fa[i] = LDF(SC_Q, 272, 0, i); \
            fa[4] = LDF(SC_QK, 144, 0, 0); fa[5] = LDF(SC_QK, 144, 0, 1); \
            _Pragma("unroll") for (int i = 0; i < 4; ++i) fb[i] = LDF(SC_Q, 272, 1, i); \
            fb[4] = LDF(SC_QK, 144, 1, 0); fb[5] = LDF(SC_QK, 144, 1, 1); \
            SCHED(); \
            _Pragma("unroll") for (int it = 0; it < 4; ++it) { \
                f32x4 o0 = {0.f, 0.f, 0.f, 0.f}, o1 = {0.f, 0.f, 0.f, 0.f}; \
                if ((it & 1) == 0) { \
                    _Pragma("unroll") for (int i = 0; i < 4; ++i) { o0 = mfma16(fa[i], bq[0][i], o0); o1 = mfma16(fa[i], bq[1][i], o1); } \
                    _Pragma("unroll") for (int i = 0; i < 2; ++i) { o0 = mfma16(fa[4 + i], bv[0][i], o0); o1 = mfma16(fa[4 + i], bv[1][i], o1); } \
                    SCHED(); \
                    if (it + 2 < 4) { _Pragma("unroll") for (int i = 0; i < 4; ++i) fa[i] = LDF(SC_Q, 272, it + 2, i); fa[4] = LDF(SC_QK, 144, it + 2, 0); fa[5] = LDF(SC_QK, 144, it + 2, 1); } \
                } else { \
                    _Pragma("unroll") for (int i = 0; i < 4; ++i) { o0 = mfma16(fb[i], bq[0][i], o0); o1 = mfma16(fb[i], bq[1][i], o1); } \
                    _Pragma("unroll") for (int i = 0; i < 2; ++i) { o0 = mfma16(fb[4 + i], bv[0][i], o0); o1 = mfma16(fb[4 + i], bv[1][i], o1); } \
                    SCHED(); \
                    if (it + 2 < 4) { _Pragma("unroll") for (int i = 0; i < 4; ++i) fb[i] = LDF(SC_Q, 272, it + 2, i); fb[4] = LDF(SC_QK, 144, it + 2, 0); fb[5] = LDF(SC_QK, 144, it + 2, 1); } \
                } \
                _Pragma("unroll") for (int e = 0; e < 4; ++e) { const int i_ = 16 * it + 4 * fq + e; \
                    *(LAS bf16_t*)(lds + SC_OB + i_ * 272 + (32 * wave + fr) * 2) = f2bf(o0[e]); *(LAS bf16_t*)(lds + SC_OB + i_ * 272 + (32 * wave + 16 + fr) * 2) = f2bf(o1[e]); } \
                SCHED(); \
            } } while (0)
#pragma unroll 1
        for (int c2 = 0; c2 < 64; ++c2) { SSTEP(c2); }
#undef SSTEP
#undef LDF
#undef SCHED
        __syncthreads();
    } else {
        const int ht = tid - 256;
        u32x4 ra0[9], ra1[9], rb0[7], ru0[4], ru1[4]; float rd0, rd1;
#define LOADA(ra, ru, rd, cc) do { const int cc_ = (cc) < 64 ? (cc) : 63; const unsigned char* s_ = dn + (size_t)cc_ * DN_CHUNK; \
        _Pragma("unroll") for (int i = 0; i < 9; ++i) ra[i] = *(const u32x4*)(s_ + DN_W + (size_t)(ht + 256 * i) * 16); \
        _Pragma("unroll") for (int i = 0; i < 4; ++i) ru[i] = *(const u32x4*)(s_ + DN_UT + (size_t)(ht + 256 * i) * 16); rd = *(const float*)(s_ + DN_MISC); } while (0)
#define WRITEA(ra, ru, rd) do { _Pragma("unroll") for (int i = 0; i < 9; ++i) if (i < 8 || ht < 192) *(LAS u32x4*)(lds + SC_W + (ht + 256 * i) * 16) = ra[i]; \
        _Pragma("unroll") for (int i = 0; i < 4; ++i) *(LAS u32x4*)(lds + SC_UT + (ht + 256 * i) * 16) = ru[i]; if (ht == 0) *(LAS float*)(lds + SC_DC) = rd; } while (0)
#define LOADB(rb, cc) do { const int cc_ = (cc) < 64 ? (cc) : 63; const unsigned char* s_ = dn + (size_t)cc_ * DN_CHUNK + DN_Q; _Pragma("unroll") for (int i = 0; i < 7; ++i) rb[i] = *(const u32x4*)(s_ + (size_t)(ht + 256 * i) * 16); } while (0)
#define WRITEB(rb) do { _Pragma("unroll") for (int i = 0; i < 7; ++i) if (i < 6 || ht < 128) *(LAS u32x4*)(lds + SC_Q + (ht + 256 * i) * 16) = rb[i]; } while (0)
        LOADA(ra0, ru0, rd0, 0); WRITEA(ra0, ru0, rd0); LOADA(ra1, ru1, rd1, 1); LOADA(ra0, ru0, rd0, 2); LOADB(rb0, 0);
        const int ei = ht >> 2, ecg = ht & 3;
        const bf16_t* zbase = proj + (size_t)(b * SEQ + ei) * LDP + PZ + h * HD + 32 * ecg;
        if (ht < 32) *(LAS f32x4*)(lds + SC_NW + ht * 16) = *(const f32x4*)(p.norm_w + 4 * ht);
        u32x4 zr0[4];
#pragma unroll
        for (int k = 0; k < 4; ++k) zr0[k] = *(const u32x4*)(zbase + 8 * k);
#define EPILOG(ce) do { \
                const int row = b * SEQ + (ce) * 64 + ei; \
                float ss = 0.f; \
                _Pragma("unroll") for (int k = 0; k < 4; ++k) { float o[8]; unpack8(*(const LAS u32x4*)(lds + SC_OB + ei * 272 + (32 * ecg + 8 * k) * 2), o); \
                    _Pragma("unroll") for (int e = 0; e < 8; ++e) ss += o[e] * o[e]; } \
                ss += __shfl_xor(ss, 1); ss += __shfl_xor(ss, 2); \
                const float rs = rsqrtf(ss * (1.f / 128.f) + NORM_EPS); \
                bf16_t* op = cat + (size_t)row * DM + h * HD + 32 * ecg; \
                _Pragma("unroll") for (int k = 0; k < 4; ++k) { float z[8], o[8]; unpack8(zr0[k], z); unpack8(*(const LAS u32x4*)(lds + SC_OB + ei * 272 + (32 * ecg + 8 * k) * 2), o); float r[8]; \
                    const f32x4 nw0 = *(const LAS f32x4*)(lds + SC_NW + (32 * ecg + 8 * k) * 4), nw1 = *(const LAS f32x4*)(lds + SC_NW + (32 * ecg + 8 * k + 4) * 4); \
                    _Pragma("unroll") for (int e = 0; e < 8; ++e) r[e] = o[e] * rs * (e < 4 ? nw0[e] : nw1[e - 4]) * silu_f(z[e]); \
                    *(bf16x8*)(op + 8 * k) = pack8((f32x4){r[0], r[1], r[2], r[3]}, (f32x4){r[4], r[5], r[6], r[7]}); } } while (0)
#define HSTEP(c, RBX, RAY, RUY, RDY) do { \
            LBAR();                                                                                 \
            WRITEB(RBX); LOADB(RBX, (c) + 1); \
            { const int ce = (c) > 0 ? (c) - 1 : 0; EPILOG(ce); } \
            { _Pragma("unroll") for (int k = 0; k < 4; ++k) zr0[k] = *(const u32x4*)(zbase + (size_t)(c) * 64 * LDP + 8 * k); }     \
            LBAR();                                                                                 \
            WRITEA(RAY, RUY, RDY); LOADA(RAY, RUY, RDY, (c) + 3); \
            } while (0)
#pragma unroll 1
        for (int c2 = 0; c2 < 64; c2 += 2) { HSTEP(c2, rb0, ra1, ru1, rd1); HSTEP(c2 + 1, rb0, ra0, ru0, rd0); }
        __syncthreads();
        EPILOG(63);
#undef HSTEP
#undef EPILOG
#undef LOADA
#undef WRITEA
#undef LOADB
#undef WRITEB
    }
    __syncthreads();
}

namespace fox {
constexpr int D = 128, NW = 8, QBLK = 32, KVBLK = 64, QB = NW * QBLK;
constexpr int SHM_V = KVBLK * D * 2, SHM_K = KVBLK * D * 2;
constexpr int OFF_WS = 2 * SHM_V + 2 * SHM_K, OFF_BIAS = OFF_WS + NW * 64 * 4, OFF_Q = OFF_BIAS + 2 * 64 * 4, LDS_NEED = OFF_Q + NW * 8192;
constexpr float SCALE = 0.08838834764831845f, INV_SCALE = 11.313708498984761f, THR = 8.f;
constexpr int W = SEQ;
#define KSWZ(row, colB) ((row) * 256 + ((colB) ^ (((row) & 7) << 4)))
#define SBAR() __builtin_amdgcn_sched_barrier(0)
__device__ __forceinline__ int v_st(int k, int c) { const int kk = (k & ~0xC) | ((k & 4) << 1) | ((k & 8) >> 1); return ((kk >> 3) * 4 + (c >> 5)) * 512 + ((kk & 7) * 32 + (c & 31)) * 2; }
__device__ __forceinline__ int v_rd_base(int lane) { return ((lane & 3) << 3) | (((lane >> 2) & 3) << 6) | (((lane >> 4) & 1) << 5) | (((lane >> 5) & 1) << 8); }
constexpr int v_rd_off(int d0, int ks, int half) { return d0 * 512 + ks * 4096 + half * 2048; }
__device__ __forceinline__ int crow(int r, int hi) { return (r & 3) + 8 * (r >> 2) + 4 * hi; }
__device__ __forceinline__ void mask_tile(f32x16& p0, f32x16& p1, int dq, unsigned Wm) {
    const float NEG = -__builtin_inff();
#pragma unroll
    for (int r = 0; r < 16; ++r) {
        const int c = (r & 3) + 8 * (r >> 2);
        if ((unsigned)(dq - c) >= Wm) p0[r] = NEG;
        if ((unsigned)(dq - c - 32) >= Wm) p1[r] = NEG;
    }
}
__device__ __forceinline__ void partialSM(f32x16& p0, f32x16& p1, float& m_reg, float& mn, float& alpha) {
    float pmax = p0[0]; for (int r = 1; r < 16; ++r) pmax = fmaxf(pmax, p0[r]); for (int r = 0; r < 16; ++r) pmax = fmaxf(pmax, p1[r]);
    { auto rr = __builtin_amdgcn_permlane32_swap(__float_as_uint(pmax), __float_as_uint(pmax), false, false);
      pmax = fmaxf(__uint_as_float(rr[0]), __uint_as_float(rr[1])); }
    constexpr float C2 = 1.4426950408889634f * SCALE;
    if (__builtin_expect(__all((pmax - m_reg) * SCALE <= THR), 1)) { mn = m_reg; alpha = 1.f; }
    else { mn = fmaxf(m_reg, pmax); alpha = __builtin_amdgcn_exp2f((m_reg - mn) * C2); m_reg = mn; }
    const float mnL = -mn * C2;
    for (int r = 0; r < 16; ++r) p0[r] = fmaf(p0[r], C2, mnL); for (int r = 0; r < 16; ++r) p1[r] = fmaf(p1[r], C2, mnL);
    for (int r = 0; r < 16; ++r) p0[r] = __builtin_amdgcn_exp2f(p0[r]);
}
__device__ __forceinline__ void finishSM(f32x16& p0, f32x16& p1, float alpha, float& l_reg, bf16x8& pa0, bf16x8& pa1, bf16x8& pa2, bf16x8& pa3) {
    for (int r = 0; r < 16; ++r) p1[r] = __builtin_amdgcn_exp2f(p1[r]);
    float ps = 0; for (int r = 0; r < 16; ++r) ps += p0[r]; for (int r = 0; r < 16; ++r) ps += p1[r];
    { auto rr = __builtin_amdgcn_permlane32_swap(__float_as_uint(ps), __float_as_uint(ps), false, false);
      ps = __uint_as_float(rr[0]) + __uint_as_float(rr[1]); }
    l_reg = l_reg * alpha + ps;
#define PK4(P, B_, OUT) do { unsigned a0 = cvtpk(P[B_+0], P[B_+1]), a1 = cvtpk(P[B_+2], P[B_+3]);                          \
        unsigned b0 = cvtpk(P[B_+4], P[B_+5]), b1 = cvtpk(P[B_+6], P[B_+7]);                                             \
        auto r0 = __builtin_amdgcn_permlane32_swap(a0, b0, false, false); auto r1 = __builtin_amdgcn_permlane32_swap(a1, b1, false, false); \
        u32x4 w = {r0[0], r1[0], r0[1], r1[1]}; OUT = *reinterpret_cast<bf16x8*>(&w); } while (0)
    PK4(p0, 0, pa0); PK4(p0, 8, pa1); PK4(p1, 0, pa2); PK4(p1, 8, pa3);
#undef PK4
}
template <int KB>
__device__ __forceinline__ void qkt(f32x16& p0, f32x16& p1, const char* K_lds, const char* bias_lds, int r32, int hi, const char* qf) {
    const char* bb = bias_lds + KB * 256 + hi * 16;
#pragma unroll
    for (int g = 0; g < 4; ++g) { const f32x4 b0 = *reinterpret_cast<const f32x4*>(bb + g * 32), b1 = *reinterpret_cast<const f32x4*>(bb + 128 + g * 32);
        p0[4 * g] = b0[0]; p0[4 * g + 1] = b0[1]; p0[4 * g + 2] = b0[2]; p0[4 * g + 3] = b0[3];
        p1[4 * g] = b1[0]; p1[4 * g + 1] = b1[1]; p1[4 * g + 2] = b1[2]; p1[4 * g + 3] = b1[3]; }
    const char* kb[4];
#pragma unroll
    for (int dd = 0; dd < 4; ++dd) kb[dd] = K_lds + KB * SHM_K + KSWZ(r32, (dd * 16 + hi * 8) * 2);
#pragma unroll
    for (int d0 = 0; d0 < 8; ++d0) { const char* a = kb[d0 & 3] + (d0 >> 2) * 128;
        bf16x8 b0 = *reinterpret_cast<const bf16x8*>(a);
        bf16x8 b1 = *reinterpret_cast<const bf16x8*>(a + 32 * 256);
        const bf16x8 q = *reinterpret_cast<const bf16x8*>(qf + d0 * 1024);
        p0 = __builtin_amdgcn_mfma_f32_32x32x16_bf16(b0, q, p0, 0, 0, 0);
        p1 = __builtin_amdgcn_mfma_f32_32x32x16_bf16(b1, q, p1, 0, 0, 0); }
}
template <int VB>
__device__ __forceinline__ void pv_tile(f32x16* o, int vb0, bf16x8 pa0, bf16x8 pa1, bf16x8 pa2, bf16x8 pa3) {
    s16x4 ra[4], rb[4];
#define PV_RD(dst, hb) do { constexpr int b_ = VB * SHM_V + v_rd_off((hb) >> 1, 0, 0) + ((hb) & 1) * 8192; \
        TRRD(dst[0], vb0, b_); TRRD(dst[1], vb0, b_ + 2048); TRRD(dst[2], vb0, b_ + 4096); TRRD(dst[3], vb0, b_ + 6144); } while (0)
#define PV_MM(src, hb) do { \
        o[(hb) >> 1] = __builtin_amdgcn_mfma_f32_32x32x16_bf16(((hb) & 1) ? pa2 : pa0, join8(src[0], src[1]), o[(hb) >> 1], 0, 0, 0); \
        o[(hb) >> 1] = __builtin_amdgcn_mfma_f32_32x32x16_bf16(((hb) & 1) ? pa3 : pa1, join8(src[2], src[3]), o[(hb) >> 1], 0, 0, 0); } while (0)
#define PV_W4() do { asm volatile("s_waitcnt lgkmcnt(4)" ::: "memory"); SBAR(); } while (0)
#define PV_W0() do { asm volatile("s_waitcnt lgkmcnt(0)" ::: "memory"); SBAR(); } while (0)
    PV_RD(ra, 0);
    PV_RD(rb, 1); PV_W4(); PV_MM(ra, 0); SBAR();
    PV_RD(ra, 2); PV_W4(); PV_MM(rb, 1); SBAR();
    PV_RD(rb, 3); PV_W4(); PV_MM(ra, 2); SBAR();
    PV_RD(ra, 4); PV_W4(); PV_MM(rb, 3); SBAR();
    PV_RD(rb, 5); PV_W4(); PV_MM(ra, 4); SBAR();
    PV_RD(ra, 6); PV_W4(); PV_MM(rb, 5); SBAR();
    PV_RD(rb, 7); PV_W4(); PV_MM(ra, 6); SBAR();
    PV_W0(); PV_MM(rb, 7);
#undef PV_RD
#undef PV_MM
#undef PV_W4
#undef PV_W0
}
struct BlockRef { int bh, qb, jlo; };
__device__ __forceinline__ const bf16_t* ref_Q(unsigned char* ws, BlockRef r) { return (const bf16_t*)(ws + WS_PROJ) + (size_t)((r.bh >> 3) * SEQ + r.qb * QB) * LDP + FQ + (r.bh & 7) * HD; }
__device__ __forceinline__ const bf16_t* ref_K(unsigned char* ws, BlockRef r) { return (const bf16_t*)(ws + WS_PROJ) + (size_t)((r.bh >> 3) * SEQ) * LDP + FK + (r.bh & 7) * HD; }
__device__ __forceinline__ bf16_t* ref_O(unsigned char* ws, BlockRef r) { return (bf16_t*)(ws + WS_HBUF) + (size_t)((r.bh >> 3) * SEQ + r.qb * QB) * DM + 1024 + (r.bh & 7) * HD; }
__device__ __forceinline__ const float* ref_F(unsigned char* ws, BlockRef r) { return (const float*)(ws + WS_FCUM) + (size_t)r.bh * SEQ; }
struct Seam { bf16x8 qr[8]; bf16x8 st_v0, st_v1, st_k0, st_k1; };
#define ROW(p_, k0, rr) ((p_) + (unsigned)(((k0) + (rr)) * LDP + sc))
#define VMWN(n) asm volatile("s_waitcnt vmcnt(%0)" :: "i"(n) : "memory")
#define LD8(ptr) (*reinterpret_cast<const bf16x8*>(ptr))
#define SLOAD_H(Kp, Vp, Fp, k0, bf) do { const bf16_t* r0_ = ROW(Kp, k0, sr); const bf16_t* r1_ = ROW(Kp, k0, 32 + sr);             \
                         S.st_v0 = LD8(r0_ + (FV - FK)); S.st_v1 = LD8(r1_ + (FV - FK)); S.st_k0 = LD8(r0_); S.st_k1 = LD8(r1_); \
                         if (wid == 0) __builtin_amdgcn_global_load_lds((const unsigned*)((Fp) + (k0) + lane), (LAS unsigned*)(lds_las + OFF_BIAS + (bf) * 256), 4, 0, 0); } while (0)
#define SWRITE_HK(bf) do { *(bf16x8*)(K_lds + (bf) * SHM_K + kws) = S.st_k0; *(bf16x8*)(K_lds + (bf) * SHM_K + kws + 32 * 256) = S.st_k1; } while (0)
#define SWRITE_HV(bf) do { *(bf16x8*)(V_lds + (bf) * SHM_V + vst0) = S.st_v0; *(bf16x8*)(V_lds + (bf) * SHM_V + vst1) = S.st_v1; } while (0)
#define SWRITE_H(bf) do { SWRITE_HV(bf); SWRITE_HK(bf); } while (0)
__device__ __forceinline__ void prime(unsigned char* wsb, const BlockRef cur, char* lds, LAS unsigned char* lds_las, Seam& S, int wv) {
    const int wid = wv, lane = lane_id(), tid = wid * 64 + lane, r32 = lane & 31, hi = lane >> 5;
    const int sr = tid >> 4, sc = (tid & 15) * 8, kws = KSWZ(sr, sc * 2); char* K_lds = lds + 2 * SHM_V; char* bias_lds = lds + OFF_BIAS;
    { const bf16_t* q_ = ref_Q(wsb, cur); for (int d0 = 0; d0 < 8; ++d0) S.qr[d0] = LD8(q_ + (unsigned)((wid * QBLK + r32) * LDP + d0 * 16 + hi * 8)); }
    SLOAD_H(ref_K(wsb, cur), 0, ref_F(wsb, cur), cur.jlo * KVBLK, 0); VM0(); SWRITE_HK(0);
    for (int d0 = 0; d0 < 8; ++d0) *(bf16x8*)(lds + OFF_Q + wid * 8192 + d0 * 1024 + lane * 16) = S.qr[d0];
    __syncthreads();
}
__device__ __forceinline__ void block(unsigned char* wsb, const BlockRef cur, const BlockRef nxt, char* lds, LAS unsigned char* lds_las, Seam& S, int wv) {
    const int wid = wv, lane = lane_id(), tid = wid * 64 + lane, r32 = lane & 31, hi = lane >> 5;
    const int P0 = cur.qb * QB;
    const int j_hi = (P0 + QB - 1) / KVBLK + 1, j_lo = cur.jlo;
    const int NT = j_hi - j_lo;
    const int qlo = P0 + wid * QBLK, qm = qlo + r32 - 4 * hi;
    char* V_lds = lds; char* K_lds = lds + 2 * SHM_V; char* bias_lds = lds + OFF_BIAS; const char* qf = lds + OFF_Q + wid * 8192 + lane * 16;
    float* ws = (float*)(lds + OFF_WS) + wid * 64; float* li_l = ws, * al_l = ws + 32;
    float m_reg = -1e30f, l_reg = 0; f32x16 o[4] = {};
    const int sr = tid >> 4, sc = (tid & 15) * 8, vst0 = v_st(sr, sc), vst1 = v_st(32 + sr, sc), kws = KSWZ(sr, sc * 2);
    const int vb0 = (int)(uintptr_t)V_lds + v_rd_base(lane);
    const bf16_t* Kh = ref_K(wsb, cur); const float* Fh = ref_F(wsb, cur);
#define RESC(a) do { if (__any((a) < 1.f)) { if (hi == 0) al_l[r32] = (a); asm volatile("s_waitcnt lgkmcnt(0)" ::: "memory");              \
                     for (int d_ = 0; d_ < 4; ++d_) for (int r = 0; r < 16; ++r) o[d_][r] *= al_l[crow(r, hi)]; } } while (0)
#define KBASE(t) ((j_lo + (t)) * KVBLK)
#define MASKT(P0_, P1_, t) do { const int kb_ = KBASE(t); if (kb_ + KVBLK - 1 > qlo) mask_tile(P0_, P1_, qm - kb_, (unsigned)W); } while (0)
    constexpr int NQL = 8;
#define SEAM_K0() do { VMWN(NQL); SWRITE_HK(0); SBAR(); } while (0)
    f32x16 pA0, pA1, pB0, pB1; float mnA, mnB, alA, alB; bf16x8 pa0, pa1, pa2, pa3;
    SWRITE_HV(0); SBAR();
    if (NT > 1) { SLOAD_H(Kh, 0, Fh, KBASE(1), 1); }
    SBAR(); qkt<0>(pA0, pA1, K_lds, bias_lds, r32, hi, qf);
    MASKT(pA0, pA1, 0); partialSM(pA0, pA1, m_reg, mnA, alA);
    if (NT > 1) { VM0(); SWRITE_H(1); }
    __syncthreads();
#define HALF_STEP(PX0, PX1, mnX, alX, PY0, PY1, alY, t, KB, VB, SB) do {                                                      \
        SBAR(); qkt<KB>(PX0, PX1, K_lds, bias_lds, r32, hi, qf);                                             \
        finishSM(PY0, PY1, alY, l_reg, pa0, pa1, pa2, pa3); SBAR();                                                           \
        if ((t) + 1 < NT) { SLOAD_H(Kh, 0, Fh, KBASE((t) + 1), SB); SBAR(); }                                               \
        pv_tile<VB>(o, vb0, pa0, pa1, pa2, pa3); MASKT(PX0, PX1, (t)); partialSM(PX0, PX1, m_reg, mnX, alX);                                        \
        __syncthreads();                                                                                                      \
        if ((t) + 1 < NT) { VM0(); SWRITE_H(SB); }                                                                          \
        RESC(alX); __syncthreads(); } while (0)
    for (int t = 1; t + 1 < NT; t += 2) {
        HALF_STEP(pB0, pB1, mnB, alB, pA0, pA1, alA, t, 1, 0, 0);
        HALF_STEP(pA0, pA1, mnA, alA, pB0, pB1, alB, t + 1, 0, 1, 1);
    }
    const bool even = (NT & 1) == 0;
    if (even) { SBAR(); qkt<1>(pB0, pB1, K_lds, bias_lds, r32, hi, qf); SBAR(); }
    SLOAD_H(ref_K(wsb, nxt), 0, ref_F(wsb, nxt), nxt.jlo * KVBLK, 0); SBAR();
    { const bf16_t* q_ = ref_Q(wsb, nxt);
#pragma unroll
    for (int d0 = 0; d0 < 8; ++d0) S.qr[d0] = LD8(q_ + (unsigned)((wid * QBLK + r32) * LDP + d0 * 16 + hi * 8)); }
    SBAR();
    finishSM(pA0, pA1, alA, l_reg, pa0, pa1, pa2, pa3); SBAR();
    pv_tile<0>(o, vb0, pa0, pa1, pa2, pa3);
    if (even) { MASKT(pB0, pB1, NT - 1); partialSM(pB0, pB1, m_reg, mnB, alB); __syncthreads(); RESC(alB);
        finishSM(pB0, pB1, alB, l_reg, pa0, pa1, pa2, pa3); SBAR(); pv_tile<1>(o, vb0, pa0, pa1, pa2, pa3); }
    SBAR(); SEAM_K0();
    if (hi == 0) li_l[r32] = l_reg; asm volatile("s_waitcnt lgkmcnt(0)" ::: "memory");
    float rli[16];
#pragma unroll
    for (int r = 0; r < 16; ++r) rli[r] = __builtin_amdgcn_rcpf(li_l[crow(r, hi)]);
    bf16_t* Ow = ref_O(wsb, cur) + (size_t)(wid * QBLK) * DM;
#pragma unroll
    for (int r = 0; r < 16; ++r) { const int orow = crow(r, hi);
#pragma unroll
        for (int d0 = 0; d0 < 4; ++d0) { const float v = o[d0][r] * rli[r];
            const float vn = __shfl_xor(v, 1);
            if ((r32 & 1) == 0) *(unsigned*)(Ow + (unsigned)(orow * DM + d0 * 32 + r32)) = cvtpk(v, vn); } }
#pragma unroll
    for (int d0 = 0; d0 < 8; ++d0) *(bf16x8*)(lds + OFF_Q + wid * 8192 + d0 * 1024 + lane * 16) = S.qr[d0];
    __syncthreads();
#undef RESC
#undef KBASE
#undef MASKT
#undef SEAM_K0
#undef HALF_STEP
}
#undef ROW
#undef VMWN
#undef SLOAD_H
#undef SWRITE_HK
#undef SWRITE_HV
#undef SWRITE_H
#undef LD8
}

__device__ __forceinline__ int attn_pull(unsigned* qbase, int& qx, int x0, bool& dead) {
    if (dead) return -1;
    for (;;) {
        const int k = (int)__hip_atomic_fetch_add(qbase + 64 * qx, 1u, __ATOMIC_RELAXED, __HIP_MEMORY_SCOPE_AGENT);
        if (k < 128) return qx * 128 + k;
        qx = (qx + 1) & 7; if (qx == x0) { dead = true; return -1; }
    }
}
__device__ __forceinline__ int fox_jlo(const Params& p, int bh, int qb, int lane) {
    const float* Bv = (const float*)(p.ws + WS_FCUM) + (size_t)bh * SEQ;
    const unsigned* mx = (const unsigned*)(p.ws + WS_CTL) + CW_QKMAX + 32 * bh;
    const float q2 = __uint_as_float(__hip_atomic_load(mx, __ATOMIC_RELAXED, __HIP_MEMORY_SCOPE_AGENT)), k2 = __uint_as_float(__hip_atomic_load(mx + 1, __ATOMIC_RELAXED, __HIP_MEMORY_SCOPE_AGENT));
    const float thr = (26.f + 2.f * fox::SCALE * sqrtf(q2 * k2) * 1.01f) * fox::INV_SCALE;
    const float b1 = Bv[64 * lane + 63], b0 = Bv[qb * fox::QB];
    const unsigned long long m = __ballot(b1 < b0 - thr);
    return __builtin_popcountll(m);
}
__device__ __forceinline__ fox::BlockRef attn_ref(const Params& p, int item, int lane) { fox::BlockRef r; const int x = item >> 7, k = item & 127; r.bh = 8 * x + (k & 7); r.qb = 15 - (k >> 3);
    r.jlo = __builtin_amdgcn_readfirstlane(fox_jlo(p, r.bh, r.qb, lane)); return r; }
__device__ __forceinline__ void p4_attention(const Params& p, const Frame& F, char* lds_generic) {
    using namespace fox;
    unsigned* qbase = (unsigned*)(p.ws + WS_CTL) + CW_QUEUE;
    volatile LAS int* qslot = (volatile LAS int*)(F.lds + LDS_MISC + 64);
    const int x0 = (int)(xb_xcc_id() & 7u); int qx = x0; bool dead = false;
    if (F.tid == 0) { qslot[0] = attn_pull(qbase, qx, x0, dead); qslot[1] = attn_pull(qbase, qx, x0, dead); }
    __syncthreads();
    int L = qslot[0], Ln = qslot[1];
    if (L < 0) { __syncthreads(); return; }
    BlockRef cur = attn_ref(p, L, F.lane);
    Seam S;
    prime(p.ws, cur, lds_generic, F.lds, S, F.wave);
    for (int it = 0;; ++it) {
        const bool last = Ln < 0;
        const BlockRef nxt = last ? cur : attn_ref(p, Ln, F.lane);
        if (F.tid == 0) qslot[it & 1] = attn_pull(qbase, qx, x0, dead);
        block(p.ws, cur, nxt, lds_generic, F.lds, S, F.wave);
        if (last) break;
        cur = nxt; L = Ln; Ln = qslot[it & 1];
    }
    __syncthreads();
}

__device__ __forceinline__ unsigned lnperm(unsigned c) { return (c & ~511u) | (((c >> 2) & 1u) << 8) | (((c & 511u) >> 3) << 2) | (c & 3u); }
constexpr int L1_G1P = 0, L1_LNG = 8192, L1_LNB = 16384, L1_SC2P = 24576, L1_SH2 = 32768, L1_LG = 40960;
__device__ __forceinline__ void p6_ln1_router(const Params& p, const Frame& F) {
    const float* mod = (const float*)(p.ws + WS_MOD); const bf16_t* y1 = (const bf16_t*)(p.ws + WS_Y1); bf16_t* x1 = (bf16_t*)(p.ws + WS_X1); bf16_t* h2 = (bf16_t*)(p.ws + WS_H2);
    const bf16_t* rw = (const bf16_t*)(p.ws + WS_RTW); unsigned char* h2f8 = p.ws + WS_H2F8;
    unsigned* cnt = (unsigned*)(p.ws + WS_CTL) + CW_CNT;
    int* rt_e = (int*)(p.ws + WS_RT + RT_E); float* rt_w = (float*)(p.ws + WS_RT + RT_W); int* rt_pos = (int*)(p.ws + WS_RT + RT_POS); int* elist = (int*)(p.ws + WS_ELIST);
    LAS float* lg = (LAS float*)(F.lds + L1_LG + F.wave * 4096);
    const int fr = F.lane & 15, fq = F.lane >> 4;
    int bcur = -1;
    for (int g0 = F.bid; g0 < NTOK / 128; g0 += F.G) {
        const int b = (g0 * 128) / SEQ;
        if (b != bcur) { __syncthreads(); bcur = b; const float* mb = mod + (size_t)b * (6 * DM);
            for (unsigned i = (unsigned)F.tid; i < (unsigned)DM; i += 512u) { LAS float* L = (LAS float*)F.lds; const float* m2 = mb + 2 * DM; const float* m3 = mb + 3 * DM; const float* m4 = mb + 4 * DM;
                const unsigned pi = lnperm(i); L[L1_G1P / 4 + pi] = 1.f + m2[i]; L[L1_LNG / 4 + pi] = p.ln1_g[i]; L[L1_LNB / 4 + pi] = p.ln1_b[i]; L[L1_SC2P / 4 + pi] = 1.f + m4[i]; L[L1_SH2 / 4 + pi] = m3[i]; }
            __syncthreads(); }
        const int row0 = g0 * 128 + F.wave * 16;
#pragma unroll 1
        for (int pr = 0; pr < 8; ++pr) {
            f32x4 xa[2][8]; u32x4 ya[2][4];
#pragma unroll
            for (int r = 0; r < 2; ++r)
#pragma unroll
                for (int i = 0; i < 4; ++i) { const size_t o = (size_t)(row0 + 2 * pr + r) * DM + i * 512 + F.lane * 8;
                    xa[r][2 * i] = __builtin_nontemporal_load((const f32x4*)(p.x + o)); xa[r][2 * i + 1] = __builtin_nontemporal_load((const f32x4*)(p.x + o + 4)); ya[r][i] = *(const u32x4*)(y1 + o); }
#pragma unroll
            for (int r = 0; r < 2; ++r) {
                float v[32]; float s = 0.f;
#pragma unroll
                for (int i = 0; i < 4; ++i) { const int col = i * 512 + F.lane * 8; const int pcol = i * 512 + F.lane * 4; float yf[8]; unpack8(ya[r][i], yf);
                    const f32x4 ga = *(const LAS f32x4*)(F.lds + L1_G1P + pcol * 4), gb = *(const LAS f32x4*)(F.lds + L1_G1P + pcol * 4 + 1024);
#pragma unroll
                    for (int e = 0; e < 4; ++e) { v[i * 8 + e] = ALPHA * xa[r][2 * i][e] + ga[e] * yf[e]; v[i * 8 + 4 + e] = ALPHA * xa[r][2 * i + 1][e] + gb[e] * yf[4 + e]; }
#pragma unroll
                    for (int e = 0; e < 8; ++e) s += v[i * 8 + e]; }
                const float mean = wave_sum(s) * (1.f / DM);
                float q = 0.f;
#pragma unroll
                for (int k = 0; k < 32; ++k) { const float d = v[k] - mean; q += d * d; }
                const float rstd = rsqrtf(wave_sum(q) * (1.f / DM) + LN_EPS);
#pragma unroll
                for (int i = 0; i < 4; ++i) { const int col = i * 512 + F.lane * 8; const int pcol = i * 512 + F.lane * 4; const size_t o = (size_t)(row0 + 2 * pr + r) * DM + col;
                    const f32x4 g0v = *(const LAS f32x4*)(F.lds + L1_LNG + pcol * 4), g1v = *(const LAS f32x4*)(F.lds + L1_LNG + pcol * 4 + 1024), b0 = *(const LAS f32x4*)(F.lds + L1_LNB + pcol * 4), b1 = *(const LAS f32x4*)(F.lds + L1_LNB + pcol * 4 + 1024);
                    const f32x4 c0 = *(const LAS f32x4*)(F.lds + L1_SC2P + pcol * 4), c1 = *(const LAS f32x4*)(F.lds + L1_SC2P + pcol * 4 + 1024), s0 = *(const LAS f32x4*)(F.lds + L1_SH2 + pcol * 4), s1 = *(const LAS f32x4*)(F.lds + L1_SH2 + pcol * 4 + 1024);
                    f32x4 o0, o1, h0, h1;
#pragma unroll
                    for (int e = 0; e < 4; ++e) { o0[e] = (v[i * 8 + e] - mean) * rstd * g0v[e] + b0[e]; o1[e] = (v[i * 8 + 4 + e] - mean) * rstd * g1v[e] + b1[e];
                        h0[e] = o0[e] * c0[e] + s0[e]; h1[e] = o1[e] * c1[e] + s1[e]; }
                    __builtin_nontemporal_store(pack8(o0, o1), (bf16x8*)(x1 + o));
                    *(bf16x8*)(h2 + o) = pack8(h0, h1);
                    *(u32x2*)(h2f8 + o) = (u32x2){pack_fp8x4(h0[0], h0[1], h0[2], h0[3]), pack_fp8x4(h1[0], h1[1], h1[2], h1[3])}; }
                __builtin_amdgcn_sched_barrier(0);
            }
        }
        VM0();
        f32x4 acc[3]; acc[0] = acc[1] = acc[2] = (f32x4){0.f, 0.f, 0.f, 0.f};
        const bf16_t* ar = h2 + (size_t)(row0 + fr) * DM + 8 * fq;
#pragma unroll 4
        for (int s_ = 0; s_ < 64; ++s_) {
            const bf16x8 a = *(const bf16x8*)(ar + 32 * s_);
#pragma unroll
            for (int ct = 0; ct < 3; ++ct) { const bf16_t* bp = rw + (unsigned)(((ct * 64 + s_) * 64 + F.lane) * 8);
                acc[ct] = mfma16(a, *(const bf16x8*)bp, acc[ct]); acc[ct] = mfma16(a, *(const bf16x8*)(bp + 48 * DM), acc[ct]); }
        }
#pragma unroll
        for (int ct = 0; ct < 3; ++ct)
#pragma unroll
            for (int j = 0; j < 4; ++j) lg[(4 * fq + j) * 48 + 16 * ct + fr] = acc[ct][j];
        asm volatile("s_waitcnt lgkmcnt(0)" ::: "memory");
        if (F.lane < 16) {
            const int t = row0 + F.lane; const LAS float* l = lg + F.lane * 48;
            float gl[4];
#pragma unroll
            for (int g = 0; g < 4; ++g) gl[g] = l[g] + p.b_rg[g];
            float gm = gl[0]; int gi = 0;
#pragma unroll
            for (int g = 1; g < 4; ++g) if (gl[g] > gm) { gm = gl[g]; gi = g; }
            float gs = 0.f;
#pragma unroll
            for (int g = 0; g < 4; ++g) gs += __expf(gl[g] - gm);
            const float gw = 1.f / gs;
            float el[8];
#pragma unroll
            for (int e = 0; e < 8; ++e) el[e] = l[4 + 8 * gi + e] + p.b_re[8 * gi + e];
            float m0 = el[0]; int e0 = 0;
#pragma unroll
            for (int e = 1; e < 8; ++e) if (el[e] > m0) { m0 = el[e]; e0 = e; }
            float m1 = -__builtin_inff(); int e1 = 0;
#pragma unroll
            for (int e = 0; e < 8; ++e) if (e != e0 && el[e] > m1) { m1 = el[e]; e1 = e; }
            const float p1 = __expf(m1 - m0); const float w0 = gw / (1.f + p1), w1 = gw * p1 / (1.f + p1);
            const int x0 = 8 * gi + e0, x1i = 8 * gi + e1;
            const unsigned q0 = atomicAdd(cnt + 32 * x0, 1u), q1 = atomicAdd(cnt + 32 * x1i, 1u);
            rt_e[2 * t] = x0; rt_e[2 * t + 1] = x1i; rt_w[2 * t] = w0; rt_w[2 * t + 1] = w1; rt_pos[2 * t] = (int)q0; rt_pos[2 * t + 1] = (int)q1;
            elist[(unsigned)x0 * (unsigned)NTOK + q0] = t; elist[(unsigned)x1i * (unsigned)NTOK + q1] = t;
        }
    }
    __syncthreads();
}
__device__ __forceinline__ void slot_prefix(const Params& p, const Frame& F, LAS int* ps) {
    if (F.wave == 0) {
        const unsigned* cnt = (const unsigned*)(p.ws + WS_CTL) + CW_CNT;
        const int c = F.lane < NEXP ? (int)__hip_atomic_load(cnt + 32 * (F.lane & 31), __ATOMIC_RELAXED, __HIP_MEMORY_SCOPE_AGENT) : 0;
        const int pad = (c + 255) / 256 * 256; int incl = pad;
#pragma unroll
        for (int o = 1; o < 32; o <<= 1) { const int t = __shfl_up(incl, o); if (F.lane >= o) incl += t; }
        if (F.lane < NEXP) { ps[F.lane] = incl - pad; ps[32 + F.lane] = c; }
        if (F.lane == NEXP - 1) ps[64] = incl;
    }
}
constexpr int L2_G2P = 0, L2_LNG = 8192, L2_LNB = 16384, L2_PS = 24576;
__device__ __forceinline__ void p11_final(const Params& p, const Frame& F) {
    const float* mod = (const float*)(p.ws + WS_MOD); const bf16_t* x1 = (const bf16_t*)(p.ws + WS_X1); const unsigned char* yb = p.ws + WS_YB; const int* rt_e = (const int*)(p.ws + WS_RT + RT_E); const int* rt_pos = (const int*)(p.ws + WS_RT + RT_POS); const float* rt_w = (const float*)(p.ws + WS_RT + RT_W);
    LAS int* ps = (LAS int*)(F.lds + L2_PS);
    slot_prefix(p, F, ps);
    int bcur = -1;
    for (int g0 = F.bid; g0 < NTOK / 128; g0 += F.G) {
        const int b = (g0 * 128) / SEQ;
        if (b != bcur) { __syncthreads(); bcur = b; const float* mb = mod + (size_t)b * (6 * DM);
            for (unsigned i = (unsigned)F.tid; i < (unsigned)DM; i += 512u) { LAS float* L = (LAS float*)F.lds; const float* m5 = mb + 5 * DM; const unsigned pi = lnperm(i); L[L2_G2P / 4 + pi] = 1.f + m5[i]; L[L2_LNG / 4 + pi] = p.ln2_g[i]; L[L2_LNB / 4 + pi] = p.ln2_b[i]; }
            __syncthreads(); }
        const int row0 = g0 * 128 + F.wave * 16;
#pragma unroll 1
        for (int pr = 0; pr < 8; ++pr) {
            u32x4 xv[2][4]; u32x2 ya[2][4], yc[2][4]; float wa[2], wc[2];
#pragma unroll
            for (int r = 0; r < 2; ++r) { const int row = row0 + 2 * pr + r; const int sa = ps[rt_e[2 * row]] + rt_pos[2 * row], sb = ps[rt_e[2 * row + 1]] + rt_pos[2 * row + 1]; wa[r] = rt_w[2 * row] * Y8_INV; wc[r] = rt_w[2 * row + 1] * Y8_INV;
#pragma unroll
                for (int i = 0; i < 4; ++i) { const int col = i * 512 + F.lane * 8;
                    xv[r][i] = *(const u32x4*)(x1 + (size_t)row * DM + col); ya[r][i] = *(const u32x2*)(yb + (size_t)sa * DM + col); yc[r][i] = *(const u32x2*)(yb + (size_t)sb * DM + col); } }
#pragma unroll
            for (int r = 0; r < 2; ++r) { const int row = row0 + 2 * pr + r;
                float v[32]; float s = 0.f;
#pragma unroll
                for (int i = 0; i < 4; ++i) { const int col = i * 512 + F.lane * 8; const int pcol = i * 512 + F.lane * 4; float xf[8], yf[8], zf[8]; unpack8(xv[r][i], xf); unpack8_fp8(ya[r][i], yf); unpack8_fp8(yc[r][i], zf);
                    const f32x4 ga = *(const LAS f32x4*)(F.lds + L2_G2P + pcol * 4), gb = *(const LAS f32x4*)(F.lds + L2_G2P + pcol * 4 + 1024);
#pragma unroll
                    for (int e = 0; e < 4; ++e) { v[i * 8 + e] = ALPHA * xf[e] + ga[e] * (wa[r] * yf[e] + wc[r] * zf[e]); v[i * 8 + 4 + e] = ALPHA * xf[4 + e] + gb[e] * (wa[r] * yf[4 + e] + wc[r] * zf[4 + e]); }
#pragma unroll
                    for (int e = 0; e < 8; ++e) s += v[i * 8 + e]; }
                const float mean = wave_sum(s) * (1.f / DM);
                float q = 0.f;
#pragma unroll
                for (int k = 0; k < 32; ++k) { const float d = v[k] - mean; q += d * d; }
                const float rstd = rsqrtf(wave_sum(q) * (1.f / DM) + LN_EPS);
#pragma unroll
                for (int i = 0; i < 4; ++i) { const int col = i * 512 + F.lane * 8; const int pcol = i * 512 + F.lane * 4;
                    const f32x4 g0v = *(const LAS f32x4*)(F.lds + L2_LNG + pcol * 4), g1v = *(const LAS f32x4*)(F.lds + L2_LNG + pcol * 4 + 1024), b0 = *(const LAS f32x4*)(F.lds + L2_LNB + pcol * 4), b1 = *(const LAS f32x4*)(F.lds + L2_LNB + pcol * 4 + 1024);
                    f32x4 o0, o1;
#pragma unroll
                    for (int e = 0; e < 4; ++e) { o0[e] = (v[i * 8 + e] - mean) * rstd * g0v[e] + b0[e]; o1[e] = (v[i * 8 + 4 + e] - mean) * rstd * g1v[e] + b1[e]; }
                    __builtin_nontemporal_store(o0, (f32x4*)(p.out + (size_t)row * DM + col)); __builtin_nontemporal_store(o1, (f32x4*)(p.out + (size_t)row * DM + col + 4)); }
                __builtin_amdgcn_sched_barrier(0);
            }
        }
    }
    __syncthreads();
}

typedef const __attribute__((address_space(4))) Params* kparams_t;
__device__ __forceinline__ Params load_params() {
#if defined(__HIP_DEVICE_COMPILE__)
    kparams_t pp = (kparams_t)__builtin_amdgcn_kernarg_segment_ptr(); asm volatile("" : "+s"(pp)); return *pp;
#else
    return Params{};
#endif
}
__device__ __forceinline__ Frame make_frame(unsigned char* lds_raw, int wv) {
    Frame F; F.lds = (LAS unsigned char*)lds_raw; F.lane = lane_id(); F.wave = wv; F.tid = wv * 64 + F.lane; F.G = gridDim.x; F.bid = blockIdx.x; return F;
}
constexpr int MOE_TL = 320, MOE_GI = 448;
template <bool TOK> __device__ __forceinline__ LAS int* moe_tables(const Params& p, const Frame& F, int& ntiles, int ntl) {
    LAS int* tl = (LAS int*)(F.lds + pg8::STAGE_BYTES); LAS int* ps = tl + MOE_TL;
    slot_prefix(p, F, ps);
    __syncthreads();
    ntiles = ps[64] / 256;
    for (int i = F.tid; i < ntiles; i += 512) { int e = 0;
#pragma unroll
        for (int x = 1; x < NEXP; ++x) if (ps[x] <= 256 * i) e = x;
        tl[i] = e; }
    __syncthreads();
    if constexpr (TOK) { const int* elist = (const int*)(p.ws + WS_ELIST);
        const int total = ntiles * ntl;
        if (F.tid < 256) {
            int tv[6];
#pragma unroll
            for (int u = 0; u < 6; ++u) { const int L = u * F.G + F.bid; const bool ok = L < total; const int t = ok ? L / ntl : 0, e = tl[t], pos = 256 * t - ps[e] + F.tid; const bool in = ok && pos < ps[32 + e];
                const int v = elist[in ? (unsigned)e * (unsigned)NTOK + (unsigned)pos : 0u]; tv[u] = in ? v : 0; }
#pragma unroll
            for (int u = 0; u < 6; ++u) if (u * F.G + F.bid < total) tl[MOE_GI + u * 256 + F.tid] = tv[u];
            for (int u = 6; u < 24; ++u) { const int L = u * F.G + F.bid; if (L >= total) break;
                const int t = L / ntl, e = tl[t], pos = 256 * t - ps[e] + F.tid; tl[MOE_GI + u * 256 + F.tid] = pos < ps[32 + e] ? elist[(unsigned)e * (unsigned)NTOK + (unsigned)pos] : 0; } }
        __syncthreads(); }
    return tl;
}
template <unsigned MASK> __global__ void __launch_bounds__(512, 2) fwd(Params p_unused) {
    extern __shared__ __attribute__((aligned(16))) unsigned char lds_raw[];
    volatile LAS unsigned* misc = (volatile LAS unsigned*)((LAS unsigned char*)lds_raw + LDS_MISC);
    const int wv = __builtin_amdgcn_readfirstlane((int)threadIdx.x >> 6);
    __builtin_assume(wv >= 0 && wv < 8);
    if (wv == 0) misc[lane_id()] = 0u;
    __syncthreads();
    int lo, hi; unsigned* barw;
    { const Params p = load_params(); lo = p.ph_lo; hi = p.ph_hi; barw = (unsigned*)(p.ws + WS_CTL); }
    XcdBarrier bar; bar.bar = barw; bar.x = 0; bar.st = misc;
    bar.wv = wv;
    if (hi - lo > 1) bar = xcd_barrier_post(barw, misc, wv);
#define IN(k) (((MASK >> (k)) & 1u) && lo <= (k) && (k) < hi)
#define SEAM(k) do { if (IN(k) && IN((k) + 1)) xcd_barrier(bar); } while (0)
#ifndef PROBE_REP
#define PROBE_REP 0u
#endif
#define PHASE(k, ...) if (IN(k)) __VA_ARGS__ if (((PROBE_REP >> (k)) & 1u) && IN(k)) { xcd_barrier(bar); __VA_ARGS__ } SEAM(k);
    PHASE(0, { const Params p = load_params(); const Frame F = make_frame(lds_raw, wv); p0_prologue(p, F); })
    PHASE(1, { const Params p = load_params(); const Frame F = make_frame(lds_raw, wv); p1_hpass(p, F); })
    PHASE(2, { const Params p = load_params(); const Frame F = make_frame(lds_raw, wv); pg8::Gemm g{(const bf16_t*)(p.ws + WS_HBUF), (const bf16_t*)(p.ws + WS_WIN), NTOK, LDP, DM}; pg8::StaticOrder S; S.init(NTOK, LDP, F.G, F.bid);
        pg8::EpiBf16T<true> E{(bf16_t*)(p.ws + WS_PROJ), LDP}; pg8::gemm_phase<pg8::EpiBf16T<true>, pg8::StaticOrder, false>(F.lds, g, S, E, nullptr, F.wave); })
    PHASE(3, { const Params p = load_params(); const Frame F = make_frame(lds_raw, wv); p3_dnprep(p, F); })
    PHASE(4, { const Params p = load_params(); const Frame F = make_frame(lds_raw, wv); const int ncv = F.G - 64 < CVT_WGS ? F.G - 64 : CVT_WGS; if (F.bid < 64) scan_unit(p, F, F.bid); else if (F.bid < 64 + ncv) moe_weight_tiles(p, F, F.bid - 64, ncv);
        p4_attention(p, F, (char*)lds_raw); })
    PHASE(6, { const Params p = load_params(); const Frame F = make_frame(lds_raw, wv); pg8::Gemm g{(const bf16_t*)(p.ws + WS_HBUF), (const bf16_t*)(p.ws + WS_WOUT), NTOK, DM, DM}; pg8::StaticOrder S; S.init(NTOK, DM, F.G, F.bid);
        pg8::EpiBf16 E{(bf16_t*)(p.ws + WS_Y1), DM}; pg8::gemm_phase<pg8::EpiBf16, pg8::StaticOrder, false>(F.lds, g, S, E, nullptr, F.wave); })
    PHASE(7, { const Params p = load_params(); const Frame F = make_frame(lds_raw, wv); p6_ln1_router(p, F); })
    PHASE(10, { const Params p = load_params(); const Frame F = make_frame(lds_raw, wv); int ntiles;
        LAS int* tl = moe_tables<true>(p, F, ntiles, 4);
        pg8::Gemm g{(const bf16_t*)(p.ws + WS_H2F8), (const bf16_t*)((const unsigned char*)p.out + OUT_W1), 0, 0, DM / 2};
        pg8::MoeOrder S{tl, ntiles, 4, F.G, F.bid};
        pg8::EpiSwiglu E{p.ws + WS_HID}; pg8::gemm_phase<pg8::EpiSwiglu, pg8::MoeOrder, true, true>(F.lds, g, S, E, tl + MOE_GI, F.wave); })
    PHASE(11, { const Params p = load_params(); const Frame F = make_frame(lds_raw, wv); int ntiles;
        LAS int* tl = moe_tables<false>(p, F, ntiles, 8);
        pg8::Gemm g{(const bf16_t*)(p.ws + WS_HID), (const bf16_t*)((const unsigned char*)p.out + OUT_W2), 0, 0, DEXP / 2};
        pg8::MoeOrder S{tl, ntiles, 8, F.G, F.bid};
        pg8::EpiY8 E{p.ws + WS_YB}; pg8::gemm_phase<pg8::EpiY8, pg8::MoeOrder, false, true>(F.lds, g, S, E, nullptr, F.wave); })
    PHASE(12, { const Params p = load_params(); const Frame F = make_frame(lds_raw, wv); p11_final(p, F); })
#undef IN
#undef SEAM
#undef PHASE
}

typedef void (*kern_t)(Params);
template <int K> struct PhaseTab { static void fill(kern_t* t) { t[K] = fwd<(1u << K)>; PhaseTab<K - 1>::fill(t); } };
template <> struct PhaseTab<-1> { static void fill(kern_t*) {} };
extern "C" void kernel_launch(void* const* d_in, const int* in_sizes, int n_in, void* d_out, int out_size, void* d_ws, size_t ws_size, hipStream_t stream) {
    static int grid = 0; static kern_t tab[NPHASE + 1];
    if (grid == 0) {
        if (n_in != 22 || out_size != NTOK * DM || ws_size < WS_END) { fprintf(stderr, "kernel_launch: unexpected shapes (n_in %d, out %d, ws %zu)\n", n_in, out_size, ws_size); grid = -1; return; }
        int dev = 0, cus = 0, per_cu = 0;
        if (hipGetDevice(&dev) != hipSuccess || hipDeviceGetAttribute(&cus, hipDeviceAttributeMultiprocessorCount, dev) != hipSuccess) { grid = -1; return; }
#if MK_ONE_LAUNCH
        tab[NPHASE] = fwd<0xffffu>;
        const int k0 = NPHASE, k1 = NPHASE + 1;
#else
        PhaseTab<NPHASE - 1>::fill(tab);
        const int k0 = 0, k1 = NPHASE;
#endif
        for (int k = k0; k < k1; ++k) {
            if (hipFuncSetAttribute((const void*)tab[k], hipFuncAttributeMaxDynamicSharedMemorySize, LDS_BYTES) != hipSuccess) { fprintf(stderr, "kernel_launch: hipFuncSetAttribute failed\n"); grid = -1; return; }
            if (hipOccupancyMaxActiveBlocksPerMultiprocessor(&per_cu, (const void*)tab[k], 512, LDS_BYTES) != hipSuccess || per_cu < 1) { fprintf(stderr, "kernel_launch: occupancy query says %d\n", per_cu); (void)hipGetLastError(); }
        }
        grid = cus;
        if (grid < 128) { fprintf(stderr, "kernel_launch: built for a 256-CU device (got %d CUs)\n", cus); grid = -1; return; }
    }
    if (grid < 0) return;
    (void)hipMemsetAsync((char*)d_ws + WS_CTL, 0, CTL_BYTES, stream);
    Params p{};
    p.x = (const float*)d_in[0]; p.c = (const float*)d_in[1]; p.w_ada = (const float*)d_in[2]; p.b_ada = (const float*)d_in[3]; p.w_in = (const float*)d_in[4]; p.conv_w = (const float*)d_in[5];
    p.a_log = (const float*)d_in[6]; p.dt_bias = (const float*)d_in[7]; p.norm_w = (const float*)d_in[8]; p.f_bias = (const float*)d_in[9]; p.w_out = (const float*)d_in[10];
    p.ln1_g = (const float*)d_in[11]; p.ln1_b = (const float*)d_in[12]; p.w_rg = (const float*)d_in[13]; p.b_rg = (const float*)d_in[14]; p.w_re = (const float*)d_in[15]; p.b_re = (const float*)d_in[16];
    p.w_gate = (const float*)d_in[17]; p.w_up = (const float*)d_in[18]; p.w_down = (const float*)d_in[19]; p.ln2_g = (const float*)d_in[20]; p.ln2_b = (const float*)d_in[21];
    p.out = (float*)d_out; p.ws = (unsigned char*)d_ws;
#if MK_ONE_LAUNCH
    p.ph_lo = 0; p.ph_hi = NPHASE;
    hipLaunchKernelGGL(tab[NPHASE], dim3(grid), dim3(512), LDS_BYTES, stream, p);
#else
    for (int k = 0; k < NPHASE; ++k) { p.ph_lo = k; p.ph_hi = k + 1; hipLaunchKernelGGL(tab[k], dim3(grid), dim3(512), LDS_BYTES, stream, p); }
#endif
}
```
